# Optimizing an MI355X kernel written in HIP

```python
import math
import jax, jax.numpy as jnp
from jax import lax
import numpy as np

D_MODEL = 1024
BATCH = 8
SEQ = 2048
DEPTH = 1
DEC_BATCH = 128
DEC_SEQ = 1
PAST_LEN = 16384
PAGE_SIZE = 128

D_MIX = 2 * D_MODEL
D_S5 = D_MIX // 2
S5_CH = 16
S5_GROUPS = D_S5 // S5_CH
S5_STATE = 64
D_SSD = D_MIX - D_S5
SSD_HEAD_DIM = 64
SSD_HEADS = D_SSD // SSD_HEAD_DIM
SSD_GROUPS = 2
SSD_HPG = SSD_HEADS // SSD_GROUPS
SSD_STATE = 128
SSD_CONV = 4
SSD_CHUNK = 128
D_CONV = D_SSD + 2 * SSD_GROUPS * SSD_STATE
D_IN_PROJ = D_S5 + D_SSD + D_CONV + SSD_HEADS
D_FF = 4 * D_MODEL
EPS = 1e-5

kernel_name = "hymba_s5_ssd_decoder_step"


def rmsnorm(x, w):
    xf = x.astype(jnp.float32)
    xf = xf * lax.rsqrt(jnp.mean(xf * xf, axis=-1, keepdims=True) + EPS)
    return (xf * w.astype(jnp.float32)).astype(x.dtype)


def _complex_affine_combine(e1, e2):
    a1r, a1i, b1r, b1i = e1
    a2r, a2i, b2r, b2i = e2
    ar = a2r * a1r - a2i * a1i
    ai = a2r * a1i + a2i * a1r
    br = a2r * b1r - a2i * b1i + b2r
    bi = a2r * b1i + a2i * b1r + b2i
    return (ar, ai, br, bi)


def s5_mixer(u, h0_re, h0_im, lam_re, lam_im, log_dt, b_re, b_im, c_re, c_im, d_s5, w_glu, b_glu):
    bsz, L, _ = u.shape
    uf = u.astype(jnp.float32).reshape(bsz, L, S5_GROUPS, S5_CH)
    dt = jnp.exp(log_dt.astype(jnp.float32))[:, None]
    lr = lam_re.astype(jnp.float32)
    li = lam_im.astype(jnp.float32)
    mag = jnp.exp(lr * dt)
    ab_re = mag * jnp.cos(li * dt)
    ab_im = mag * jnp.sin(li * dt)
    den = lr * lr + li * li
    nr, ni = ab_re - 1.0, ab_im
    f_re = (nr * lr + ni * li) / den
    f_im = (ni * lr - nr * li) / den
    br = b_re.astype(jnp.float32)
    bi = b_im.astype(jnp.float32)
    bb_re = f_re[..., None] * br - f_im[..., None] * bi
    bb_im = f_re[..., None] * bi + f_im[..., None] * br
    bu_re = jnp.einsum('gpc,blgc->blgp', bb_re, uf)
    bu_im = jnp.einsum('gpc,blgc->blgp', bb_im, uf)
    a_re = jnp.broadcast_to(ab_re, bu_re.shape)
    a_im = jnp.broadcast_to(ab_im, bu_im.shape)
    A_re, A_im, s_re, s_im = lax.associative_scan(
        _complex_affine_combine, (a_re, a_im, bu_re, bu_im), axis=1)
    h0r = h0_re.astype(jnp.float32)[:, None]
    h0i = h0_im.astype(jnp.float32)[:, None]
    h_re = A_re * h0r - A_im * h0i + s_re
    h_im = A_re * h0i + A_im * h0r + s_im
    y = (jnp.einsum('gcp,blgp->blgc', c_re.astype(jnp.float32), h_re)
         - jnp.einsum('gcp,blgp->blgc', c_im.astype(jnp.float32), h_im)
         + d_s5.astype(jnp.float32).reshape(S5_GROUPS, S5_CH) * uf)
    y = y.reshape(bsz, L, D_S5)
    g = jax.nn.gelu(y)
    out = g * jax.nn.sigmoid(g @ w_glu.astype(jnp.float32) + b_glu.astype(jnp.float32))
    return out.astype(u.dtype), h_re[:, -1], h_im[:, -1]


def ssd_chunked(x, dt, A, B, C, h0):
    bsz, L = x.shape[:2]
    Q = min(SSD_CHUNK, L)
    pad = (-L) % Q
    if pad:
        padw = lambda t: jnp.pad(t, [(0, 0), (0, pad)] + [(0, 0)] * (t.ndim - 2))
        x, dt, B, C = padw(x), padw(dt), padw(B), padw(C)
    nc = (L + pad) // Q
    x = x.reshape(bsz, nc, Q, SSD_GROUPS, SSD_HPG, SSD_HEAD_DIM)
    dt = dt.reshape(bsz, nc, Q, SSD_GROUPS, SSD_HPG)
    B = B.reshape(bsz, nc, Q, SSD_GROUPS, SSD_STATE)
    C = C.reshape(bsz, nc, Q, SSD_GROUPS, SSD_STATE)
    a = jnp.moveaxis(dt * A, 2, -1)
    a_cum = jnp.cumsum(a, axis=-1)
    mask = jnp.tril(jnp.ones((Q, Q), dtype=bool))
    seg = a_cum[..., :, None] - a_cum[..., None, :]
    Lmat = jnp.exp(jnp.where(mask, seg, -jnp.inf))
    xdt = x * dt[..., None]
    cb = jnp.einsum('bclgn,bcsgn->bcgls', C, B)
    y_diag = jnp.einsum('bcgls,bcgrls,bcsgrp->bclgrp', cb, Lmat, xdt)
    decay_states = jnp.exp(a_cum[..., -1:] - a_cum)
    states = jnp.einsum('bclgn,bcgrl,bclgrp->bcgrpn', B, decay_states, xdt)
    chunk_decay = jnp.exp(a_cum[..., -1])

    def step(h, inp):
        dec, st = inp
        return dec[..., None, None] * h + st, h

    h_last, h_prev = lax.scan(step, h0, (jnp.moveaxis(chunk_decay, 1, 0), jnp.moveaxis(states, 1, 0)))
    h_prev = jnp.moveaxis(h_prev, 0, 1)
    y_off = jnp.einsum('bclgn,bcgrpn,bcgrl->bclgrp', C, h_prev, jnp.exp(a_cum))
    y = (y_diag + y_off).reshape(bsz, nc * Q, SSD_GROUPS, SSD_HPG, SSD_HEAD_DIM)[:, :L]
    return y, h_last


def ssd_mixer(z, xbc, dt_raw, h0, conv_buf, conv_w, conv_b, a_log, dt_bias, d_ssd, norm_w):
    bsz, L, _ = xbc.shape
    xpad = jnp.concatenate([conv_buf.astype(xbc.dtype), xbc], axis=1)
    new_conv = xpad[:, -(SSD_CONV - 1):]
    conv = conv_b + sum(xpad[:, k:k + L] * conv_w[k] for k in range(SSD_CONV))
    conv = jax.nn.silu(conv.astype(jnp.float32))
    xs = conv[..., :D_SSD].reshape(bsz, L, SSD_GROUPS, SSD_HPG, SSD_HEAD_DIM)
    Bm = conv[..., D_SSD:D_SSD + SSD_GROUPS * SSD_STATE].reshape(bsz, L, SSD_GROUPS, SSD_STATE)
    Cm = conv[..., D_SSD + SSD_GROUPS * SSD_STATE:].reshape(bsz, L, SSD_GROUPS, SSD_STATE)
    dt = jax.nn.softplus(dt_raw.astype(jnp.float32) + dt_bias.astype(jnp.float32))
    dt = dt.reshape(bsz, L, SSD_GROUPS, SSD_HPG)
    A = -jnp.exp(a_log.astype(jnp.float32)).reshape(SSD_GROUPS, SSD_HPG)
    h0g = h0.astype(jnp.float32).reshape(bsz, SSD_GROUPS, SSD_HPG, SSD_HEAD_DIM, SSD_STATE)
    y, h_last = ssd_chunked(xs, dt, A, Bm, Cm, h0g)
    y = y + d_ssd.astype(jnp.float32).reshape(SSD_GROUPS, SSD_HPG, 1) * xs
    y = y.reshape(bsz, L, D_SSD) * jax.nn.silu(z.astype(jnp.float32))
    yg = y.reshape(bsz, L, SSD_GROUPS, D_SSD // SSD_GROUPS)
    yg = yg * lax.rsqrt(jnp.mean(yg * yg, axis=-1, keepdims=True) + EPS)
    y = yg.reshape(bsz, L, D_SSD) * norm_w.astype(jnp.float32)
    h_last = h_last.reshape(bsz, SSD_HEADS, SSD_HEAD_DIM, SSD_STATE)
    return y.astype(z.dtype), h_last, new_conv


def hybrid_layer(x, h5_re, h5_im, h_ssd, conv_buf, p):
    h = rmsnorm(x, p['norm_mix_w'])
    proj = h @ p['w_in']
    o1, o2, o3 = D_S5, D_S5 + D_SSD, D_S5 + D_SSD + D_CONV
    u, z, xbc, dt_raw = proj[..., :o1], proj[..., o1:o2], proj[..., o2:o3], proj[..., o3:]
    y5, n5_re, n5_im = s5_mixer(u, h5_re, h5_im, p['s5_lam_re'], p['s5_lam_im'], p['s5_log_dt'],
                                p['s5_b_re'], p['s5_b_im'], p['s5_c_re'], p['s5_c_im'], p['s5_d'],
                                p['s5_w_glu'], p['s5_b_glu'])
    y5 = rmsnorm(y5, p['s5_norm_w'])
    yssd, n_ssd, n_conv = ssd_mixer(z, xbc, dt_raw, h_ssd, conv_buf, p['ssd_conv_w'], p['ssd_conv_b'],
                                    p['ssd_a_log'], p['ssd_dt_bias'], p['ssd_d'], p['ssd_norm_w'])
    x = x + jnp.concatenate([y5, yssd], axis=-1) @ p['w_out']
    hf = rmsnorm(x, p['norm_ffn_w'])
    x = x + jnp.square(jax.nn.relu(hf @ p['w_ff1'])) @ p['w_ff2']
    return x, n5_re, n5_im, n_ssd, n_conv


def setup_inputs(seed: int = 0) -> dict:
    key = jax.random.key(seed)
    ks = jax.random.split(key, 32)
    nrm = lambda k, shape, s: jax.random.normal(k, shape, jnp.float32) * s
    Ld = DEPTH
    dt_ssd = jnp.exp(jax.random.uniform(ks[20], (Ld, SSD_HEADS), jnp.float32, math.log(1e-3), math.log(1e-1)))
    return {
        "x_prompt": nrm(ks[0], (BATCH, SEQ, D_MODEL), 1.0),
        "x_sample": nrm(ks[1], (DEC_BATCH, DEC_SEQ, D_MODEL), 1.0),
        "state_s5_re": nrm(ks[2], (Ld, DEC_BATCH, S5_GROUPS, S5_STATE), 0.5),
        "state_s5_im": nrm(ks[3], (Ld, DEC_BATCH, S5_GROUPS, S5_STATE), 0.5),
        "state_ssd": nrm(ks[4], (Ld, DEC_BATCH, SSD_HEADS, SSD_HEAD_DIM, SSD_STATE), 0.1),
        "state_conv": nrm(ks[5], (Ld, DEC_BATCH, SSD_CONV - 1, D_CONV), 1.0),
        "norm_mix_w": 1.0 + nrm(ks[6], (Ld, D_MODEL), 0.02),
        "w_in": nrm(ks[7], (Ld, D_MODEL, D_IN_PROJ), D_MODEL ** -0.5),
        "s5_lam_re": -0.5 + nrm(ks[8], (Ld, S5_GROUPS, S5_STATE), 0.01),
        "s5_lam_im": jnp.broadcast_to(math.pi * jnp.arange(S5_STATE, dtype=jnp.float32), (Ld, S5_GROUPS, S5_STATE))
                      + nrm(ks[9], (Ld, S5_GROUPS, S5_STATE), 0.01),
        "s5_log_dt": jax.random.uniform(ks[10], (Ld, S5_GROUPS), jnp.float32, math.log(1e-3), math.log(1e-1)),
        "s5_b_re": nrm(ks[11], (Ld, S5_GROUPS, S5_STATE, S5_CH), (2 * S5_CH) ** -0.5),
        "s5_b_im": nrm(ks[12], (Ld, S5_GROUPS, S5_STATE, S5_CH), (2 * S5_CH) ** -0.5),
        "s5_c_re": nrm(ks[13], (Ld, S5_GROUPS, S5_CH, S5_STATE), (2 * S5_STATE) ** -0.5),
        "s5_c_im": nrm(ks[14], (Ld, S5_GROUPS, S5_CH, S5_STATE), (2 * S5_STATE) ** -0.5),
        "s5_d": nrm(ks[15], (Ld, D_S5), 1.0),
        "s5_w_glu": nrm(ks[16], (Ld, D_S5, D_S5), D_S5 ** -0.5),
        "s5_b_glu": nrm(ks[17], (Ld, D_S5), 0.01),
        "s5_norm_w": 1.0 + nrm(ks[18], (Ld, D_S5), 0.02),
        "ssd_conv_w": nrm(ks[19], (Ld, SSD_CONV, D_CONV), SSD_CONV ** -0.5),
        "ssd_conv_b": nrm(ks[21], (Ld, D_CONV), 0.01),
        "ssd_a_log": jnp.log(jax.random.uniform(ks[22], (Ld, SSD_HEADS), jnp.float32, 1.0, 16.0)),
        "ssd_dt_bias": dt_ssd + jnp.log(-jnp.expm1(-dt_ssd)),
        "ssd_d": 1.0 + nrm(ks[23], (Ld, SSD_HEADS), 0.02),
        "ssd_norm_w": 1.0 + nrm(ks[24], (Ld, D_SSD), 0.02),
        "w_out": nrm(ks[25], (Ld, D_MIX, D_MODEL), D_MIX ** -0.5),
        "norm_ffn_w": 1.0 + nrm(ks[26], (Ld, D_MODEL), 0.02),
        "w_ff1": nrm(ks[27], (Ld, D_MODEL, D_FF), D_MODEL ** -0.5),
        "w_ff2": nrm(ks[28], (Ld, D_FF, D_MODEL), D_FF ** -0.5),
        "norm_final_w": 1.0 + nrm(ks[29], (D_MODEL,), 0.02),
    }


def reference(x_prompt, x_sample, state_s5_re, state_s5_im, state_ssd, state_conv,
              norm_mix_w, w_in, s5_lam_re, s5_lam_im, s5_log_dt, s5_b_re, s5_b_im, s5_c_re, s5_c_im,
              s5_d, s5_w_glu, s5_b_glu, s5_norm_w, ssd_conv_w, ssd_conv_b, ssd_a_log, ssd_dt_bias,
              ssd_d, ssd_norm_w, w_out, norm_ffn_w, w_ff1, w_ff2, norm_final_w):
    bp = x_prompt.shape[0]
    xp, xs = x_prompt, x_sample
    np_re, np_im, np_ssd, np_conv = [], [], [], []
    ns_re, ns_im, ns_ssd, ns_conv = [], [], [], []
    for l in range(DEPTH):
        p = dict(norm_mix_w=norm_mix_w[l], w_in=w_in[l], s5_lam_re=s5_lam_re[l], s5_lam_im=s5_lam_im[l],
                 s5_log_dt=s5_log_dt[l], s5_b_re=s5_b_re[l], s5_b_im=s5_b_im[l], s5_c_re=s5_c_re[l],
                 s5_c_im=s5_c_im[l], s5_d=s5_d[l], s5_w_glu=s5_w_glu[l], s5_b_glu=s5_b_glu[l],
                 s5_norm_w=s5_norm_w[l], ssd_conv_w=ssd_conv_w[l], ssd_conv_b=ssd_conv_b[l],
                 ssd_a_log=ssd_a_log[l], ssd_dt_bias=ssd_dt_bias[l], ssd_d=ssd_d[l], ssd_norm_w=ssd_norm_w[l],
                 w_out=w_out[l], norm_ffn_w=norm_ffn_w[l], w_ff1=w_ff1[l], w_ff2=w_ff2[l])
        z5 = jnp.zeros((bp, S5_GROUPS, S5_STATE), jnp.float32)
        zssd = jnp.zeros((bp, SSD_HEADS, SSD_HEAD_DIM, SSD_STATE), jnp.float32)
        zconv = jnp.zeros((bp, SSD_CONV - 1, D_CONV), x_prompt.dtype)
        xp, a, b, c, d = hybrid_layer(xp, z5, z5, zssd, zconv, p)
        np_re.append(a); np_im.append(b); np_ssd.append(c); np_conv.append(d)
        xs, a, b, c, d = hybrid_layer(xs, state_s5_re[l], state_s5_im[l], state_ssd[l], state_conv[l], p)
        ns_re.append(a); ns_im.append(b); ns_ssd.append(c); ns_conv.append(d)
    y_prompt = rmsnorm(xp, norm_final_w)
    y_sample = rmsnorm(xs, norm_final_w)
    return (y_prompt, y_sample,
            jnp.stack(np_re), jnp.stack(np_im), jnp.stack(np_ssd), jnp.stack(np_conv),
            jnp.stack(ns_re), jnp.stack(ns_im), jnp.stack(ns_ssd), jnp.stack(ns_conv))
```

```cpp
#include <hip/hip_runtime.h>
#include <hip/hip_cooperative_groups.h>
#include <cstdio>
#include <cstdint>
namespace cg = cooperative_groups;

namespace pg8 {
#define PG8_LAS __attribute__((address_space(3)))
typedef unsigned short bf16_t;
typedef short bf16x8 __attribute__((ext_vector_type(8)));
typedef float f32x4 __attribute__((ext_vector_type(4)));
typedef unsigned u32x4 __attribute__((ext_vector_type(4)));
typedef unsigned u32x2 __attribute__((ext_vector_type(2)));
constexpr int BM = 256, BK = 64, HALF = 128, HTB = HALF * BK * 2  , STAGE_BYTES = 8 * HTB, NXCD = 8, WGM = 8;

__host__ __device__ __forceinline__ int lds_byte(int r, int c) { const int st = (r >> 4) * 2 + (c >> 5), rr = r & 15, cc = c & 31, ob = rr * 64 + cc * 2; return st * 1024 + (ob ^ (((ob >> 9) & 1) << 5)); }
__host__ __device__ __forceinline__ void stage_rc(int b, int& R, int& C) { const int st = b / 1024, sb = b % 1024, swz = sb ^ (((sb >> 9) & 1) << 5); R = (st >> 1) * 16 + swz / 64; C = (st & 1) * 32 + (swz % 64) / 2; }
__host__ __device__ __forceinline__ int perm32(int rho) { const int n = rho >> 4, i = rho & 15; return 8 * (i >> 2) + 4 * n + (i & 3); }

struct Unit { int pm, pn; };
struct Gemm { const bf16_t* A; const bf16_t* Bt; int lda, ldb, K; };

struct StaticOrder {
    int nM, nN, nwg, G, c;
    __host__ __device__ void init(int M, int N, int G_, int c_) { nM = M / BM; nN = N / BM; nwg = nM * nN; G = G_; c = c_; }
    __host__ __device__ bool next(int i, Unit& u) const {
        const long L = (long)i * G + c; if (L >= nwg) return false;
        int wgid = (int)L; { const int q = nwg / NXCD, r = nwg % NXCD, xcd = wgid % NXCD, off = wgid / NXCD; wgid = (xcd < r ? xcd * (q + 1) : r * (q + 1) + (xcd - r) * q) + off; }
        const int nig = WGM * nN, gid = wgid / nig, fm = gid * WGM, gsz = (nM - fm) < WGM ? (nM - fm) : WGM;
        u.pm = fm + ((wgid % nig) % gsz); u.pn = (wgid % nig) / gsz; return true;
    }
};

__device__ __forceinline__ unsigned cvt_pk_bf16(float lo, float hi) { unsigned r; asm volatile("v_cvt_pk_bf16_f32 %0, %1, %2" : "=v"(r) : "v"(lo), "v"(hi)); return r; }

template <class Epi, class Sched, bool ALIGN_EPI = false, bool SP2 = false>
__device__ __forceinline__ void gemm_phase(PG8_LAS unsigned char* lds, const Gemm g, const Sched& S, const Epi& E) {
    const int tid = threadIdx.x, wid = __builtin_amdgcn_readfirstlane(tid >> 6), lane = tid & 63, wr = wid >> 2, wc = wid & 3, fr = lane & 15, fq = lane >> 4;
    const int K = g.K, nt = K / BK;
    unsigned voffA[2], voffB[2];
#pragma unroll
    for (int i = 0; i < 2; ++i) { int R, C; stage_rc(tid * 16 + i * 8192, R, C); const int Rb = Epi::PERM ? ((R & ~31) + perm32(R & 31)) : R;
        voffA[i] = (unsigned)(R * g.lda + C) * 2u; voffB[i] = (unsigned)(Rb * g.ldb + C) * 2u; }
    const size_t kstep = (size_t)(BK * 2);
    const size_t hstepA = (size_t)HALF * g.lda * 2, hstepB = (size_t)HALF * g.ldb * 2;
    const size_t tstepA = 2 * hstepA, tstepB = 2 * hstepB;
    const unsigned ldsw = (unsigned)wid * 1024u;
    const int aoff = lds_byte(wr * 64 + fr, fq * 8), boff = lds_byte(wc * 32 + fr, fq * 8);
#define PG8_SA(b, h) (((b) * 2 + (h)) * HTB)
#define PG8_SB(b, h) ((4 + (b) * 2 + (h)) * HTB)
#define PG8_STAGE(bufoff, gbase, voff) do { _Pragma("unroll") for (int _i = 0; _i < 2; ++_i) \
        __builtin_amdgcn_global_load_lds((const unsigned*)((const char*)(gbase) + (voff)[_i]), (PG8_LAS unsigned*)(lds + (bufoff) + ldsw + _i * 8192), 16, 0, 0); } while (0)
#define PG8_LDA(dst, b, h) do { _Pragma("unroll") for (int m = 0; m < 4; ++m) _Pragma("unroll") for (int k = 0; k < 2; ++k) dst[m][k] = *(const PG8_LAS bf16x8*)(lds + PG8_SA(b, h) + aoff + m * 2048 + k * 1024); } while (0)
#define PG8_LDB(dst, b, h) do { _Pragma("unroll") for (int n = 0; n < 2; ++n) _Pragma("unroll") for (int k = 0; k < 2; ++k) dst[n][k] = *(const PG8_LAS bf16x8*)(lds + PG8_SB(b, h) + boff + n * 2048 + k * 1024); } while (0)
#define PG8_MMA(ai, bj, At, Bt) do { __builtin_amdgcn_s_setprio(1); _Pragma("unroll") for (int m = 0; m < 4; ++m) _Pragma("unroll") for (int n = 0; n < 2; ++n) _Pragma("unroll") for (int k = 0; k < 2; ++k) \
        acc[ai][bj][m][n] = __builtin_amdgcn_mfma_f32_16x16x32_bf16(Bt[n][k], At[m][k], acc[ai][bj][m][n], 0, 0, 0); __builtin_amdgcn_s_setprio(0); } while (0)
#define PG8_WAIT_V(n) asm volatile("s_waitcnt vmcnt(" #n ")" ::: "memory")
#define PG8_WAIT_L(n) asm volatile("s_waitcnt lgkmcnt(" #n ")" ::: "memory")
#define PG8_BAR __builtin_amdgcn_s_barrier()
#define PG8_SCHED __builtin_amdgcn_sched_barrier(0)
    Unit cur, nxt; int ui = 0;
    if (!S.next(0, cur)) return;
    f32x4 acc[2][2][4][2];
#pragma unroll
    for (int a = 0; a < 2; ++a)
#pragma unroll
        for (int b = 0; b < 2; ++b)
#pragma unroll
            for (int m = 0; m < 4; ++m)
#pragma unroll
                for (int n = 0; n < 2; ++n) acc[a][b][m][n] = (f32x4){0.f, 0.f, 0.f, 0.f};
    bf16x8 At[4][2], B0[2][2], B1[2][2];
    const char* cA = (const char*)g.A + (size_t)cur.pm * tstepA; const char* cB = (const char*)g.Bt + (size_t)cur.pn * tstepB;
    if constexpr (SP2) {
        PG8_STAGE(PG8_SB(0, 0), cB, voffB); PG8_STAGE(PG8_SB(0, 1), cB + hstepB, voffB); PG8_STAGE(PG8_SA(0, 0), cA, voffA); PG8_STAGE(PG8_SA(0, 1), cA + hstepA, voffA);
        if (wr == 1) PG8_BAR;
        PG8_WAIT_V(2); PG8_BAR;
        PG8_STAGE(PG8_SB(1, 0), cB + kstep, voffB); PG8_STAGE(PG8_SA(1, 0), cA + kstep, voffA); PG8_STAGE(PG8_SB(1, 1), cB + hstepB + kstep, voffB);
        PG8_WAIT_V(6); PG8_BAR;
    } else {
        PG8_STAGE(PG8_SB(0, 0), cB, voffB); PG8_STAGE(PG8_SA(0, 0), cA, voffA); PG8_STAGE(PG8_SB(0, 1), cB + hstepB, voffB); PG8_STAGE(PG8_SA(0, 1), cA + hstepA, voffA);
        if (wr == 1) PG8_BAR;
        PG8_WAIT_V(4); PG8_BAR;
        PG8_STAGE(PG8_SB(1, 0), cB + kstep, voffB); PG8_STAGE(PG8_SA(1, 0), cA + kstep, voffA); PG8_STAGE(PG8_SB(1, 1), cB + hstepB + kstep, voffB);
        PG8_WAIT_V(6); PG8_BAR;
    }
    for (;;) {
        const bool has_next = S.next(ui + 1, nxt);
        const char* nA = has_next ? (const char*)g.A + (size_t)nxt.pm * tstepA : cA; const char* nB = has_next ? (const char*)g.Bt + (size_t)nxt.pn * tstepB : cB;
        for (int t = 0; t < nt; t += 2) {
            const bool last = (t == nt - 2);
            const char* a1 = cA + (size_t)(t + 1) * kstep;
            const char* a2 = last ? nA : cA + (size_t)(t + 2) * kstep; const char* b2 = last ? nB : cB + (size_t)(t + 2) * kstep;
            const char* a3 = a2 + kstep; const char* b3 = b2 + kstep;
            if constexpr (Epi::MID) { if (t == (nt >> 1)) E.mid(acc, cur, wr, wc, fr, fq); }
            if constexpr (SP2) {
            PG8_LDB(B0, 0, 0); PG8_LDB(B1, 0, 1); PG8_SCHED; PG8_LDA(At, 0, 0); PG8_STAGE(PG8_SA(1, 1), a1 + hstepA, voffA);
            PG8_WAIT_V(8); PG8_WAIT_L(0); PG8_BAR; PG8_MMA(0, 0, At, B0); PG8_MMA(0, 1, At, B1); PG8_BAR; PG8_SCHED;
            PG8_LDA(At, 0, 1); PG8_STAGE(PG8_SB(0, 0), b2, voffB); PG8_STAGE(PG8_SB(0, 1), b2 + hstepB, voffB); PG8_STAGE(PG8_SA(0, 0), a2, voffA);
            PG8_WAIT_V(8); PG8_WAIT_L(0); PG8_BAR; PG8_MMA(1, 0, At, B0); PG8_MMA(1, 1, At, B1); PG8_BAR; PG8_SCHED;
            PG8_LDB(B0, 1, 0); PG8_LDB(B1, 1, 1); PG8_SCHED; PG8_LDA(At, 1, 0); PG8_STAGE(PG8_SA(0, 1), a2 + hstepA, voffA);
            PG8_WAIT_V(8); PG8_WAIT_L(0); PG8_BAR; PG8_MMA(0, 0, At, B0); PG8_MMA(0, 1, At, B1); PG8_BAR; PG8_SCHED;
            PG8_LDA(At, 1, 1); PG8_STAGE(PG8_SB(1, 0), b3, voffB); PG8_STAGE(PG8_SB(1, 1), b3 + hstepB, voffB); PG8_STAGE(PG8_SA(1, 0), a3, voffA);
            PG8_WAIT_V(8); PG8_WAIT_L(0); PG8_BAR; PG8_MMA(1, 0, At, B0); PG8_MMA(1, 1, At, B1); PG8_BAR; PG8_SCHED;
            } else {
            PG8_LDB(B0, 0, 0); PG8_SCHED; PG8_LDA(At, 0, 0); PG8_STAGE(PG8_SA(1, 1), a1 + hstepA, voffA);
            PG8_WAIT_L(8); PG8_BAR; PG8_WAIT_L(0); PG8_MMA(0, 0, At, B0); PG8_BAR; PG8_SCHED;
            PG8_LDB(B1, 0, 1); PG8_STAGE(PG8_SB(0, 0), b2, voffB);
            PG8_BAR; PG8_WAIT_L(0); PG8_MMA(0, 1, At, B1); PG8_BAR;
            PG8_LDA(At, 0, 1); PG8_STAGE(PG8_SA(0, 0), a2, voffA);
            PG8_BAR; PG8_WAIT_L(0); PG8_MMA(1, 0, At, B0); PG8_BAR; PG8_SCHED;
            PG8_STAGE(PG8_SB(0, 1), b2 + hstepB, voffB);
            PG8_WAIT_V(6); PG8_BAR; PG8_MMA(1, 1, At, B1); PG8_BAR;
            PG8_LDB(B0, 1, 0); PG8_SCHED; PG8_LDA(At, 1, 0); PG8_STAGE(PG8_SA(0, 1), a2 + hstepA, voffA);
            PG8_WAIT_L(8); PG8_BAR; PG8_WAIT_L(0); PG8_MMA(0, 0, At, B0); PG8_BAR; PG8_SCHED;
            PG8_LDB(B1, 1, 1); PG8_STAGE(PG8_SB(1, 0), b3, voffB);
            PG8_BAR; PG8_WAIT_L(0); PG8_MMA(0, 1, At, B1); PG8_BAR;
            PG8_LDA(At, 1, 1); PG8_STAGE(PG8_SA(1, 0), a3, voffA);
            PG8_BAR; PG8_WAIT_L(0); PG8_MMA(1, 0, At, B0); PG8_BAR; PG8_SCHED;
            PG8_STAGE(PG8_SB(1, 1), b3 + hstepB, voffB);
            PG8_WAIT_V(6); PG8_BAR; PG8_MMA(1, 1, At, B1); PG8_BAR;
            }
        }
        if constexpr (ALIGN_EPI) { if (wr == 0) PG8_BAR; }
        E(acc, cur, wr, wc, fr, fq);
        if (!has_next) break;
#pragma unroll
        for (int a = 0; a < 2; ++a)
#pragma unroll
            for (int b = 0; b < 2; ++b)
#pragma unroll
                for (int m = 0; m < 4; ++m)
#pragma unroll
                    for (int n = 0; n < 2; ++n) acc[a][b][m][n] = (f32x4){0.f, 0.f, 0.f, 0.f};
        cur = nxt; cA = nA; cB = nB; ++ui;
        if constexpr (ALIGN_EPI) { if (wr == 1) PG8_BAR; }
    }
    PG8_WAIT_V(0);
    if constexpr (!ALIGN_EPI) { if (wr == 0) PG8_BAR; }
    PG8_BAR;
#undef PG8_SA
#undef PG8_SB
#undef PG8_STAGE
#undef PG8_LDA
#undef PG8_LDB
#undef PG8_MMA
#undef PG8_WAIT_V
#undef PG8_WAIT_L
#undef PG8_BAR
#undef PG8_SCHED
}
}

#define LAS __attribute__((address_space(3)))
typedef unsigned short bf16_t;
typedef short bf16x8 __attribute__((ext_vector_type(8)));
typedef float f32x4 __attribute__((ext_vector_type(4)));
typedef float f32x2 __attribute__((ext_vector_type(2)));
typedef float f32x16 __attribute__((ext_vector_type(16)));
typedef unsigned u32x4 __attribute__((ext_vector_type(4)));
typedef unsigned u32x2 __attribute__((ext_vector_type(2)));

constexpr int DM = 1024, NB = 8, SEQ = 2048, MP = NB * SEQ, NSAMP = 128, TT = MP + NSAMP;
constexpr int NCH = SEQ / 128;
constexpr int PJ = 3584;
constexpr int N1 = 3840, N1V = 3600;
constexpr int DCONV = 1536, DFF = 4096;
constexpr float EPS = 1e-5f;
constexpr int XT_P = 136;

constexpr size_t MiB = 1u << 20;
constexpr size_t WS_SS5 = 0, WS_SSF = 128 * 1024, WS_CD = 384 * 1024, WS_AB = 512 * 1024, WS_AQ = 576 * 1024;
constexpr size_t WS_BBT = 1 * MiB, WS_CM = 1 * MiB + 256 * 1024, WS_DT = 2 * MiB, WS_SE = 4 * MiB;
constexpr size_t WS_WIN = 8 * MiB, WS_WGLU = WS_WIN + (size_t)N1 * DM * 2, WS_WOUT = WS_WGLU + (size_t)DM * DM * 2, WS_WFF1 = WS_WOUT + (size_t)DM * 2048 * 2, WS_WFF2 = WS_WFF1 + (size_t)DFF * DM * 2;
constexpr size_t WS_XN = 38 * MiB;
constexpr size_t WS_PROJ = 71 * MiB;
constexpr size_t WS_ST = 184 * MiB;
constexpr size_t WS_HID = 71 * MiB;
constexpr size_t WS_END = 216 * MiB;
static_assert(WS_WFF2 + (size_t)DM * DFF * 2 <= WS_XN && WS_XN + (size_t)TT * DM * 2 <= WS_PROJ && WS_PROJ + (size_t)TT * PJ * 2 <= WS_ST && WS_HID + (size_t)TT * DFF * 2 <= WS_END, "ws map");

constexpr size_t O_YS = (size_t)MP * DM, O_S5RP = O_YS + (size_t)NSAMP * DM, O_S5IP = O_S5RP + 32768, O_SSDP = O_S5IP + 32768, O_CVP = O_SSDP + 1048576,
                 O_S5RS = O_CVP + 36864, O_S5IS = O_S5RS + 524288, O_SSDS = O_S5IS + 524288, O_CVS = O_SSDS + 16777216, O_END = O_CVS + 589824;

constexpr int LDS_BYTES = 147456;

struct Args { const float* in[30]; float* out; unsigned char* ws; int ph_lo, ph_hi; };

__device__ __forceinline__ float bf2f(unsigned short b) { return __builtin_bit_cast(float, (unsigned)b << 16); }
__device__ __forceinline__ float bflo(unsigned w) { return __builtin_bit_cast(float, w << 16); }
__device__ __forceinline__ float bfhi(unsigned w) { return __builtin_bit_cast(float, w & 0xffff0000u); }
__device__ __forceinline__ unsigned pk2(float lo, float hi) { return pg8::cvt_pk_bf16(lo, hi); }
__device__ __forceinline__ float wave_sum(float v) {
#pragma unroll
    for (int o = 1; o < 64; o <<= 1) v += __shfl_xor(v, o);
    return v;
}
__device__ __forceinline__ float sigmoidf_(float v) { return __builtin_amdgcn_rcpf(1.f + __expf(-v)); }
__device__ __forceinline__ float siluf_(float v) { return v * sigmoidf_(v); }
__device__ __forceinline__ float gelu_tanh(float v) { const float u = 1.5957691216057308f * (v + 0.044715f * v * v * v); return v * sigmoidf_(u); }
__device__ __forceinline__ float softplusf_(float x) { return fmaxf(x, 0.f) + log1pf(__expf(-fabsf(x))); }
__device__ __forceinline__ float rs_from_ss(float ss, float n) { return 1.0f / sqrtf(ss / n + EPS); }

struct EpiProj {
    static constexpr bool PERM = true, MID = false;
    bf16_t* P; float* DT;
    __device__ __forceinline__ void operator()(const f32x4 (&acc)[2][2][4][2], const pg8::Unit& u, int wr, int wc, int fr, int fq) const {
        const int row0 = u.pm * 256 + wr * 64 + fr, col0 = u.pn * 256 + wc * 32 + 8 * fq;
#pragma unroll
        for (int ai = 0; ai < 2; ++ai)
#pragma unroll
            for (int m = 0; m < 4; ++m) { const int row = row0 + ai * 128 + m * 16;
#pragma unroll
                for (int bj = 0; bj < 2; ++bj) { const int col = col0 + bj * 128; const f32x4 v0 = acc[ai][bj][m][0], v1 = acc[ai][bj][m][1];
                    if (col < PJ) { u32x4 w; w.x = pk2(v0[0], v0[1]); w.y = pk2(v0[2], v0[3]); w.z = pk2(v1[0], v1[1]); w.w = pk2(v1[2], v1[3]); *(u32x4*)(P + (size_t)row * PJ + col) = w; }
                    else if (col < N1V) { float* d = DT + (size_t)row * 16 + (col - PJ); *(f32x4*)d = v0; *(f32x4*)(d + 4) = v1; } } }
    }
};
struct EpiGlu {
    static constexpr bool PERM = true, MID = false;
    const bf16_t* G; bf16_t* P; const float* bias; float* SS;
    __device__ __forceinline__ void operator()(const f32x4 (&acc)[2][2][4][2], const pg8::Unit& u, int wr, int wc, int fr, int fq) const {
        const int row0 = u.pm * 256 + wr * 64 + fr, col0 = u.pn * 256 + wc * 32 + 8 * fq;
        f32x4 bv[2][2];
#pragma unroll
        for (int bj = 0; bj < 2; ++bj) { bv[bj][0] = *(const f32x4*)(bias + col0 + bj * 128); bv[bj][1] = *(const f32x4*)(bias + col0 + bj * 128 + 4); }
#pragma unroll
        for (int ai = 0; ai < 2; ++ai)
#pragma unroll
            for (int m = 0; m < 4; ++m) { const int row = row0 + ai * 128 + m * 16; float ss = 0.f;
#pragma unroll
                for (int bj = 0; bj < 2; ++bj) { const int col = col0 + bj * 128; const u32x4 gw = *(const u32x4*)(G + (size_t)row * DM + col);
                    const f32x4 v0 = acc[ai][bj][m][0] + bv[bj][0], v1 = acc[ai][bj][m][1] + bv[bj][1]; float o[8];
                    o[0] = bflo(gw.x) * sigmoidf_(v0[0]); o[1] = bfhi(gw.x) * sigmoidf_(v0[1]); o[2] = bflo(gw.y) * sigmoidf_(v0[2]); o[3] = bfhi(gw.y) * sigmoidf_(v0[3]);
                    o[4] = bflo(gw.z) * sigmoidf_(v1[0]); o[5] = bfhi(gw.z) * sigmoidf_(v1[1]); o[6] = bflo(gw.w) * sigmoidf_(v1[2]); o[7] = bfhi(gw.w) * sigmoidf_(v1[3]);
#pragma unroll
                    for (int i = 0; i < 8; ++i) ss += o[i] * o[i];
                    u32x4 w; w.x = pk2(o[0], o[1]); w.y = pk2(o[2], o[3]); w.z = pk2(o[4], o[5]); w.w = pk2(o[6], o[7]); *(u32x4*)(P + (size_t)row * PJ + col) = w; }
                ss += __shfl_xor(ss, 16); ss += __shfl_xor(ss, 32);
                if (fq == 0) atomicAdd(SS + row, ss); }
    }
};
struct EpiOut {
    static constexpr bool PERM = true, MID = true;
    const float* X; float* X1; bf16_t* X1B; float* SSF; const float* SS5;
    __device__ __forceinline__ void mid(f32x4 (&acc)[2][2][4][2], const pg8::Unit& u, int wr, int wc, int fr, int fq) const {
        const int row0 = u.pm * 256 + wr * 64 + fr;
#pragma unroll
        for (int ai = 0; ai < 2; ++ai)
#pragma unroll
            for (int m = 0; m < 4; ++m) { const float s = rs_from_ss(SS5[row0 + ai * 128 + m * 16], 1024.f);
#pragma unroll
                for (int bj = 0; bj < 2; ++bj) { acc[ai][bj][m][0] *= s; acc[ai][bj][m][1] *= s; } }
    }
    __device__ __forceinline__ void operator()(const f32x4 (&acc)[2][2][4][2], const pg8::Unit& u, int wr, int wc, int fr, int fq) const {
        const int row0 = u.pm * 256 + wr * 64 + fr, col0 = u.pn * 256 + wc * 32 + 8 * fq;
#pragma unroll
        for (int ai = 0; ai < 2; ++ai)
#pragma unroll
            for (int m = 0; m < 4; ++m) { const int row = row0 + ai * 128 + m * 16; float ss = 0.f;
#pragma unroll
                for (int bj = 0; bj < 2; ++bj) { const size_t off = (size_t)row * DM + col0 + bj * 128;
                    const f32x4 v0 = *(const f32x4*)(X + off) + acc[ai][bj][m][0], v1 = *(const f32x4*)(X + off + 4) + acc[ai][bj][m][1];
                    ss += (v0[0] * v0[0] + v0[1] * v0[1]) + (v0[2] * v0[2] + v0[3] * v0[3]) + (v1[0] * v1[0] + v1[1] * v1[1]) + (v1[2] * v1[2] + v1[3] * v1[3]);
                    *(f32x4*)(X1 + off) = v0; *(f32x4*)(X1 + off + 4) = v1;
                    u32x4 w; w.x = pk2(v0[0], v0[1]); w.y = pk2(v0[2], v0[3]); w.z = pk2(v1[0], v1[1]); w.w = pk2(v1[2], v1[3]); *(u32x4*)(X1B + off) = w; }
                ss += __shfl_xor(ss, 16); ss += __shfl_xor(ss, 32);
                if (fq == 0) atomicAdd(SSF + row, ss); }
    }
};
struct EpiFF1 {
    static constexpr bool PERM = true, MID = false;
    bf16_t* H; const float* SSF;
    __device__ __forceinline__ void operator()(const f32x4 (&acc)[2][2][4][2], const pg8::Unit& u, int wr, int wc, int fr, int fq) const {
        const int row0 = u.pm * 256 + wr * 64 + fr, col0 = u.pn * 256 + wc * 32 + 8 * fq;
#pragma unroll
        for (int ai = 0; ai < 2; ++ai)
#pragma unroll
            for (int m = 0; m < 4; ++m) { const int row = row0 + ai * 128 + m * 16; const float s = rs_from_ss(SSF[row], 1024.f);
#pragma unroll
                for (int bj = 0; bj < 2; ++bj) { f32x4 v0 = acc[ai][bj][m][0] * s, v1 = acc[ai][bj][m][1] * s;
#pragma unroll
                    for (int i = 0; i < 4; ++i) { const float a = fmaxf(v0[i], 0.f), b = fmaxf(v1[i], 0.f); v0[i] = a * a; v1[i] = b * b; }
                    u32x4 w; w.x = pk2(v0[0], v0[1]); w.y = pk2(v0[2], v0[3]); w.z = pk2(v1[0], v1[1]); w.w = pk2(v1[2], v1[3]); *(u32x4*)(H + (size_t)row * DFF + col0 + bj * 128) = w; } }
    }
};
struct EpiFF2 {
    static constexpr bool PERM = true, MID = false;
    float* X1;
    __device__ __forceinline__ void operator()(const f32x4 (&acc)[2][2][4][2], const pg8::Unit& u, int wr, int wc, int fr, int fq) const {
        const int row0 = u.pm * 256 + wr * 64 + fr, col0 = u.pn * 256 + wc * 32 + 8 * fq;
#pragma unroll
        for (int ai = 0; ai < 2; ++ai)
#pragma unroll
            for (int m = 0; m < 4; ++m) { const int row = row0 + ai * 128 + m * 16;
#pragma unroll
                for (int bj = 0; bj < 2; ++bj) { float* p = X1 + (size_t)row * DM + col0 + bj * 128;
                    const f32x4 v0 = *(const f32x4*)p + acc[ai][bj][m][0], v1 = *(const f32x4*)(p + 4) + acc[ai][bj][m][1]; *(f32x4*)p = v0; *(f32x4*)(p + 4) = v1; } }
    }
};

template <class F>
__device__ __forceinline__ void skinny_gemm(LAS unsigned char* lds, const bf16_t* A, int lda, const bf16_t* Bt, int ldb, int K, int nct, const F& f) {
    const int tid = threadIdx.x, wid = tid >> 6, lane = tid & 63;
    LAS float* red = (LAS float*)lds;
    const int nunits = 4 * nct, kw = K >> 3;
    for (int u = blockIdx.x; u < nunits; u += gridDim.x) {
        const int rt = u & 3, ct = u >> 2;
        const bf16_t* ap = A + (size_t)(rt * 32 + (lane & 31)) * lda + wid * kw + (lane >> 5) * 8;
        const bf16_t* bp = Bt + (size_t)(ct * 32 + (lane & 31)) * ldb + wid * kw + (lane >> 5) * 8;
        f32x16 acc;
#pragma unroll
        for (int i = 0; i < 16; ++i) acc[i] = 0.f;
#pragma unroll 8
        for (int kk = 0; kk < kw; kk += 16) { const bf16x8 a = *(const bf16x8*)(ap + kk), b = *(const bf16x8*)(bp + kk); acc = __builtin_amdgcn_mfma_f32_32x32x16_bf16(a, b, acc, 0, 0, 0); }
#pragma unroll
        for (int r = 0; r < 16; ++r) red[wid * 1056 + ((r & 3) + 8 * (r >> 2) + 4 * (lane >> 5)) * 33 + (lane & 31)] = acc[r];
        __syncthreads();
        const int row = tid >> 4, c = (tid & 15) * 2;
        float lo0 = 0.f, lo1 = 0.f, hi0 = 0.f, hi1 = 0.f;
#pragma unroll
        for (int w = 0; w < 4; ++w) { lo0 += red[w * 1056 + row * 33 + c]; lo1 += red[w * 1056 + row * 33 + c + 1]; hi0 += red[(w + 4) * 1056 + row * 33 + c]; hi1 += red[(w + 4) * 1056 + row * 33 + c + 1]; }
        f(rt * 32 + row, ct * 32 + c, lo0, hi0, lo1, hi1);
        __syncthreads();
    }
}
__device__ __forceinline__ float red16(float v) { v += __shfl_xor(v, 1); v += __shfl_xor(v, 2); v += __shfl_xor(v, 4); v += __shfl_xor(v, 8); return v; }

__device__ __forceinline__ void p0_transpose_item(const float* W, int K, int Nsrc, int N, bf16_t* WT, const float* gain, LAS float* scr, int item, int lane) {
    const int nblk = N / 32, kb = item / nblk, nb = item % nblk, k0 = 64 * kb, n0 = 32 * nb;
    const int n = n0 + (lane & 31); const bool ok = n < Nsrc;
#pragma unroll 8
    for (int i = 0; i < 32; ++i) { const int kk = 2 * i + (lane >> 5); float v = ok ? W[(size_t)(k0 + kk) * Nsrc + n] : 0.f; if (gain) v *= gain[k0 + kk]; scr[kk * 33 + (lane & 31)] = v; }
    asm volatile("s_waitcnt lgkmcnt(0)" ::: "memory");
    const int c = lane & 7;
#pragma unroll
    for (int j = 0; j < 4; ++j) { const int nn = (lane >> 3) + 8 * j; const LAS float* s = scr + (8 * c) * 33 + nn;
        u32x4 o; o.x = pk2(s[0 * 33], s[1 * 33]); o.y = pk2(s[2 * 33], s[3 * 33]); o.z = pk2(s[4 * 33], s[5 * 33]); o.w = pk2(s[6 * 33], s[7 * 33]);
        *(u32x4*)(WT + (size_t)(n0 + nn) * K + k0 + 8 * c) = o; }
    asm volatile("s_waitcnt lgkmcnt(0)" ::: "memory");
}

__device__ __forceinline__ void conv4x4(const bf16_t* xcol, long rowg, bool zero_hist3, const float* cw, const float* cbias, int ch, float (&out)[4][4]) {
    float xin[7][4];
#pragma unroll
    for (int rr = 0; rr < 7; ++rr) {
        if (rr < 3 && zero_hist3) { xin[rr][0] = xin[rr][1] = xin[rr][2] = xin[rr][3] = 0.f; }
        else { const u32x2 w = *(const u32x2*)(xcol + (rowg - 3 + rr) * PJ); xin[rr][0] = bflo(w.x); xin[rr][1] = bfhi(w.x); xin[rr][2] = bflo(w.y); xin[rr][3] = bfhi(w.y); }
    }
    const f32x4 b = *(const f32x4*)(cbias + ch);
    f32x4 w[4];
#pragma unroll
    for (int k = 0; k < 4; ++k) w[k] = *(const f32x4*)(cw + k * DCONV + ch);
#pragma unroll
    for (int i = 0; i < 4; ++i)
#pragma unroll
        for (int j = 0; j < 4; ++j) { float v = b[j];
#pragma unroll
            for (int k = 0; k < 4; ++k) v += w[k][j] * xin[i + k][j];
            out[i][j] = siluf_(v); }
}

__device__ __forceinline__ void ssd_dt_acum(LAS float* dtv, LAS float* acu, const float* DT, long r0, int g, const float* dt_bias, const float* a_log, int wid, int lane) {
    const int h = g * 8 + wid; const float bias = dt_bias[h], A = -__expf(a_log[h]); const int t0 = 2 * lane;
    const float d0 = softplusf_(DT[(r0 + t0) * 16 + h] + bias), d1 = softplusf_(DT[(r0 + t0 + 1) * 16 + h] + bias);
    const float a0 = d0 * A, s = a0 + d1 * A; float inc = s;
#pragma unroll
    for (int o = 1; o < 64; o <<= 1) { const float v = __shfl_up(inc, o); if (lane >= o) inc += v; }
    const float exc = inc - s;
    dtv[wid * 128 + t0] = d0; dtv[wid * 128 + t0 + 1] = d1; acu[wid * 128 + t0] = exc + a0; acu[wid * 128 + t0 + 1] = exc + s;
}

struct Frame {
    const float* in[30]; float* out; unsigned char* ws;
    bf16_t *WIN, *WGLU, *WOUT, *WFF1, *WFF2, *XN, *PROJ, *ST, *HID, *BBT, *CM;
    float *SS5, *SSF, *CD, *DT; f32x2 *AB, *AQ, *SE;
};
#define MFMA16(a, b, c) __builtin_amdgcn_mfma_f32_16x16x32_bf16((a), (b), (c), 0, 0, 0)
#define MFMA32(a, b, c) __builtin_amdgcn_mfma_f32_32x32x16_bf16((a), (b), (c), 0, 0, 0)

__device__ __forceinline__ void ssd_states_tile(LAS unsigned char* lds, const Frame& F, int b, int c, int g) {
    const int tid = threadIdx.x, wid = __builtin_amdgcn_readfirstlane(tid >> 6), lane = tid & 63, fr = lane & 15, fq = lane >> 4;
    LAS bf16_t* Bt = (LAS bf16_t*)lds; LAS bf16_t* Xt = (LAS bf16_t*)(lds + 34816);
    LAS float* dtv = (LAS float*)(lds + 52224); LAS float* acu = dtv + 1024;
    const long r0 = (long)b * SEQ + c * 128;
    const float* cw = F.in[19]; const float* cbias = F.in[20];
    ssd_dt_acum(dtv, acu, F.DT, r0, g, F.in[22], F.in[21], wid, lane);
#pragma unroll 1
    for (int q = tid; q < 1024; q += 512) { const int cgp = q & 31, tg = q >> 5, ch = 1024 + g * 128 + cgp * 4; float o[4][4];
        conv4x4(F.PROJ + 2048 + ch, r0 + tg * 4, c == 0 && tg == 0, cw, cbias, ch, o);
#pragma unroll
        for (int j = 0; j < 4; ++j) *(LAS u32x2*)(Bt + (cgp * 4 + j) * XT_P + tg * 4) = (u32x2){pk2(o[0][j], o[1][j]), pk2(o[2][j], o[3][j])}; }
    __syncthreads();
#pragma unroll 1
    for (int hh = 0; hh < 8; ++hh) { const int h = g * 8 + hh; const float a_last = acu[hh * 128 + 127];
        { const int cgp = tid & 15, tg = tid >> 4, ch = h * 64 + cgp * 4; float o[4][4], f[4];
          conv4x4(F.PROJ + 2048 + ch, r0 + tg * 4, c == 0 && tg == 0, cw, cbias, ch, o);
#pragma unroll
          for (int i = 0; i < 4; ++i) f[i] = dtv[hh * 128 + tg * 4 + i] * __expf(a_last - acu[hh * 128 + tg * 4 + i]);
#pragma unroll
          for (int j = 0; j < 4; ++j) *(LAS u32x2*)(Xt + (cgp * 4 + j) * XT_P + tg * 4) = (u32x2){pk2(o[0][j] * f[0], o[1][j] * f[1]), pk2(o[2][j] * f[2], o[3][j] * f[3])}; }
        __syncthreads();
        f32x4 acc[4];
#pragma unroll
        for (int i = 0; i < 4; ++i) acc[i] = (f32x4){0.f, 0.f, 0.f, 0.f};
#pragma unroll
        for (int ks = 0; ks < 4; ++ks) { const bf16x8 bfr = *(const LAS bf16x8*)(Bt + (16 * wid + fr) * XT_P + ks * 32 + fq * 8);
#pragma unroll
            for (int i = 0; i < 4; ++i) { const bf16x8 afr = *(const LAS bf16x8*)(Xt + (16 * i + fr) * XT_P + ks * 32 + fq * 8); acc[i] = MFMA16(bfr, afr, acc[i]); } }
        bf16_t* st = F.ST + ((size_t)((b * 16 + c) * 16 + h) * 64) * 128;
#pragma unroll
        for (int i = 0; i < 4; ++i) *(u32x2*)(st + (size_t)(16 * i + fr) * 128 + 16 * wid + 4 * fq) = (u32x2){pk2(acc[i][0], acc[i][1]), pk2(acc[i][2], acc[i][3])};
        if (tid == 0) F.CD[(b * 16 + c) * 16 + h] = __expf(a_last);
        __syncthreads();
    }
    if (c == NCH - 1) {
        for (int e = tid; e < 3 * 768; e += 512) { const int k = e / 768, ch = g * 768 + e % 768;
            F.out[O_CVP + (size_t)(b * 3 + k) * DCONV + ch] = bf2f(F.PROJ[(size_t)(b * SEQ + SEQ - 3 + k) * PJ + 2048 + ch]); }
    }
}

__device__ __forceinline__ void ssd_y_tile(LAS unsigned char* lds, const Frame& F, int b, int c, int g) {
    const int tid = threadIdx.x, wid = __builtin_amdgcn_readfirstlane(tid >> 6), lane = tid & 63, fr = lane & 15, fq = lane >> 4;
    LAS bf16_t* Bs = (LAS bf16_t*)lds; LAS bf16_t* Ps = Bs; LAS bf16_t* Cs = (LAS bf16_t*)(lds + 34816);
    LAS bf16_t* Xt = (LAS bf16_t*)(lds + 69632); LAS bf16_t* Hs = (LAS bf16_t*)(lds + 87040);
    LAS float* dtv = (LAS float*)(lds + 104448); LAS float* acu = dtv + 1024;
    const long r0 = (long)b * SEQ + c * 128;
    const float* cw = F.in[19]; const float* cbias = F.in[20];
    ssd_dt_acum(dtv, acu, F.DT, r0, g, F.in[22], F.in[21], wid, lane);
#pragma unroll 1
    for (int q = tid; q < 2048; q += 512) { const int qq = q & 1023, cgp = qq & 31, tg = qq >> 5, isC = q >> 10, ch = 1024 + isC * 256 + g * 128 + cgp * 4; float o[4][4];
        conv4x4(F.PROJ + 2048 + ch, r0 + tg * 4, c == 0 && tg == 0, cw, cbias, ch, o);
        LAS bf16_t* dst = isC ? Cs : Bs;
#pragma unroll
        for (int i = 0; i < 4; ++i) *(LAS u32x2*)(dst + (tg * 4 + i) * XT_P + cgp * 4) = (u32x2){pk2(o[i][0], o[i][1]), pk2(o[i][2], o[i][3])}; }
    __syncthreads();
    f32x4 cb[8]; bf16x8 cfr[4];
#pragma unroll
    for (int st = 0; st < 8; ++st) cb[st] = (f32x4){0.f, 0.f, 0.f, 0.f};
#pragma unroll
    for (int ks = 0; ks < 4; ++ks) cfr[ks] = *(const LAS bf16x8*)(Cs + (16 * wid + fr) * XT_P + ks * 32 + fq * 8);
#pragma unroll
    for (int st = 0; st < 8; ++st) if (st <= wid) {
#pragma unroll
        for (int ks = 0; ks < 4; ++ks) { const bf16x8 bfr = *(const LAS bf16x8*)(Bs + (16 * st + fr) * XT_P + ks * 32 + fq * 8); cb[st] = MFMA16(bfr, cfr[ks], cb[st]); } }
    __syncthreads();
    float ss = 0.f; const int l = 16 * wid + fr;
    bf16_t* zrow = F.PROJ + (size_t)(r0 + l) * PJ + 1024 + g * 512 + 4 * fq;
#pragma unroll 1
    for (int hh = 0; hh < 8; ++hh) { const int h = g * 8 + hh;
        { const int cgp = tid & 15, tg = tid >> 4, ch = h * 64 + cgp * 4; float o[4][4], f[4];
          conv4x4(F.PROJ + 2048 + ch, r0 + tg * 4, c == 0 && tg == 0, cw, cbias, ch, o);
#pragma unroll
          for (int i = 0; i < 4; ++i) f[i] = dtv[hh * 128 + tg * 4 + i];
#pragma unroll
          for (int j = 0; j < 4; ++j) *(LAS u32x2*)(Xt + (cgp * 4 + j) * XT_P + tg * 4) = (u32x2){pk2(o[0][j] * f[0], o[1][j] * f[1]), pk2(o[2][j] * f[2], o[3][j] * f[3])}; }
        { const int e = tid * 16, p = e >> 7, n0 = e & 127; const bf16_t* src = F.ST + ((size_t)((b * 16 + c) * 16 + h) * 64 + p) * 128 + n0;
          const u32x4 v0 = *(const u32x4*)src, v1 = *(const u32x4*)(src + 8); *(LAS u32x4*)(Hs + p * XT_P + n0) = v0; *(LAS u32x4*)(Hs + p * XT_P + n0 + 8) = v1; }
        const float al = acu[hh * 128 + l];
#pragma unroll
        for (int st = 0; st < 8; ++st) if (st <= (wid | 1)) { const int s0 = 16 * st + 4 * fq; float v[4];
#pragma unroll
            for (int j = 0; j < 4; ++j) v[j] = (s0 + j <= l) ? cb[st][j] * __expf(al - acu[hh * 128 + s0 + j]) : 0.f;
            *(LAS u32x2*)(Ps + l * XT_P + s0) = (u32x2){pk2(v[0], v[1]), pk2(v[2], v[3])}; }
        __syncthreads();
        f32x4 accY[4], accO[4];
#pragma unroll
        for (int i = 0; i < 4; ++i) { accY[i] = (f32x4){0.f, 0.f, 0.f, 0.f}; accO[i] = (f32x4){0.f, 0.f, 0.f, 0.f}; }
#pragma unroll
        for (int ks = 0; ks < 4; ++ks) {
            if (ks <= (wid >> 1)) { const bf16x8 pfr = *(const LAS bf16x8*)(Ps + l * XT_P + ks * 32 + fq * 8);
#pragma unroll
                for (int pt = 0; pt < 4; ++pt) { const bf16x8 xfr = *(const LAS bf16x8*)(Xt + (16 * pt + fr) * XT_P + ks * 32 + fq * 8); accY[pt] = MFMA16(xfr, pfr, accY[pt]); } }
#pragma unroll
            for (int pt = 0; pt < 4; ++pt) { const bf16x8 hfr = *(const LAS bf16x8*)(Hs + (16 * pt + fr) * XT_P + ks * 32 + fq * 8); accO[pt] = MFMA16(hfr, cfr[ks], accO[pt]); } }
        const float el = __expf(al), rdt = 1.0f / dtv[hh * 128 + l], Dh = F.in[23][h];
#pragma unroll
        for (int pt = 0; pt < 4; ++pt) { bf16_t* zp = zrow + hh * 64 + 16 * pt; const u32x2 zw = *(const u32x2*)zp;
            const float z[4] = {bflo(zw.x), bfhi(zw.x), bflo(zw.y), bfhi(zw.y)}; float y[4];
#pragma unroll
            for (int j = 0; j < 4; ++j) { const float xs = bf2f(Xt[(16 * pt + 4 * fq + j) * XT_P + l]) * rdt; y[j] = (accY[pt][j] + el * accO[pt][j] + Dh * xs) * siluf_(z[j]); ss += y[j] * y[j]; }
            *(u32x2*)zp = (u32x2){pk2(y[0], y[1]), pk2(y[2], y[3])}; }
        __syncthreads();
    }
    ss += __shfl_xor(ss, 16); ss += __shfl_xor(ss, 32);
    const float rs = rs_from_ss(ss, 512.f);
    asm volatile("s_waitcnt vmcnt(0)" ::: "memory");
#pragma unroll 4
    for (int i = 0; i < 32; ++i) { bf16_t* zp = zrow + 16 * i; const u32x2 w = *(const u32x2*)zp;
        *(u32x2*)zp = (u32x2){pk2(bflo(w.x) * rs, bfhi(w.x) * rs), pk2(bflo(w.y) * rs, bfhi(w.y) * rs)}; }
}

template <bool MODEB>
__device__ __forceinline__ void s5_chunk_job(LAS unsigned char* wl, const Frame& F, int b, int g, int c, int lane) {
    const long r0 = (long)b * SEQ + c * 128;
    bf16x8 bfr[4];
#pragma unroll
    for (int j = 0; j < 4; ++j) bfr[j] = *(const bf16x8*)(F.BBT + (size_t)(g * 128 + j * 32 + (lane & 31)) * 16 + (lane >> 5) * 8);
    const f32x2 a = F.AB[g * 64 + lane];
    f32x2* sep = F.SE + ((size_t)(b * 64 + g) * 16 + c) * 64 + lane;
    float hr = 0.f, hi = 0.f;
    bf16x8 cfr[4]; f32x4 d4 = (f32x4){0.f, 0.f, 0.f, 0.f};
    if constexpr (MODEB) { const f32x2 h0 = *sep; hr = h0.x; hi = h0.y;
#pragma unroll
        for (int ks = 0; ks < 4; ++ks) cfr[ks] = *(const bf16x8*)(F.CM + (size_t)(g * 16 + (lane & 15)) * 128 + ks * 32 + (lane >> 4) * 8);
        d4 = *(const f32x4*)(F.in[15] + g * 16 + 4 * (lane >> 4)); }
#pragma unroll 1
    for (int rt = 0; rt < 4; ++rt) {
        const bf16x8 afr = *(const bf16x8*)(F.PROJ + (size_t)(r0 + rt * 32 + (lane & 31)) * PJ + g * 16 + (lane >> 5) * 8);
#pragma unroll
        for (int j = 0; j < 4; ++j) { f32x16 acc;
#pragma unroll
            for (int r = 0; r < 16; ++r) acc[r] = 0.f;
            acc = MFMA32(afr, bfr[j], acc);
#pragma unroll
            for (int r = 0; r < 16; ++r) *(LAS float*)(wl + ((r & 3) + 8 * (r >> 2) + 4 * (lane >> 5)) * 528 + (j * 32 + (lane & 31)) * 4) = acc[r]; }
#pragma unroll 8
        for (int t = 0; t < 32; ++t) { const f32x2 bu = *(const LAS f32x2*)(wl + t * 528 + lane * 8);
            const float nr = a.x * hr - a.y * hi + bu.x, ni = a.x * hi + a.y * hr + bu.y; hr = nr; hi = ni;
            if constexpr (MODEB) *(LAS unsigned*)(wl + t * 528 + lane * 4) = pk2(hr, hi); }
        if constexpr (MODEB) {
#pragma unroll
            for (int half = 0; half < 2; ++half) { f32x4 accy = (f32x4){0.f, 0.f, 0.f, 0.f};
#pragma unroll
                for (int ks = 0; ks < 4; ++ks) { const bf16x8 hfr = *(const LAS bf16x8*)(wl + (half * 16 + (lane & 15)) * 528 + (ks * 32 + (lane >> 4) * 8) * 2); accy = MFMA16(cfr[ks], hfr, accy); }
                const size_t row = (size_t)(r0 + rt * 32 + half * 16 + (lane & 15));
                const u32x2 uw = *(const u32x2*)(F.PROJ + row * PJ + g * 16 + 4 * (lane >> 4));
                const float y0 = gelu_tanh(accy[0] + d4[0] * bflo(uw.x)), y1 = gelu_tanh(accy[1] + d4[1] * bfhi(uw.x)), y2 = gelu_tanh(accy[2] + d4[2] * bflo(uw.y)), y3 = gelu_tanh(accy[3] + d4[3] * bfhi(uw.y));
                *(u32x2*)(F.XN + row * DM + g * 16 + 4 * (lane >> 4)) = (u32x2){pk2(y0, y1), pk2(y2, y3)}; }
        }
    }
    if constexpr (!MODEB) *sep = (f32x2){hr, hi};
}

__device__ __forceinline__ void s5_sample_job(const Frame& F, int bs, int g, int lane) {
    const size_t row = (size_t)MP + bs;
    const bf16_t* up = F.PROJ + row * PJ + g * 16;
    const u32x4 u0 = *(const u32x4*)up, u1 = *(const u32x4*)(up + 8);
    const float u[16] = {bflo(u0.x), bfhi(u0.x), bflo(u0.y), bfhi(u0.y), bflo(u0.z), bfhi(u0.z), bflo(u0.w), bfhi(u0.w), bflo(u1.x), bfhi(u1.x), bflo(u1.y), bfhi(u1.y), bflo(u1.z), bfhi(u1.z), bflo(u1.w), bfhi(u1.w)};
    const bf16_t* bp = F.BBT + (size_t)(g * 128 + 2 * lane) * 16;
    float bre = 0.f, bim = 0.f;
#pragma unroll
    for (int q = 0; q < 2; ++q) { const u32x4 wr_ = *(const u32x4*)(bp + q * 8), wi_ = *(const u32x4*)(bp + 16 + q * 8);
        bre += bflo(wr_.x) * u[q * 8 + 0] + bfhi(wr_.x) * u[q * 8 + 1] + bflo(wr_.y) * u[q * 8 + 2] + bfhi(wr_.y) * u[q * 8 + 3] + bflo(wr_.z) * u[q * 8 + 4] + bfhi(wr_.z) * u[q * 8 + 5] + bflo(wr_.w) * u[q * 8 + 6] + bfhi(wr_.w) * u[q * 8 + 7];
        bim += bflo(wi_.x) * u[q * 8 + 0] + bfhi(wi_.x) * u[q * 8 + 1] + bflo(wi_.y) * u[q * 8 + 2] + bfhi(wi_.y) * u[q * 8 + 3] + bflo(wi_.z) * u[q * 8 + 4] + bfhi(wi_.z) * u[q * 8 + 5] + bflo(wi_.w) * u[q * 8 + 6] + bfhi(wi_.w) * u[q * 8 + 7]; }
    const size_t si = (size_t)(bs * 64 + g) * 64 + lane;
    const float h0r = F.in[2][si], h0i = F.in[3][si]; const f32x2 a = F.AB[g * 64 + lane];
    const float hr = a.x * h0r - a.y * h0i + bre, hi = a.x * h0i + a.y * h0r + bim;
    F.out[O_S5RS + si] = hr; F.out[O_S5IS + si] = hi;
    float yv = 0.f;
#pragma unroll
    for (int c = 0; c < 16; ++c) { const unsigned cm = *(const unsigned*)(F.CM + (size_t)(g * 16 + c) * 128 + 2 * lane); const float tot = wave_sum(bflo(cm) * hr + bfhi(cm) * hi); if (lane == c) yv = tot; }
    if (lane < 16) { const float y = gelu_tanh(yv + F.in[15][g * 16 + lane] * bf2f(up[lane])); F.XN[row * DM + g * 16 + lane] = (bf16_t)(pk2(y, 0.f) & 0xffffu); }
}

__device__ __forceinline__ float conv1_sample(const Frame& F, int bs, int ch, bool write_state) {
    const float* sc = F.in[5] + (size_t)bs * 3 * DCONV + ch;
    const float x0 = sc[0], x1 = sc[DCONV], x2 = sc[2 * DCONV], x3 = bf2f(F.PROJ[((size_t)MP + bs) * PJ + 2048 + ch]);
    const float* cw = F.in[19] + ch;
    const float v = F.in[20][ch] + cw[0] * x0 + cw[DCONV] * x1 + cw[2 * DCONV] * x2 + cw[3 * DCONV] * x3;
    if (write_state) { float* o = F.out + O_CVS + (size_t)bs * 3 * DCONV + ch; o[0] = x1; o[DCONV] = x2; o[2 * DCONV] = x3; }
    return siluf_(v);
}
__device__ __forceinline__ void ssd_sample_job(LAS unsigned char* lds, const Frame& F, int bs, int g) {
    const int tid = threadIdx.x, wid = __builtin_amdgcn_readfirstlane(tid >> 6), lane = tid & 63, h = g * 8 + wid;
    LAS float* red = (LAS float*)lds;
    const size_t row = (size_t)MP + bs;
    const float xs = conv1_sample(F, bs, h * 64 + lane, true);
    const float B0 = conv1_sample(F, bs, 1024 + g * 128 + 2 * lane, wid == 0), B1 = conv1_sample(F, bs, 1024 + g * 128 + 2 * lane + 1, wid == 0);
    const float C0 = conv1_sample(F, bs, 1280 + g * 128 + 2 * lane, wid == 0), C1 = conv1_sample(F, bs, 1280 + g * 128 + 2 * lane + 1, wid == 0);
    const float dt = softplusf_(F.DT[row * 16 + h] + F.in[22][h]), dA = __expf(-dt * __expf(F.in[21][h]));
    const float* sp = F.in[4] + ((size_t)(bs * 16 + h) * 64) * 128 + 2 * lane;
    float* op = F.out + O_SSDS + ((size_t)(bs * 16 + h) * 64) * 128 + 2 * lane;
    float y = 0.f;
#pragma unroll 8
    for (int p = 0; p < 64; ++p) { const float xp = __shfl(xs, p) * dt; const f32x2 h0 = *(const f32x2*)(sp + p * 128);
        const f32x2 hn = (f32x2){dA * h0.x + xp * B0, dA * h0.y + xp * B1}; *(f32x2*)(op + p * 128) = hn;
        const float tot = wave_sum(C0 * hn.x + C1 * hn.y); if (lane == p) y = tot; }
    bf16_t* zp = F.PROJ + row * PJ + 1024 + h * 64 + lane;
    y = (y + F.in[23][h] * xs) * siluf_(bf2f(*zp));
    const float ssw = wave_sum(y * y);
    if (lane == 0) red[wid] = ssw;
    __syncthreads();
    float tot = 0.f;
#pragma unroll
    for (int w = 0; w < 8; ++w) tot += red[w];
    *zp = (bf16_t)(pk2(y * rs_from_ss(tot, 512.f), 0.f) & 0xffffu);
    __syncthreads();
}

__global__ void __launch_bounds__(512, 2) hymba_fwd(Args args) {
    extern __shared__ __attribute__((aligned(16))) unsigned char lds_raw[];
    LAS unsigned char* lds = (LAS unsigned char*)lds_raw;
    cg::grid_group grid = cg::this_grid();
    Frame F;
#pragma unroll
    for (int i = 0; i < 30; ++i) F.in[i] = args.in[i];
    F.out = args.out; F.ws = args.ws;
    unsigned char* ws = args.ws;
    F.WIN = (bf16_t*)(ws + WS_WIN); F.WGLU = (bf16_t*)(ws + WS_WGLU); F.WOUT = (bf16_t*)(ws + WS_WOUT); F.WFF1 = (bf16_t*)(ws + WS_WFF1); F.WFF2 = (bf16_t*)(ws + WS_WFF2);
    F.XN = (bf16_t*)(ws + WS_XN); F.PROJ = (bf16_t*)(ws + WS_PROJ); F.ST = (bf16_t*)(ws + WS_ST); F.HID = (bf16_t*)(ws + WS_HID);
    F.BBT = (bf16_t*)(ws + WS_BBT); F.CM = (bf16_t*)(ws + WS_CM);
    F.SS5 = (float*)(ws + WS_SS5); F.SSF = (float*)(ws + WS_SSF); F.CD = (float*)(ws + WS_CD); F.DT = (float*)(ws + WS_DT);
    F.AB = (f32x2*)(ws + WS_AB); F.AQ = (f32x2*)(ws + WS_AQ); F.SE = (f32x2*)(ws + WS_SE);
    const int tid = threadIdx.x, wid = __builtin_amdgcn_readfirstlane(tid >> 6), lane = tid & 63;
    const int G = gridDim.x, gt = blockIdx.x * 512 + tid, GT = G * 512, gw = blockIdx.x * 8 + wid, NGW = G * 8;
    const int lo = args.ph_lo, hi = args.ph_hi;
#define IN(k) (lo <= (k) && (k) < hi)
#define SEAM(k) do { if (IN(k) && IN((k) + 1)) grid.sync(); } while (0)

    if (IN(0)) {
        for (int i = gt; i < TT; i += GT) { F.SS5[i] = 0.f; F.SSF[i] = 0.f; }
        LAS float* scr = (LAS float*)(lds + wid * 8448);
        constexpr int I_IN = 16 * (N1 / 32), I_GLU = 16 * 32, I_OUT = 32 * 32, I_FF1 = 16 * 128, I_FF2 = 64 * 32, I_ALL = I_IN + I_GLU + I_OUT + I_FF1 + I_FF2;
        for (int it = gw; it < I_ALL; it += NGW) { int r = it;
            if (r < I_IN) { p0_transpose_item(F.in[7], 1024, N1V, N1, F.WIN, nullptr, scr, r, lane); continue; } r -= I_IN;
            if (r < I_GLU) { p0_transpose_item(F.in[16], 1024, 1024, 1024, F.WGLU, nullptr, scr, r, lane); continue; } r -= I_GLU;
            if (r < I_OUT) { const int k0 = 64 * (r / 32); p0_transpose_item(F.in[25], 2048, 1024, 1024, F.WOUT, k0 < 1024 ? F.in[18] : F.in[24] - 1024, scr, r, lane); continue; } r -= I_OUT;
            if (r < I_FF1) { p0_transpose_item(F.in[27], 1024, 4096, 4096, F.WFF1, F.in[26], scr, r, lane); continue; } r -= I_FF1;
            p0_transpose_item(F.in[28], 4096, 1024, 1024, F.WFF2, nullptr, scr, r, lane);
        }
        for (int m = gw; m < TT; m += NGW) { const float* src = m < MP ? F.in[0] + (size_t)m * DM : F.in[1] + (size_t)(m - MP) * DM;
            f32x4 v[4]; float s = 0.f;
#pragma unroll
            for (int j = 0; j < 4; ++j) { v[j] = *(const f32x4*)(src + 4 * lane + 256 * j); s += (v[j][0] * v[j][0] + v[j][1] * v[j][1]) + (v[j][2] * v[j][2] + v[j][3] * v[j][3]); }
            const float rs = rs_from_ss(wave_sum(s), 1024.f);
#pragma unroll
            for (int j = 0; j < 4; ++j) { const f32x4 gn = *(const f32x4*)(F.in[6] + 4 * lane + 256 * j);
                *(u32x2*)(F.XN + (size_t)m * DM + 4 * lane + 256 * j) = (u32x2){pk2(v[j][0] * rs * gn[0], v[j][1] * rs * gn[1]), pk2(v[j][2] * rs * gn[2], v[j][3] * rs * gn[3])}; } }
        for (int idx = gt; idx < 4096; idx += GT) { const int g = idx >> 6, p = idx & 63;
            const float dt = expf(F.in[10][g]), lr = F.in[8][idx], li = F.in[9][idx];
            const float mag = expf(lr * dt), ang = li * dt; float abr = mag * cosf(ang), abi = mag * sinf(ang);
            const float den = lr * lr + li * li, nr = abr - 1.f, ni = abi, fre = (nr * lr + ni * li) / den, fim = (ni * lr - nr * li) / den;
            F.AB[idx] = (f32x2){abr, abi};
            float qr = abr, qi = abi;
#pragma unroll
            for (int k = 0; k < 7; ++k) { const float tr = qr * qr - qi * qi, ti = 2.f * qr * qi; qr = tr; qi = ti; }
            F.AQ[idx] = (f32x2){qr, qi};
#pragma unroll 4
            for (int c = 0; c < 16; ++c) { const float br = F.in[11][(size_t)idx * 16 + c], bi = F.in[12][(size_t)idx * 16 + c];
                F.BBT[(size_t)(g * 128 + 2 * p) * 16 + c] = (bf16_t)(pk2(fre * br - fim * bi, 0.f) & 0xffffu); F.BBT[(size_t)(g * 128 + 2 * p + 1) * 16 + c] = (bf16_t)(pk2(fre * bi + fim * br, 0.f) & 0xffffu);
                const float cr = F.in[13][(size_t)(g * 16 + c) * 64 + p], ci = F.in[14][(size_t)(g * 16 + c) * 64 + p];
                *(unsigned*)(F.CM + (size_t)(g * 16 + c) * 128 + 2 * p) = pk2(cr, -ci); } }
    }
    SEAM(0);

    if (IN(1)) {
        pg8::Gemm gm{F.XN, F.WIN, DM, DM, DM}; pg8::StaticOrder S; S.init(MP, N1, G, (int)blockIdx.x);
        EpiProj E{F.PROJ, F.DT};
        pg8::gemm_phase<EpiProj, pg8::StaticOrder, true, true>(lds, gm, S, E);
        bf16_t* P = F.PROJ; float* DTp = F.DT;
        skinny_gemm(lds, F.XN + (size_t)MP * DM, DM, F.WIN, DM, DM, 113, [=](int row, int col, float lo0, float hi0, float lo1, float hi1) {
            const float v0 = lo0 + hi0, v1 = lo1 + hi1; const size_t r = (size_t)MP + row;
            if (col < PJ) *(unsigned*)(P + r * PJ + col) = pk2(v0, v1); else if (col < N1V) { DTp[r * 16 + col - PJ] = v0; DTp[r * 16 + col - PJ + 1] = v1; } });
    }
    SEAM(1);

    if (IN(2)) {
        for (int tile = blockIdx.x; tile < NB * NCH * 2; tile += G) ssd_states_tile(lds, F, tile >> 5, (tile >> 1) & 15, tile & 1);
        __syncthreads();
        for (int job = gw; job < NB * NCH * 64; job += NGW) s5_chunk_job<false>(lds + wid * 16896, F, job >> 10, job & 63, (job >> 6) & 15, lane);
        __syncthreads();
        for (int j = blockIdx.x; j < NSAMP * 2; j += G) ssd_sample_job(lds, F, j >> 1, j & 1);
        for (int job = gw; job < NSAMP * 64; job += NGW) s5_sample_job(F, job >> 6, job & 63, lane);
    }
    SEAM(2);

    if (IN(3)) {
        for (int idx = gt; idx < NB * 16 * 64 * 16; idx += GT) { const int n8 = idx & 15, p = (idx >> 4) & 63, h = (idx >> 10) & 15, b = idx >> 14;
            bf16_t* base = F.ST + ((size_t)(b * 16 * 16 + h) * 64 + p) * 128 + n8 * 8; const size_t cstep = (size_t)16 * 64 * 128;
            u32x4 v[NCH];
#pragma unroll
            for (int c = 0; c < NCH; ++c) v[c] = *(const u32x4*)(base + c * cstep);
            float hs[8];
#pragma unroll
            for (int i = 0; i < 8; ++i) hs[i] = 0.f;
#pragma unroll
            for (int c = 0; c < NCH; ++c) { const float cd = F.CD[(b * 16 + c) * 16 + h];
                *(u32x4*)(base + c * cstep) = (u32x4){pk2(hs[0], hs[1]), pk2(hs[2], hs[3]), pk2(hs[4], hs[5]), pk2(hs[6], hs[7])};
                hs[0] = cd * hs[0] + bflo(v[c].x); hs[1] = cd * hs[1] + bfhi(v[c].x); hs[2] = cd * hs[2] + bflo(v[c].y); hs[3] = cd * hs[3] + bfhi(v[c].y);
                hs[4] = cd * hs[4] + bflo(v[c].z); hs[5] = cd * hs[5] + bfhi(v[c].z); hs[6] = cd * hs[6] + bflo(v[c].w); hs[7] = cd * hs[7] + bfhi(v[c].w); }
            float* o = F.out + O_SSDP + ((size_t)(b * 16 + h) * 64 + p) * 128 + n8 * 8;
            *(f32x4*)o = (f32x4){hs[0], hs[1], hs[2], hs[3]}; *(f32x4*)(o + 4) = (f32x4){hs[4], hs[5], hs[6], hs[7]}; }
        for (int idx = gt; idx < NB * 64 * 64; idx += GT) { const int p = idx & 63, bg = idx >> 6, g = bg & 63;
            const f32x2 aq = F.AQ[g * 64 + p]; f32x2* sp = F.SE + (size_t)bg * 16 * 64 + p; float hr = 0.f, hi_ = 0.f;
#pragma unroll 4
            for (int c = 0; c < NCH; ++c) { const f32x2 t = sp[c * 64]; sp[c * 64] = (f32x2){hr, hi_}; const float nr = aq.x * hr - aq.y * hi_ + t.x, ni = aq.x * hi_ + aq.y * hr + t.y; hr = nr; hi_ = ni; }
            F.out[O_S5RP + idx] = hr; F.out[O_S5IP + idx] = hi_; }
    }
    SEAM(3);

    if (IN(4)) {
        for (int tile = blockIdx.x; tile < NB * NCH * 2; tile += G) ssd_y_tile(lds, F, tile >> 5, (tile >> 1) & 15, tile & 1);
        __syncthreads();
        for (int job = gw; job < NB * NCH * 64; job += NGW) s5_chunk_job<true>(lds + wid * 16896, F, job >> 10, job & 63, (job >> 6) & 15, lane);
        __syncthreads();
    }
    SEAM(4);

    if (IN(5)) {
        pg8::Gemm gm{F.XN, F.WGLU, DM, DM, DM}; pg8::StaticOrder S; S.init(MP, DM, G, (int)blockIdx.x);
        EpiGlu E{F.XN, F.PROJ, F.in[17], F.SS5};
        pg8::gemm_phase<EpiGlu, pg8::StaticOrder, false, true>(lds, gm, S, E);
        const bf16_t* Gp = F.XN; bf16_t* P = F.PROJ; const float* bias = F.in[17]; float* SS = F.SS5;
        skinny_gemm(lds, F.XN + (size_t)MP * DM, DM, F.WGLU, DM, DM, 32, [=](int row, int col, float lo0, float hi0, float lo1, float hi1) {
            const size_t r = (size_t)MP + row; const unsigned gw_ = *(const unsigned*)(Gp + r * DM + col);
            const float o0 = bflo(gw_) * sigmoidf_(lo0 + hi0 + bias[col]), o1 = bfhi(gw_) * sigmoidf_(lo1 + hi1 + bias[col + 1]);
            *(unsigned*)(P + r * PJ + col) = pk2(o0, o1);
            const float ss = red16(o0 * o0 + o1 * o1); if ((threadIdx.x & 15) == 0) atomicAdd(SS + r, ss); });
    }
    SEAM(5);

    if (IN(6)) {
        pg8::Gemm gm{F.PROJ, F.WOUT, PJ, 2048, 2048}; pg8::StaticOrder S; S.init(MP, DM, G, (int)blockIdx.x);
        EpiOut E{F.in[0], F.out, F.XN, F.SSF, F.SS5};
        pg8::gemm_phase<EpiOut, pg8::StaticOrder, false, true>(lds, gm, S, E);
        const float* xs = F.in[1]; float* X1 = F.out; bf16_t* X1B = F.XN; float* SSF = F.SSF; const float* SS5 = F.SS5;
        skinny_gemm(lds, F.PROJ + (size_t)MP * PJ, PJ, F.WOUT, 2048, 2048, 32, [=](int row, int col, float lo0, float hi0, float lo1, float hi1) {
            const size_t r = (size_t)MP + row; const float s = rs_from_ss(SS5[r], 1024.f);
            const float v0 = xs[(size_t)row * DM + col] + lo0 * s + hi0, v1 = xs[(size_t)row * DM + col + 1] + lo1 * s + hi1;
            X1[r * DM + col] = v0; X1[r * DM + col + 1] = v1; *(unsigned*)(X1B + r * DM + col) = pk2(v0, v1);
            const float ss = red16(v0 * v0 + v1 * v1); if ((threadIdx.x & 15) == 0) atomicAdd(SSF + r, ss); });
    }
    SEAM(6);

    if (IN(7)) {
        pg8::Gemm gm{F.XN, F.WFF1, DM, DM, DM}; pg8::StaticOrder S; S.init(MP, DFF, G, (int)blockIdx.x);
        EpiFF1 E{F.HID, F.SSF};
        pg8::gemm_phase<EpiFF1, pg8::StaticOrder, true, true>(lds, gm, S, E);
        bf16_t* H = F.HID; const float* SSF = F.SSF;
        skinny_gemm(lds, F.XN + (size_t)MP * DM, DM, F.WFF1, DM, DM, 128, [=](int row, int col, float lo0, float hi0, float lo1, float hi1) {
            const size_t r = (size_t)MP + row; const float s = rs_from_ss(SSF[r], 1024.f);
            const float a = fmaxf((lo0 + hi0) * s, 0.f), b = fmaxf((lo1 + hi1) * s, 0.f); *(unsigned*)(H + r * DFF + col) = pk2(a * a, b * b); });
    }
    SEAM(7);

    if (IN(8)) {
        pg8::Gemm gm{F.HID, F.WFF2, DFF, DFF, DFF}; pg8::StaticOrder S; S.init(MP, DM, G, (int)blockIdx.x);
        EpiFF2 E{F.out};
        pg8::gemm_phase<EpiFF2, pg8::StaticOrder, false, true>(lds, gm, S, E);
        float* X1 = F.out;
        skinny_gemm(lds, F.HID + (size_t)MP * DFF, DFF, F.WFF2, DFF, DFF, 32, [=](int row, int col, float lo0, float hi0, float lo1, float hi1) {
            const size_t r = (size_t)MP + row; X1[r * DM + col] += lo0 + hi0; X1[r * DM + col + 1] += lo1 + hi1; });
    }
    SEAM(8);

    if (IN(9)) {
        for (int m = gw; m < TT; m += NGW) { float* src = F.out + (size_t)m * DM;
            f32x4 v[4]; float s = 0.f;
#pragma unroll
            for (int j = 0; j < 4; ++j) { v[j] = *(const f32x4*)(src + 4 * lane + 256 * j); s += (v[j][0] * v[j][0] + v[j][1] * v[j][1]) + (v[j][2] * v[j][2] + v[j][3] * v[j][3]); }
            const float rs = rs_from_ss(wave_sum(s), 1024.f);
#pragma unroll
            for (int j = 0; j < 4; ++j) { const f32x4 gn = *(const f32x4*)(F.in[29] + 4 * lane + 256 * j); *(f32x4*)(src + 4 * lane + 256 * j) = v[j] * rs * gn; } }
    }
#undef IN
#undef SEAM
}

#ifndef N_LAUNCHES
#define N_LAUNCHES 1
#endif
extern "C" void kernel_launch(void* const* d_in, const int* in_sizes, int n_in, void* d_out, int out_size, void* d_ws, size_t ws_size, hipStream_t stream) {
    static int grid = 0;
    if (grid == 0) {
        if (n_in != 30 || (size_t)out_size != O_END || ws_size < WS_END) { fprintf(stderr, "kernel_launch: unexpected shapes: n_in %d out_size %d ws %zu\n", n_in, out_size, ws_size); grid = -1; return; }
        int dev = 0, cus = 0, per_cu = 0;
        (void)hipGetDevice(&dev); (void)hipDeviceGetAttribute(&cus, hipDeviceAttributeMultiprocessorCount, dev);
        if (hipFuncSetAttribute((const void*)hymba_fwd, hipFuncAttributeMaxDynamicSharedMemorySize, LDS_BYTES) != hipSuccess) { fprintf(stderr, "kernel_launch: hipFuncSetAttribute failed\n"); grid = -1; return; }
        if (hipOccupancyMaxActiveBlocksPerMultiprocessor(&per_cu, (const void*)hymba_fwd, 512, LDS_BYTES) != hipSuccess || per_cu < 1) { fprintf(stderr, "kernel_launch: occupancy query says %d\n", per_cu); per_cu = 1; }
        (void)hipGetLastError();
        grid = cus * per_cu;
    }
    if (grid < 0) return;
    Args a{};
    for (int i = 0; i < 30; ++i) a.in[i] = (const float*)d_in[i];
    a.out = (float*)d_out; a.ws = (unsigned char*)d_ws;
    constexpr int NPH = 10;
    for (int li = 0; li < N_LAUNCHES; ++li) {
        a.ph_lo = (N_LAUNCHES == 1) ? 0 : li; a.ph_hi = (N_LAUNCHES == 1) ? NPH : li + 1;
        void* kargs[] = {&a};
        const hipError_t e = hipLaunchCooperativeKernel((const void*)hymba_fwd, dim3(grid), dim3(512), kargs, LDS_BYTES, stream);
        if (e != hipSuccess) { fprintf(stderr, "kernel_launch: cooperative launch %d failed: %s (grid %d)\n", li, hipGetErrorString(e), grid); break; }
    }
}
```

```cpp
#include <hip/hip_runtime.h>
#include <hip/hip_cooperative_groups.h>
#include <cstdio>
#include <cstdint>
namespace cg = cooperative_groups;

namespace pg8 {
#define PG8_LAS __attribute__((address_space(3)))
typedef unsigned short bf16_t;
typedef short bf16x8 __attribute__((ext_vector_type(8)));
typedef float f32x4 __attribute__((ext_vector_type(4)));
typedef unsigned u32x4 __attribute__((ext_vector_type(4)));
typedef unsigned u32x2 __attribute__((ext_vector_type(2)));
constexpr int BM = 256, BK = 64, HALF = 128, HTB = HALF * BK * 2  , STAGE_BYTES = 8 * HTB, NXCD = 8, WGM = 8;

__host__ __device__ __forceinline__ int lds_byte(int r, int c) { const int st = (r >> 4) * 2 + (c >> 5), rr = r & 15, cc = c & 31, ob = rr * 64 + cc * 2; return st * 1024 + (ob ^ (((ob >> 9) & 1) << 5)); }
__host__ __device__ __forceinline__ void stage_rc(int b, int& R, int& C) { const int st = b / 1024, sb = b % 1024, swz = sb ^ (((sb >> 9) & 1) << 5); R = (st >> 1) * 16 + swz / 64; C = (st & 1) * 32 + (swz % 64) / 2; }
__host__ __device__ __forceinline__ int perm32(int rho) { const int n = rho >> 4, i = rho & 15; return 8 * (i >> 2) + 4 * n + (i & 3); }

struct Unit { int pm, pn; };
struct Gemm { const bf16_t* A; const bf16_t* Bt; int lda, ldb, K; };

struct StaticOrder {
    int nM, nN, nwg, G, c;
    __host__ __device__ void init(int M, int N, int G_, int c_) { nM = M / BM; nN = N / BM; nwg = nM * nN; G = G_; c = c_; }
    __host__ __device__ bool next(int i, Unit& u) const {
        const long L = (long)i * G + c; if (L >= nwg) return false;
        int wgid = (int)L; { const int q = nwg / NXCD, r = nwg % NXCD, xcd = wgid % NXCD, off = wgid / NXCD; wgid = (xcd < r ? xcd * (q + 1) : r * (q + 1) + (xcd - r) * q) + off; }
        const int nig = WGM * nN, gid = wgid / nig, fm = gid * WGM, gsz = (nM - fm) < WGM ? (nM - fm) : WGM;
        u.pm = fm + ((wgid % nig) % gsz); u.pn = (wgid % nig) / gsz; return true;
    }
};

__device__ __forceinline__ unsigned cvt_pk_bf16(float lo, float hi) { unsigned r; asm volatile("v_cvt_pk_bf16_f32 %0, %1, %2" : "=v"(r) : "v"(lo), "v"(hi)); return r; }

template <class Epi, class Sched, bool ALIGN_EPI = false, bool SP2 = false>
__device__ __forceinline__ void gemm_phase(PG8_LAS unsigned char* lds, const Gemm g, const Sched& S, const Epi& E) {
    const int tid = threadIdx.x, wid = __builtin_amdgcn_readfirstlane(tid >> 6), lane = tid & 63, wr = wid >> 2, wc = wid & 3, fr = lane & 15, fq = lane >> 4;
    const int K = g.K, nt = K / BK;
    unsigned voffA[2], voffB[2];
#pragma unroll
    for (int i = 0; i < 2; ++i) { int R, C; stage_rc(tid * 16 + i * 8192, R, C); const int Rb = Epi::PERM ? ((R & ~31) + perm32(R & 31)) : R;
        voffA[i] = (unsigned)(R * g.lda + C) * 2u; voffB[i] = (unsigned)(Rb * g.ldb + C) * 2u; }
    const size_t kstep = (size_t)(BK * 2);
    const size_t hstepA = (size_t)HALF * g.lda * 2, hstepB = (size_t)HALF * g.ldb * 2;
    const size_t tstepA = 2 * hstepA, tstepB = 2 * hstepB;
    const unsigned ldsw = (unsigned)wid * 1024u;
    const int aoff = lds_byte(wr * 64 + fr, fq * 8), boff = lds_byte(wc * 32 + fr, fq * 8);
#define PG8_SA(b, h) (((b) * 2 + (h)) * HTB)
#define PG8_SB(b, h) ((4 + (b) * 2 + (h)) * HTB)
#define PG8_STAGE(bufoff, gbase, voff) do { _Pragma("unroll") for (int _i = 0; _i < 2; ++_i) \
        __builtin_amdgcn_global_load_lds((const unsigned*)((const char*)(gbase) + (voff)[_i]), (PG8_LAS unsigned*)(lds + (bufoff) + ldsw + _i * 8192), 16, 0, 0); } while (0)
#define PG8_LDA(dst, b, h) do { _Pragma("unroll") for (int m = 0; m < 4; ++m) _Pragma("unroll") for (int k = 0; k < 2; ++k) dst[m][k] = *(const PG8_LAS bf16x8*)(lds + PG8_SA(b, h) + aoff + m * 2048 + k * 1024); } while (0)
#define PG8_LDB(dst, b, h) do { _Pragma("unroll") for (int n = 0; n < 2; ++n) _Pragma("unroll") for (int k = 0; k < 2; ++k) dst[n][k] = *(const PG8_LAS bf16x8*)(lds + PG8_SB(b, h) + boff + n * 2048 + k * 1024); } while (0)
#define PG8_MMA(ai, bj, At, Bt) do { __builtin_amdgcn_s_setprio(1); _Pragma("unroll") for (int m = 0; m < 4; ++m) _Pragma("unroll") for (int n = 0; n < 2; ++n) _Pragma("unroll") for (int k = 0; k < 2; ++k) \
        acc[ai][bj][m][n] = __builtin_amdgcn_mfma_f32_16x16x32_bf16(Bt[n][k], At[m][k], acc[ai][bj][m][n], 0, 0, 0); __builtin_amdgcn_s_setprio(0); } while (0)
#define PG8_WAIT_V(n) asm volatile("s_waitcnt vmcnt(" #n ")" ::: "memory")
#define PG8_WAIT_L(n) asm volatile("s_waitcnt lgkmcnt(" #n ")" ::: "memory")
#define PG8_BAR __builtin_amdgcn_s_barrier()
#define PG8_SCHED __builtin_amdgcn_sched_barrier(0)
    Unit cur, nxt; int ui = 0;
    if (!S.next(0, cur)) return;
    f32x4 acc[2][2][4][2];
#pragma unroll
    for (int a = 0; a < 2; ++a)
#pragma unroll
        for (int b = 0; b < 2; ++b)
#pragma unroll
            for (int m = 0; m < 4; ++m)
#pragma unroll
                for (int n = 0; n < 2; ++n) acc[a][b][m][n] = (f32x4){0.f, 0.f, 0.f, 0.f};
    bf16x8 At[4][2], B0[2][2], B1[2][2];
    const char* cA = (const char*)g.A + (size_t)cur.pm * tstepA; const char* cB = (const char*)g.Bt + (size_t)cur.pn * tstepB;
    if constexpr (SP2) {
        PG8_STAGE(PG8_SB(0, 0), cB, voffB); PG8_STAGE(PG8_SB(0, 1), cB + hstepB, voffB); PG8_STAGE(PG8_SA(0, 0), cA, voffA); PG8_STAGE(PG8_SA(0, 1), cA + hstepA, voffA);
        if (wr == 1) PG8_BAR;
        PG8_WAIT_V(2); PG8_BAR;
        PG8_STAGE(PG8_SB(1, 0), cB + kstep, voffB); PG8_STAGE(PG8_SA(1, 0), cA + kstep, voffA); PG8_STAGE(PG8_SB(1, 1), cB + hstepB + kstep, voffB);
        PG8_WAIT_V(6); PG8_BAR;
    } else {
        PG8_STAGE(PG8_SB(0, 0), cB, voffB); PG8_STAGE(PG8_SA(0, 0), cA, voffA); PG8_STAGE(PG8_SB(0, 1), cB + hstepB, voffB); PG8_STAGE(PG8_SA(0, 1), cA + hstepA, voffA);
        if (wr == 1) PG8_BAR;
        PG8_WAIT_V(4); PG8_BAR;
        PG8_STAGE(PG8_SB(1, 0), cB + kstep, voffB); PG8_STAGE(PG8_SA(1, 0), cA + kstep, voffA); PG8_STAGE(PG8_SB(1, 1), cB + hstepB + kstep, voffB);
        PG8_WAIT_V(6); PG8_BAR;
    }
    for (;;) {
        const bool has_next = S.next(ui + 1, nxt);
        const char* nA = has_next ? (const char*)g.A + (size_t)nxt.pm * tstepA : cA; const char* nB = has_next ? (const char*)g.Bt + (size_t)nxt.pn * tstepB : cB;
        for (int t = 0; t < nt; t += 2) {
            const bool last = (t == nt - 2);
            const char* a1 = cA + (size_t)(t + 1) * kstep;
            const char* a2 = last ? nA : cA + (size_t)(t + 2) * kstep; const char* b2 = last ? nB : cB + (size_t)(t + 2) * kstep;
            const char* a3 = a2 + kstep; const char* b3 = b2 + kstep;
            if constexpr (Epi::MID) { if (t == (nt >> 1)) E.mid(acc, cur, wr, wc, fr, fq); }
            if constexpr (SP2) {
            PG8_LDB(B0, 0, 0); PG8_LDB(B1, 0, 1); PG8_SCHED; PG8_LDA(At, 0, 0); PG8_STAGE(PG8_SA(1, 1), a1 + hstepA, voffA);
            PG8_WAIT_V(8); PG8_WAIT_L(0); PG8_BAR; PG8_MMA(0, 0, At, B0); PG8_MMA(0, 1, At, B1); PG8_BAR; PG8_SCHED;
            PG8_LDA(At, 0, 1); PG8_STAGE(PG8_SB(0, 0), b2, voffB); PG8_STAGE(PG8_SB(0, 1), b2 + hstepB, voffB); PG8_STAGE(PG8_SA(0, 0), a2, voffA);
            PG8_WAIT_V(8); PG8_WAIT_L(0); PG8_BAR; PG8_MMA(1, 0, At, B0); PG8_MMA(1, 1, At, B1); PG8_BAR; PG8_SCHED;
            PG8_LDB(B0, 1, 0); PG8_LDB(B1, 1, 1); PG8_SCHED; PG8_LDA(At, 1, 0); PG8_STAGE(PG8_SA(0, 1), a2 + hstepA, voffA);
            PG8_WAIT_V(8); PG8_WAIT_L(0); PG8_BAR; PG8_MMA(0, 0, At, B0); PG8_MMA(0, 1, At, B1); PG8_BAR; PG8_SCHED;
            PG8_LDA(At, 1, 1); PG8_STAGE(PG8_SB(1, 0), b3, voffB); PG8_STAGE(PG8_SB(1, 1), b3 + hstepB, voffB); PG8_STAGE(PG8_SA(1, 0), a3, voffA);
            PG8_WAIT_V(8); PG8_WAIT_L(0); PG8_BAR; PG8_MMA(1, 0, At, B0); PG8_MMA(1, 1, At, B1); PG8_BAR; PG8_SCHED;
            } else {
            PG8_LDB(B0, 0, 0); PG8_SCHED; PG8_LDA(At, 0, 0); PG8_STAGE(PG8_SA(1, 1), a1 + hstepA, voffA);
            PG8_WAIT_L(8); PG8_BAR; PG8_WAIT_L(0); PG8_MMA(0, 0, At, B0); PG8_BAR; PG8_SCHED;
            PG8_LDB(B1, 0, 1); PG8_STAGE(PG8_SB(0, 0), b2, voffB);
            PG8_BAR; PG8_WAIT_L(0); PG8_MMA(0, 1, At, B1); PG8_BAR;
            PG8_LDA(At, 0, 1); PG8_STAGE(PG8_SA(0, 0), a2, voffA);
            PG8_BAR; PG8_WAIT_L(0); PG8_MMA(1, 0, At, B0); PG8_BAR; PG8_SCHED;
            PG8_STAGE(PG8_SB(0, 1), b2 + hstepB, voffB);
            PG8_WAIT_V(6); PG8_BAR; PG8_MMA(1, 1, At, B1); PG8_BAR;
            PG8_LDB(B0, 1, 0); PG8_SCHED; PG8_LDA(At, 1, 0); PG8_STAGE(PG8_SA(0, 1), a2 + hstepA, voffA);
            PG8_WAIT_L(8); PG8_BAR; PG8_WAIT_L(0); PG8_MMA(0, 0, At, B0); PG8_BAR; PG8_SCHED;
            PG8_LDB(B1, 1, 1); PG8_STAGE(PG8_SB(1, 0), b3, voffB);
            PG8_BAR; PG8_WAIT_L(0); PG8_MMA(0, 1, At, B1); PG8_BAR;
            PG8_LDA(At, 1, 1); PG8_STAGE(PG8_SA(1, 0), a3, voffA);
            PG8_BAR; PG8_WAIT_L(0); PG8_MMA(1, 0, At, B0); PG8_BAR; PG8_SCHED;
            PG8_STAGE(PG8_SB(1, 1), b3 + hstepB, voffB);
            PG8_WAIT_V(6); PG8_BAR; PG8_MMA(1, 1, At, B1); PG8_BAR;
            }
        }
        if constexpr (ALIGN_EPI) { if (wr == 0) PG8_BAR; }
        E(acc, cur, wr, wc, fr, fq);
        if (!has_next) break;
#pragma unroll
        for (int a = 0; a < 2; ++a)
#pragma unroll
            for (int b = 0; b < 2; ++b)
#pragma unroll
                for (int m = 0; m < 4; ++m)
#pragma unroll
                    for (int n = 0; n < 2; ++n) acc[a][b][m][n] = (f32x4){0.f, 0.f, 0.f, 0.f};
        cur = nxt; cA = nA; cB = nB; ++ui;
        if constexpr (ALIGN_EPI) { if (wr == 1) PG8_BAR; }
    }
    PG8_WAIT_V(0);
    if constexpr (!ALIGN_EPI) { if (wr == 0) PG8_BAR; }
    PG8_BAR;
#undef PG8_SA
#undef PG8_SB
#undef PG8_STAGE
#undef PG8_LDA
#undef PG8_LDB
#undef PG8_MMA
#undef PG8_WAIT_V
#undef PG8_WAIT_L
#undef PG8_BAR
#undef PG8_SCHED
}
}

#define LAS __attribute__((address_space(3)))
typedef unsigned short bf16_t;
typedef short bf16x8 __attribute__((ext_vector_type(8)));
typedef float f32x4 __attribute__((ext_vector_type(4)));
typedef float f32x2 __attribute__((ext_vector_type(2)));
typedef float f32x16 __attribute__((ext_vector_type(16)));
typedef unsigned u32x4 __attribute__((ext_vector_type(4)));
typedef unsigned u32x2 __attribute__((ext_vector_type(2)));

constexpr int DM = 1024, NB = 8, SEQ = 2048, MP = NB * SEQ, NSAMP = 128, TT = MP + NSAMP;
constexpr int NCH = SEQ / 128;
constexpr int PJ = 3584;
constexpr int N1 = 3840, N1V = 3600;
constexpr int DCONV = 1536, DFF = 4096;
constexpr float EPS = 1e-5f;
constexpr int XT_P = 136;

constexpr size_t MiB = 1u << 20;
constexpr size_t WS_SS5 = 0, WS_SSF = 128 * 1024, WS_CD = 384 * 1024, WS_BAR = 448 * 1024, WS_AB = 512 * 1024, WS_AQ = 576 * 1024;
constexpr size_t WS_BBT = 1 * MiB, WS_CM = 1 * MiB + 256 * 1024, WS_DT = 2 * MiB, WS_SE = 4 * MiB;
constexpr size_t WS_WIN = 8 * MiB, WS_WGLU = WS_WIN + (size_t)N1 * DM * 2, WS_WOUT = WS_WGLU + (size_t)DM * DM * 2, WS_WFF1 = WS_WOUT + (size_t)DM * 2048 * 2, WS_WFF2 = WS_WFF1 + (size_t)DFF * DM * 2;
constexpr size_t WS_XN = 38 * MiB;
constexpr size_t WS_PROJ = 71 * MiB;
constexpr size_t WS_ST = 184 * MiB;
constexpr size_t WS_HID = 71 * MiB;
constexpr size_t WS_END = 216 * MiB;
static_assert(WS_WFF2 + (size_t)DM * DFF * 2 <= WS_XN && WS_XN + (size_t)TT * DM * 2 <= WS_PROJ && WS_PROJ + (size_t)TT * PJ * 2 <= WS_ST && WS_HID + (size_t)TT * DFF * 2 <= WS_END, "ws map");

constexpr size_t O_YS = (size_t)MP * DM, O_S5RP = O_YS + (size_t)NSAMP * DM, O_S5IP = O_S5RP + 32768, O_SSDP = O_S5IP + 32768, O_CVP = O_SSDP + 1048576,
                 O_S5RS = O_CVP + 36864, O_S5IS = O_S5RS + 524288, O_SSDS = O_S5IS + 524288, O_CVS = O_SSDS + 16777216, O_END = O_CVS + 589824;

constexpr int LDS_BYTES = 147456;

struct Args { const float* in[30]; float* out; unsigned char* ws; int ph_lo, ph_hi; };

__device__ __forceinline__ float bf2f(unsigned short b) { return __builtin_bit_cast(float, (unsigned)b << 16); }
__device__ __forceinline__ float bflo(unsigned w) { return __builtin_bit_cast(float, w << 16); }
__device__ __forceinline__ float bfhi(unsigned w) { return __builtin_bit_cast(float, w & 0xffff0000u); }
__device__ __forceinline__ unsigned pk2(float lo, float hi) { return pg8::cvt_pk_bf16(lo, hi); }
__device__ __forceinline__ float wave_sum(float v) {
#pragma unroll
    for (int o = 1; o < 64; o <<= 1) v += __shfl_xor(v, o);
    return v;
}
__device__ __forceinline__ float sigmoidf_(float v) { return __builtin_amdgcn_rcpf(1.f + __expf(-v)); }
__device__ __forceinline__ float siluf_(float v) { return v * sigmoidf_(v); }
__device__ __forceinline__ float gelu_tanh(float v) { const float u = 1.5957691216057308f * (v + 0.044715f * v * v * v); return v * sigmoidf_(u); }
__device__ __forceinline__ float softplusf_(float x) { return fmaxf(x, 0.f) + log1pf(__expf(-fabsf(x))); }
__device__ __forceinline__ float rs_from_ss(float ss, float n) { return 1.0f / sqrtf(ss / n + EPS); }

struct EpiProj {
    static constexpr bool PERM = true, MID = false;
    bf16_t* P; float* DT;
    __device__ __forceinline__ void operator()(const f32x4 (&acc)[2][2][4][2], const pg8::Unit& u, int wr, int wc, int fr, int fq) const {
        const int row0 = u.pm * 256 + wr * 64 + fr, col0 = u.pn * 256 + wc * 32 + 8 * fq;
#pragma unroll
        for (int ai = 0; ai < 2; ++ai)
#pragma unroll
            for (int m = 0; m < 4; ++m) { const int row = row0 + ai * 128 + m * 16;
#pragma unroll
                for (int bj = 0; bj < 2; ++bj) { const int col = col0 + bj * 128; const f32x4 v0 = acc[ai][bj][m][0], v1 = acc[ai][bj][m][1];
                    if (col < PJ) { u32x4 w; w.x = pk2(v0[0], v0[1]); w.y = pk2(v0[2], v0[3]); w.z = pk2(v1[0], v1[1]); w.w = pk2(v1[2], v1[3]); *(u32x4*)(P + (size_t)row * PJ + col) = w; }
                    else if (col < N1V) { float* d = DT + (size_t)row * 16 + (col - PJ); *(f32x4*)d = v0; *(f32x4*)(d + 4) = v1; } } }
    }
};
struct EpiGlu {
    static constexpr bool PERM = true, MID = false;
    const bf16_t* G; bf16_t* P; const float* bias; float* SS;
    __device__ __forceinline__ void operator()(const f32x4 (&acc)[2][2][4][2], const pg8::Unit& u, int wr, int wc, int fr, int fq) const {
        const int row0 = u.pm * 256 + wr * 64 + fr, col0 = u.pn * 256 + wc * 32 + 8 * fq;
        f32x4 bv[2][2];
#pragma unroll
        for (int bj = 0; bj < 2; ++bj) { bv[bj][0] = *(const f32x4*)(bias + col0 + bj * 128); bv[bj][1] = *(const f32x4*)(bias + col0 + bj * 128 + 4); }
#pragma unroll
        for (int ai = 0; ai < 2; ++ai)
#pragma unroll
            for (int m = 0; m < 4; ++m) { const int row = row0 + ai * 128 + m * 16; float ss = 0.f;
#pragma unroll
                for (int bj = 0; bj < 2; ++bj) { const int col = col0 + bj * 128; const u32x4 gw = *(const u32x4*)(G + (size_t)row * DM + col);
                    const f32x4 v0 = acc[ai][bj][m][0] + bv[bj][0], v1 = acc[ai][bj][m][1] + bv[bj][1]; float o[8];
                    o[0] = bflo(gw.x) * sigmoidf_(v0[0]); o[1] = bfhi(gw.x) * sigmoidf_(v0[1]); o[2] = bflo(gw.y) * sigmoidf_(v0[2]); o[3] = bfhi(gw.y) * sigmoidf_(v0[3]);
                    o[4] = bflo(gw.z) * sigmoidf_(v1[0]); o[5] = bfhi(gw.z) * sigmoidf_(v1[1]); o[6] = bflo(gw.w) * sigmoidf_(v1[2]); o[7] = bfhi(gw.w) * sigmoidf_(v1[3]);
#pragma unroll
                    for (int i = 0; i < 8; ++i) ss += o[i] * o[i];
                    u32x4 w; w.x = pk2(o[0], o[1]); w.y = pk2(o[2], o[3]); w.z = pk2(o[4], o[5]); w.w = pk2(o[6], o[7]); *(u32x4*)(P + (size_t)row * PJ + col) = w; }
                ss += __shfl_xor(ss, 16); ss += __shfl_xor(ss, 32);
                if (fq == 0) atomicAdd(SS + row, ss); }
    }
};
struct EpiOut {
    static constexpr bool PERM = true, MID = true;
    const float* X; float* X1; bf16_t* X1B; float* SSF; const float* SS5;
    __device__ __forceinline__ void mid(f32x4 (&acc)[2][2][4][2], const pg8::Unit& u, int wr, int wc, int fr, int fq) const {
        const int row0 = u.pm * 256 + wr * 64 + fr;
#pragma unroll
        for (int ai = 0; ai < 2; ++ai)
#pragma unroll
            for (int m = 0; m < 4; ++m) { const float s = rs_from_ss(SS5[row0 + ai * 128 + m * 16], 1024.f);
#pragma unroll
                for (int bj = 0; bj < 2; ++bj) { acc[ai][bj][m][0] *= s; acc[ai][bj][m][1] *= s; } }
    }
    __device__ __forceinline__ void operator()(const f32x4 (&acc)[2][2][4][2], const pg8::Unit& u, int wr, int wc, int fr, int fq) const {
        const int row0 = u.pm * 256 + wr * 64 + fr, col0 = u.pn * 256 + wc * 32 + 8 * fq;
#pragma unroll
        for (int ai = 0; ai < 2; ++ai)
#pragma unroll
            for (int m = 0; m < 4; ++m) { const int row = row0 + ai * 128 + m * 16; float ss = 0.f;
#pragma unroll
                for (int bj = 0; bj < 2; ++bj) { const size_t off = (size_t)row * DM + col0 + bj * 128;
                    const f32x4 v0 = *(const f32x4*)(X + off) + acc[ai][bj][m][0], v1 = *(const f32x4*)(X + off + 4) + acc[ai][bj][m][1];
                    ss += (v0[0] * v0[0] + v0[1] * v0[1]) + (v0[2] * v0[2] + v0[3] * v0[3]) + (v1[0] * v1[0] + v1[1] * v1[1]) + (v1[2] * v1[2] + v1[3] * v1[3]);
                    *(f32x4*)(X1 + off) = v0; *(f32x4*)(X1 + off + 4) = v1;
                    u32x4 w; w.x = pk2(v0[0], v0[1]); w.y = pk2(v0[2], v0[3]); w.z = pk2(v1[0], v1[1]); w.w = pk2(v1[2], v1[3]); *(u32x4*)(X1B + off) = w; }
                ss += __shfl_xor(ss, 16); ss += __shfl_xor(ss, 32);
                if (fq == 0) atomicAdd(SSF + row, ss); }
    }
};
struct EpiFF1 {
    static constexpr bool PERM = true, MID = false;
    bf16_t* H; const float* SSF;
    __device__ __forceinline__ void operator()(const f32x4 (&acc)[2][2][4][2], const pg8::Unit& u, int wr, int wc, int fr, int fq) const {
        const int row0 = u.pm * 256 + wr * 64 + fr, col0 = u.pn * 256 + wc * 32 + 8 * fq;
#pragma unroll
        for (int ai = 0; ai < 2; ++ai)
#pragma unroll
            for (int m = 0; m < 4; ++m) { const int row = row0 + ai * 128 + m * 16; const float s = rs_from_ss(SSF[row], 1024.f);
#pragma unroll
                for (int bj = 0; bj < 2; ++bj) { f32x4 v0 = acc[ai][bj][m][0] * s, v1 = acc[ai][bj][m][1] * s;
#pragma unroll
                    for (int i = 0; i < 4; ++i) { const float a = fmaxf(v0[i], 0.f), b = fmaxf(v1[i], 0.f); v0[i] = a * a; v1[i] = b * b; }
                    u32x4 w; w.x = pk2(v0[0], v0[1]); w.y = pk2(v0[2], v0[3]); w.z = pk2(v1[0], v1[1]); w.w = pk2(v1[2], v1[3]); *(u32x4*)(H + (size_t)row * DFF + col0 + bj * 128) = w; } }
    }
};
struct EpiFF2 {
    static constexpr bool PERM = true, MID = false;
    float* X1;
    __device__ __forceinline__ void operator()(const f32x4 (&acc)[2][2][4][2], const pg8::Unit& u, int wr, int wc, int fr, int fq) const {
        const int row0 = u.pm * 256 + wr * 64 + fr, col0 = u.pn * 256 + wc * 32 + 8 * fq;
#pragma unroll
        for (int ai = 0; ai < 2; ++ai)
#pragma unroll
            for (int m = 0; m < 4; ++m) { const int row = row0 + ai * 128 + m * 16;
#pragma unroll
                for (int bj = 0; bj < 2; ++bj) { float* p = X1 + (size_t)row * DM + col0 + bj * 128;
                    const f32x4 v0 = *(const f32x4*)p + acc[ai][bj][m][0], v1 = *(const f32x4*)(p + 4) + acc[ai][bj][m][1]; *(f32x4*)p = v0; *(f32x4*)(p + 4) = v1; } }
    }
};

template <class F>
__device__ __forceinline__ void skinny_gemm(LAS unsigned char* lds, const bf16_t* A, int lda, const bf16_t* Bt, int ldb, int K, int nct, const F& f) {
    const int tid = threadIdx.x, wid = tid >> 6, lane = tid & 63;
    LAS float* red = (LAS float*)lds;
    const int nunits = 4 * nct, kw = K >> 3;
    for (int u = blockIdx.x; u < nunits; u += gridDim.x) {
        const int rt = u & 3, ct = u >> 2;
        const bf16_t* ap = A + (size_t)(rt * 32 + (lane & 31)) * lda + wid * kw + (lane >> 5) * 8;
        const bf16_t* bp = Bt + (size_t)(ct * 32 + (lane & 31)) * ldb + wid * kw + (lane >> 5) * 8;
        f32x16 acc;
#pragma unroll
        for (int i = 0; i < 16; ++i) acc[i] = 0.f;
#pragma unroll 8
        for (int kk = 0; kk < kw; kk += 16) { const bf16x8 a = *(const bf16x8*)(ap + kk), b = *(const bf16x8*)(bp + kk); acc = __builtin_amdgcn_mfma_f32_32x32x16_bf16(a, b, acc, 0, 0, 0); }
#pragma unroll
        for (int r = 0; r < 16; ++r) red[wid * 1056 + ((r & 3) + 8 * (r >> 2) + 4 * (lane >> 5)) * 33 + (lane & 31)] = acc[r];
        __syncthreads();
        const int row = tid >> 4, c = (tid & 15) * 2;
        float lo0 = 0.f, lo1 = 0.f, hi0 = 0.f, hi1 = 0.f;
#pragma unroll
        for (int w = 0; w < 4; ++w) { lo0 += red[w * 1056 + row * 33 + c]; lo1 += red[w * 1056 + row * 33 + c + 1]; hi0 += red[(w + 4) * 1056 + row * 33 + c]; hi1 += red[(w + 4) * 1056 + row * 33 + c + 1]; }
        f(rt * 32 + row, ct * 32 + c, lo0, hi0, lo1, hi1);
        __syncthreads();
    }
}
__device__ __forceinline__ float red16(float v) { v += __shfl_xor(v, 1); v += __shfl_xor(v, 2); v += __shfl_xor(v, 4); v += __shfl_xor(v, 8); return v; }

__device__ __forceinline__ void p0_transpose_item(const float* W, int K, int Nsrc, int N, bf16_t* WT, const float* gain, LAS float* scr, int item, int lane) {
    const int nblk = N / 32, kb = item / nblk, nb = item % nblk, k0 = 64 * kb, n0 = 32 * nb;
    const int n = n0 + (lane & 31); const bool ok = n < Nsrc;
#pragma unroll 8
    for (int i = 0; i < 32; ++i) { const int kk = 2 * i + (lane >> 5); float v = ok ? W[(size_t)(k0 + kk) * Nsrc + n] : 0.f; if (gain) v *= gain[k0 + kk]; scr[kk * 33 + (lane & 31)] = v; }
    asm volatile("s_waitcnt lgkmcnt(0)" ::: "memory");
    const int c = lane & 7;
#pragma unroll
    for (int j = 0; j < 4; ++j) { const int nn = (lane >> 3) + 8 * j; const LAS float* s = scr + (8 * c) * 33 + nn;
        u32x4 o; o.x = pk2(s[0 * 33], s[1 * 33]); o.y = pk2(s[2 * 33], s[3 * 33]); o.z = pk2(s[4 * 33], s[5 * 33]); o.w = pk2(s[6 * 33], s[7 * 33]);
        *(u32x4*)(WT + (size_t)(n0 + nn) * K + k0 + 8 * c) = o; }
    asm volatile("s_waitcnt lgkmcnt(0)" ::: "memory");
}

__device__ __forceinline__ void conv4x4(const bf16_t* xcol, long rowg, bool zero_hist3, const float* cw, const float* cbias, int ch, float (&out)[4][4]) {
    float xin[7][4];
#pragma unroll
    for (int rr = 0; rr < 7; ++rr) {
        if (rr < 3 && zero_hist3) { xin[rr][0] = xin[rr][1] = xin[rr][2] = xin[rr][3] = 0.f; }
        else { const u32x2 w = *(const u32x2*)(xcol + (rowg - 3 + rr) * PJ); xin[rr][0] = bflo(w.x); xin[rr][1] = bfhi(w.x); xin[rr][2] = bflo(w.y); xin[rr][3] = bfhi(w.y); }
    }
    const f32x4 b = *(const f32x4*)(cbias + ch);
    f32x4 w[4];
#pragma unroll
    for (int k = 0; k < 4; ++k) w[k] = *(const f32x4*)(cw + k * DCONV + ch);
#pragma unroll
    for (int i = 0; i < 4; ++i)
#pragma unroll
        for (int j = 0; j < 4; ++j) { float v = b[j];
#pragma unroll
            for (int k = 0; k < 4; ++k) v += w[k][j] * xin[i + k][j];
            out[i][j] = siluf_(v); }
}

__device__ __forceinline__ void ssd_dt_acum(LAS float* dtv, LAS float* acu, const float* DT, long r0, int g, const float* dt_bias, const float* a_log, int wid, int lane) {
    const int h = g * 8 + wid; const float bias = dt_bias[h], A = -__expf(a_log[h]); const int t0 = 2 * lane;
    const float d0 = softplusf_(DT[(r0 + t0) * 16 + h] + bias), d1 = softplusf_(DT[(r0 + t0 + 1) * 16 + h] + bias);
    const float a0 = d0 * A, s = a0 + d1 * A; float inc = s;
#pragma unroll
    for (int o = 1; o < 64; o <<= 1) { const float v = __shfl_up(inc, o); if (lane >= o) inc += v; }
    const float exc = inc - s;
    dtv[wid * 128 + t0] = d0; dtv[wid * 128 + t0 + 1] = d1; acu[wid * 128 + t0] = exc + a0; acu[wid * 128 + t0 + 1] = exc + s;
}

struct Frame {
    const float* in[30]; float* out; unsigned char* ws;
    bf16_t *WIN, *WGLU, *WOUT, *WFF1, *WFF2, *XN, *PROJ, *ST, *HID, *BBT, *CM;
    float *SS5, *SSF, *CD, *DT; f32x2 *AB, *AQ, *SE;
};
#define MFMA16(a, b, c) __builtin_amdgcn_mfma_f32_16x16x32_bf16((a), (b), (c), 0, 0, 0)
#define MFMA32(a, b, c) __builtin_amdgcn_mfma_f32_32x32x16_bf16((a), (b), (c), 0, 0, 0)

__device__ __forceinline__ void ssd_states_tile(LAS unsigned char* lds, const Frame& F, int b, int c, int g) {
    const int tid = threadIdx.x, wid = __builtin_amdgcn_readfirstlane(tid >> 6), lane = tid & 63, fr = lane & 15, fq = lane >> 4;
    LAS bf16_t* Bt = (LAS bf16_t*)lds; LAS bf16_t* Xt = (LAS bf16_t*)(lds + 34816);
    LAS float* dtv = (LAS float*)(lds + 52224); LAS float* acu = dtv + 1024;
    const long r0 = (long)b * SEQ + c * 128;
    const float* cw = F.in[19]; const float* cbias = F.in[20];
    ssd_dt_acum(dtv, acu, F.DT, r0, g, F.in[22], F.in[21], wid, lane);
#pragma unroll 1
    for (int q = tid; q < 1024; q += 512) { const int cgp = q & 31, tg = q >> 5, ch = 1024 + g * 128 + cgp * 4; float o[4][4];
        conv4x4(F.PROJ + 2048 + ch, r0 + tg * 4, c == 0 && tg == 0, cw, cbias, ch, o);
#pragma unroll
        for (int j = 0; j < 4; ++j) *(LAS u32x2*)(Bt + (cgp * 4 + j) * XT_P + tg * 4) = (u32x2){pk2(o[0][j], o[1][j]), pk2(o[2][j], o[3][j])}; }
    __syncthreads();
#pragma unroll 1
    for (int hh = 0; hh < 8; ++hh) { const int h = g * 8 + hh; const float a_last = acu[hh * 128 + 127];
        { const int cgp = tid & 15, tg = tid >> 4, ch = h * 64 + cgp * 4; float o[4][4], f[4];
          conv4x4(F.PROJ + 2048 + ch, r0 + tg * 4, c == 0 && tg == 0, cw, cbias, ch, o);
#pragma unroll
          for (int i = 0; i < 4; ++i) f[i] = dtv[hh * 128 + tg * 4 + i] * __expf(a_last - acu[hh * 128 + tg * 4 + i]);
#pragma unroll
          for (int j = 0; j < 4; ++j) *(LAS u32x2*)(Xt + (cgp * 4 + j) * XT_P + tg * 4) = (u32x2){pk2(o[0][j] * f[0], o[1][j] * f[1]), pk2(o[2][j] * f[2], o[3][j] * f[3])}; }
        __syncthreads();
        f32x4 acc[4];
#pragma unroll
        for (int i = 0; i < 4; ++i) acc[i] = (f32x4){0.f, 0.f, 0.f, 0.f};
#pragma unroll
        for (int ks = 0; ks < 4; ++ks) { const bf16x8 bfr = *(const LAS bf16x8*)(Bt + (16 * wid + fr) * XT_P + ks * 32 + fq * 8);
#pragma unroll
            for (int i = 0; i < 4; ++i) { const bf16x8 afr = *(const LAS bf16x8*)(Xt + (16 * i + fr) * XT_P + ks * 32 + fq * 8); acc[i] = MFMA16(bfr, afr, acc[i]); } }
        bf16_t* st = F.ST + ((size_t)((b * 16 + c) * 16 + h) * 64) * 128;
#pragma unroll
        for (int i = 0; i < 4; ++i) *(u32x2*)(st + (size_t)(16 * i + fr) * 128 + 16 * wid + 4 * fq) = (u32x2){pk2(acc[i][0], acc[i][1]), pk2(acc[i][2], acc[i][3])};
        if (tid == 0) F.CD[(b * 16 + c) * 16 + h] = __expf(a_last);
        __syncthreads();
    }
    if (c == NCH - 1) {
        for (int e = tid; e < 3 * 768; e += 512) { const int k = e / 768, ch = g * 768 + e % 768;
            F.out[O_CVP + (size_t)(b * 3 + k) * DCONV + ch] = bf2f(F.PROJ[(size_t)(b * SEQ + SEQ - 3 + k) * PJ + 2048 + ch]); }
    }
}

__device__ __forceinline__ void ssd_y_tile(LAS unsigned char* lds, const Frame& F, int b, int c, int g) {
    const int tid = threadIdx.x, wid = __builtin_amdgcn_readfirstlane(tid >> 6), lane = tid & 63, fr = lane & 15, fq = lane >> 4;
    LAS bf16_t* Bs = (LAS bf16_t*)lds; LAS bf16_t* Ps = Bs; LAS bf16_t* Cs = (LAS bf16_t*)(lds + 34816);
    LAS bf16_t* Xt = (LAS bf16_t*)(lds + 69632); LAS bf16_t* Hs = (LAS bf16_t*)(lds + 87040);
    LAS float* dtv = (LAS float*)(lds + 104448); LAS float* acu = dtv + 1024;
    const long r0 = (long)b * SEQ + c * 128;
    const float* cw = F.in[19]; const float* cbias = F.in[20];
    ssd_dt_acum(dtv, acu, F.DT, r0, g, F.in[22], F.in[21], wid, lane);
#pragma unroll 1
    for (int q = tid; q < 2048; q += 512) { const int qq = q & 1023, cgp = qq & 31, tg = qq >> 5, isC = q >> 10, ch = 1024 + isC * 256 + g * 128 + cgp * 4; float o[4][4];
        conv4x4(F.PROJ + 2048 + ch, r0 + tg * 4, c == 0 && tg == 0, cw, cbias, ch, o);
        LAS bf16_t* dst = isC ? Cs : Bs;
#pragma unroll
        for (int i = 0; i < 4; ++i) *(LAS u32x2*)(dst + (tg * 4 + i) * XT_P + cgp * 4) = (u32x2){pk2(o[i][0], o[i][1]), pk2(o[i][2], o[i][3])}; }
    __syncthreads();
    f32x4 cb[8]; bf16x8 cfr[4];
#pragma unroll
    for (int st = 0; st < 8; ++st) cb[st] = (f32x4){0.f, 0.f, 0.f, 0.f};
#pragma unroll
    for (int ks = 0; ks < 4; ++ks) cfr[ks] = *(const LAS bf16x8*)(Cs + (16 * wid + fr) * XT_P + ks * 32 + fq * 8);
#pragma unroll
    for (int st = 0; st < 8; ++st) if (st <= wid) {
#pragma unroll
        for (int ks = 0; ks < 4; ++ks) { const bf16x8 bfr = *(const LAS bf16x8*)(Bs + (16 * st + fr) * XT_P + ks * 32 + fq * 8); cb[st] = MFMA16(bfr, cfr[ks], cb[st]); } }
    __syncthreads();
    float ss = 0.f; const int l = 16 * wid + fr;
    bf16_t* zrow = F.PROJ + (size_t)(r0 + l) * PJ + 1024 + g * 512 + 4 * fq;
#pragma unroll 1
    for (int hh = 0; hh < 8; ++hh) { const int h = g * 8 + hh;
        { const int cgp = tid & 15, tg = tid >> 4, ch = h * 64 + cgp * 4; float o[4][4], f[4];
          conv4x4(F.PROJ + 2048 + ch, r0 + tg * 4, c == 0 && tg == 0, cw, cbias, ch, o);
#pragma unroll
          for (int i = 0; i < 4; ++i) f[i] = dtv[hh * 128 + tg * 4 + i];
#pragma unroll
          for (int j = 0; j < 4; ++j) *(LAS u32x2*)(Xt + (cgp * 4 + j) * XT_P + tg * 4) = (u32x2){pk2(o[0][j] * f[0], o[1][j] * f[1]), pk2(o[2][j] * f[2], o[3][j] * f[3])}; }
        { const int e = tid * 16, p = e >> 7, n0 = e & 127; const bf16_t* src = F.ST + ((size_t)((b * 16 + c) * 16 + h) * 64 + p) * 128 + n0;
          const u32x4 v0 = *(const u32x4*)src, v1 = *(const u32x4*)(src + 8); *(LAS u32x4*)(Hs + p * XT_P + n0) = v0; *(LAS u32x4*)(Hs + p * XT_P + n0 + 8) = v1; }
        const float al = acu[hh * 128 + l];
#pragma unroll
        for (int st = 0; st < 8; ++st) if (st <= (wid | 1)) { const int s0 = 16 * st + 4 * fq; float v[4];
#pragma unroll
            for (int j = 0; j < 4; ++j) v[j] = (s0 + j <= l) ? cb[st][j] * __expf(al - acu[hh * 128 + s0 + j]) : 0.f;
            *(LAS u32x2*)(Ps + l * XT_P + s0) = (u32x2){pk2(v[0], v[1]), pk2(v[2], v[3])}; }
        __syncthreads();
        f32x4 accY[4], accO[4];
#pragma unroll
        for (int i = 0; i < 4; ++i) { accY[i] = (f32x4){0.f, 0.f, 0.f, 0.f}; accO[i] = (f32x4){0.f, 0.f, 0.f, 0.f}; }
#pragma unroll
        for (int ks = 0; ks < 4; ++ks) {
            if (ks <= (wid >> 1)) { const bf16x8 pfr = *(const LAS bf16x8*)(Ps + l * XT_P + ks * 32 + fq * 8);
#pragma unroll
                for (int pt = 0; pt < 4; ++pt) { const bf16x8 xfr = *(const LAS bf16x8*)(Xt + (16 * pt + fr) * XT_P + ks * 32 + fq * 8); accY[pt] = MFMA16(xfr, pfr, accY[pt]); } }
#pragma unroll
            for (int pt = 0; pt < 4; ++pt) { const bf16x8 hfr = *(const LAS bf16x8*)(Hs + (16 * pt + fr) * XT_P + ks * 32 + fq * 8); accO[pt] = MFMA16(hfr, cfr[ks], accO[pt]); } }
        const float el = __expf(al), rdt = 1.0f / dtv[hh * 128 + l], Dh = F.in[23][h];
#pragma unroll
        for (int pt = 0; pt < 4; ++pt) { bf16_t* zp = zrow + hh * 64 + 16 * pt; const u32x2 zw = *(const u32x2*)zp;
            const float z[4] = {bflo(zw.x), bfhi(zw.x), bflo(zw.y), bfhi(zw.y)}; float y[4];
#pragma unroll
            for (int j = 0; j < 4; ++j) { const float xs = bf2f(Xt[(16 * pt + 4 * fq + j) * XT_P + l]) * rdt; y[j] = (accY[pt][j] + el * accO[pt][j] + Dh * xs) * siluf_(z[j]); ss += y[j] * y[j]; }
            *(u32x2*)zp = (u32x2){pk2(y[0], y[1]), pk2(y[2], y[3])}; }
        __syncthreads();
    }
    ss += __shfl_xor(ss, 16); ss += __shfl_xor(ss, 32);
    const float rs = rs_from_ss(ss, 512.f);
    asm volatile("s_waitcnt vmcnt(0)" ::: "memory");
#pragma unroll 4
    for (int i = 0; i < 32; ++i) { bf16_t* zp = zrow + 16 * i; const u32x2 w = *(const u32x2*)zp;
        *(u32x2*)zp = (u32x2){pk2(bflo(w.x) * rs, bfhi(w.x) * rs), pk2(bflo(w.y) * rs, bfhi(w.y) * rs)}; }
}

template <bool MODEB>
__device__ __forceinline__ void s5_chunk_job(LAS unsigned char* wl, const Frame& F, int b, int g, int c, int lane) {
    const long r0 = (long)b * SEQ + c * 128;
    bf16x8 bfr[4];
#pragma unroll
    for (int j = 0; j < 4; ++j) bfr[j] = *(const bf16x8*)(F.BBT + (size_t)(g * 128 + j * 32 + (lane & 31)) * 16 + (lane >> 5) * 8);
    const f32x2 a = F.AB[g * 64 + lane];
    f32x2* sep = F.SE + ((size_t)(b * 64 + g) * 16 + c) * 64 + lane;
    float hr = 0.f, hi = 0.f;
    bf16x8 cfr[4]; f32x4 d4 = (f32x4){0.f, 0.f, 0.f, 0.f};
    if constexpr (MODEB) { const f32x2 h0 = *sep; hr = h0.x; hi = h0.y;
#pragma unroll
        for (int ks = 0; ks < 4; ++ks) cfr[ks] = *(const bf16x8*)(F.CM + (size_t)(g * 16 + (lane & 15)) * 128 + ks * 32 + (lane >> 4) * 8);
        d4 = *(const f32x4*)(F.in[15] + g * 16 + 4 * (lane >> 4)); }
#pragma unroll 1
    for (int rt = 0; rt < 4; ++rt) {
        const bf16x8 afr = *(const bf16x8*)(F.PROJ + (size_t)(r0 + rt * 32 + (lane & 31)) * PJ + g * 16 + (lane >> 5) * 8);
#pragma unroll
        for (int j = 0; j < 4; ++j) { f32x16 acc;
#pragma unroll
            for (int r = 0; r < 16; ++r) acc[r] = 0.f;
            acc = MFMA32(afr, bfr[j], acc);
#pragma unroll
            for (int r = 0; r < 16; ++r) *(LAS float*)(wl + ((r & 3) + 8 * (r >> 2) + 4 * (lane >> 5)) * 528 + (j * 32 + (lane & 31)) * 4) = acc[r]; }
#pragma unroll 8
        for (int t = 0; t < 32; ++t) { const f32x2 bu = *(const LAS f32x2*)(wl + t * 528 + lane * 8);
            const float nr = a.x * hr - a.y * hi + bu.x, ni = a.x * hi + a.y * hr + bu.y; hr = nr; hi = ni;
            if constexpr (MODEB) *(LAS unsigned*)(wl + t * 528 + lane * 4) = pk2(hr, hi); }
        if constexpr (MODEB) {
#pragma unroll
            for (int half = 0; half < 2; ++half) { f32x4 accy = (f32x4){0.f, 0.f, 0.f, 0.f};
#pragma unroll
                for (int ks = 0; ks < 4; ++ks) { const bf16x8 hfr = *(const LAS bf16x8*)(wl + (half * 16 + (lane & 15)) * 528 + (ks * 32 + (lane >> 4) * 8) * 2); accy = MFMA16(cfr[ks], hfr, accy); }
                const size_t row = (size_t)(r0 + rt * 32 + half * 16 + (lane & 15));
                const u32x2 uw = *(const u32x2*)(F.PROJ + row * PJ + g * 16 + 4 * (lane >> 4));
                const float y0 = gelu_tanh(accy[0] + d4[0] * bflo(uw.x)), y1 = gelu_tanh(accy[1] + d4[1] * bfhi(uw.x)), y2 = gelu_tanh(accy[2] + d4[2] * bflo(uw.y)), y3 = gelu_tanh(accy[3] + d4[3] * bfhi(uw.y));
                *(u32x2*)(F.XN + row * DM + g * 16 + 4 * (lane >> 4)) = (u32x2){pk2(y0, y1), pk2(y2, y3)}; }
        }
    }
    if constexpr (!MODEB) *sep = (f32x2){hr, hi};
}

__device__ __forceinline__ void s5_sample_job(const Frame& F, int bs, int g, int lane) {
    const size_t row = (size_t)MP + bs;
    const bf16_t* up = F.PROJ + row * PJ + g * 16;
    const u32x4 u0 = *(const u32x4*)up, u1 = *(const u32x4*)(up + 8);
    const float u[16] = {bflo(u0.x), bfhi(u0.x), bflo(u0.y), bfhi(u0.y), bflo(u0.z), bfhi(u0.z), bflo(u0.w), bfhi(u0.w), bflo(u1.x), bfhi(u1.x), bflo(u1.y), bfhi(u1.y), bflo(u1.z), bfhi(u1.z), bflo(u1.w), bfhi(u1.w)};
    const bf16_t* bp = F.BBT + (size_t)(g * 128 + 2 * lane) * 16;
    float bre = 0.f, bim = 0.f;
#pragma unroll
    for (int q = 0; q < 2; ++q) { const u32x4 wr_ = *(const u32x4*)(bp + q * 8), wi_ = *(const u32x4*)(bp + 16 + q * 8);
        bre += bflo(wr_.x) * u[q * 8 + 0] + bfhi(wr_.x) * u[q * 8 + 1] + bflo(wr_.y) * u[q * 8 + 2] + bfhi(wr_.y) * u[q * 8 + 3] + bflo(wr_.z) * u[q * 8 + 4] + bfhi(wr_.z) * u[q * 8 + 5] + bflo(wr_.w) * u[q * 8 + 6] + bfhi(wr_.w) * u[q * 8 + 7];
        bim += bflo(wi_.x) * u[q * 8 + 0] + bfhi(wi_.x) * u[q * 8 + 1] + bflo(wi_.y) * u[q * 8 + 2] + bfhi(wi_.y) * u[q * 8 + 3] + bflo(wi_.z) * u[q * 8 + 4] + bfhi(wi_.z) * u[q * 8 + 5] + bflo(wi_.w) * u[q * 8 + 6] + bfhi(wi_.w) * u[q * 8 + 7]; }
    const size_t si = (size_t)(bs * 64 + g) * 64 + lane;
    const float h0r = F.in[2][si], h0i = F.in[3][si]; const f32x2 a = F.AB[g * 64 + lane];
    const float hr = a.x * h0r - a.y * h0i + bre, hi = a.x * h0i + a.y * h0r + bim;
    F.out[O_S5RS + si] = hr; F.out[O_S5IS + si] = hi;
    float yv = 0.f;
#pragma unroll
    for (int c = 0; c < 16; ++c) { const unsigned cm = *(const unsigned*)(F.CM + (size_t)(g * 16 + c) * 128 + 2 * lane); const float tot = wave_sum(bflo(cm) * hr + bfhi(cm) * hi); if (lane == c) yv = tot; }
    if (lane < 16) { const float y = gelu_tanh(yv + F.in[15][g * 16 + lane] * bf2f(up[lane])); F.XN[row * DM + g * 16 + lane] = (bf16_t)(pk2(y, 0.f) & 0xffffu); }
}

__device__ __forceinline__ float conv1_sample(const Frame& F, int bs, int ch, bool write_state) {
    const float* sc = F.in[5] + (size_t)bs * 3 * DCONV + ch;
    const float x0 = sc[0], x1 = sc[DCONV], x2 = sc[2 * DCONV], x3 = bf2f(F.PROJ[((size_t)MP + bs) * PJ + 2048 + ch]);
    const float* cw = F.in[19] + ch;
    const float v = F.in[20][ch] + cw[0] * x0 + cw[DCONV] * x1 + cw[2 * DCONV] * x2 + cw[3 * DCONV] * x3;
    if (write_state) { float* o = F.out + O_CVS + (size_t)bs * 3 * DCONV + ch; o[0] = x1; o[DCONV] = x2; o[2 * DCONV] = x3; }
    return siluf_(v);
}
__device__ __forceinline__ void ssd_sample_job(LAS unsigned char* lds, const Frame& F, int bs, int g) {
    const int tid = threadIdx.x, wid = __builtin_amdgcn_readfirstlane(tid >> 6), lane = tid & 63, h = g * 8 + wid;
    LAS float* red = (LAS float*)lds;
    const size_t row = (size_t)MP + bs;
    const float xs = conv1_sample(F, bs, h * 64 + lane, true);
    const float B0 = conv1_sample(F, bs, 1024 + g * 128 + 2 * lane, wid == 0), B1 = conv1_sample(F, bs, 1024 + g * 128 + 2 * lane + 1, wid == 0);
    const float C0 = conv1_sample(F, bs, 1280 + g * 128 + 2 * lane, wid == 0), C1 = conv1_sample(F, bs, 1280 + g * 128 + 2 * lane + 1, wid == 0);
    const float dt = softplusf_(F.DT[row * 16 + h] + F.in[22][h]), dA = __expf(-dt * __expf(F.in[21][h]));
    const float* sp = F.in[4] + ((size_t)(bs * 16 + h) * 64) * 128 + 2 * lane;
    float* op = F.out + O_SSDS + ((size_t)(bs * 16 + h) * 64) * 128 + 2 * lane;
    float y = 0.f;
#pragma unroll 8
    for (int p = 0; p < 64; ++p) { const float xp = __shfl(xs, p) * dt; const f32x2 h0 = *(const f32x2*)(sp + p * 128);
        const f32x2 hn = (f32x2){dA * h0.x + xp * B0, dA * h0.y + xp * B1}; *(f32x2*)(op + p * 128) = hn;
        const float tot = wave_sum(C0 * hn.x + C1 * hn.y); if (lane == p) y = tot; }
    bf16_t* zp = F.PROJ + row * PJ + 1024 + h * 64 + lane;
    y = (y + F.in[23][h] * xs) * siluf_(bf2f(*zp));
    const float ssw = wave_sum(y * y);
    if (lane == 0) red[wid] = ssw;
    __syncthreads();
    float tot = 0.f;
#pragma unroll
    for (int w = 0; w < 8; ++w) tot += red[w];
    *zp = (bf16_t)(pk2(y * rs_from_ss(tot, 512.f), 0.f) & 0xffffu);
    __syncthreads();
}


#define XB_TMO      128
#define XB_XCNT(j)  (256  + 64 * (j))
#define XB_XSUB(j)  (1280 + 64 * (j))
#define XB_XGEN(j)  (2304 + 64 * (j))
#define XB_TOP      3328
#define XB_TOPGEN   3392
#define XCD_BAR_WORDS 3456
#define XB_SPIN_CAP (1u << 18)
__device__ __forceinline__ unsigned xb_ld(unsigned* p)              { return __hip_atomic_load(p, __ATOMIC_RELAXED, __HIP_MEMORY_SCOPE_AGENT); }
__device__ __forceinline__ unsigned xb_add(unsigned* p, unsigned v) { return __hip_atomic_fetch_add(p, v, __ATOMIC_RELAXED, __HIP_MEMORY_SCOPE_AGENT); }
__device__ __forceinline__ unsigned xb_xcc_id() { return (unsigned)__builtin_amdgcn_s_getreg((3 << 11) | 20) & 0xFu; }
#define XB_SPIN(cond, bar) do { unsigned _sp = 0; while (cond) { __builtin_amdgcn_s_sleep(1); \
    if ((++_sp & 255u) == 0u) { if (xb_ld(&(bar)[XB_TMO])) break; if (_sp > XB_SPIN_CAP) { atomicAdd(&(bar)[XB_TMO], 1u); break; } } } } while (0)
struct XcdBarrier { unsigned* bar; unsigned x; volatile LAS unsigned* st; };
__device__ __forceinline__ XcdBarrier xcd_barrier_post(unsigned* bar, volatile LAS unsigned* st) {
    XcdBarrier b; b.bar = bar; b.x = xb_xcc_id(); b.st = st;
    if (threadIdx.x == 0) (void)xb_add(&bar[XB_XCNT(b.x)], 1u);
    return b;
}
__device__ __forceinline__ void xcd_barrier_complete(unsigned* bar, unsigned x, unsigned& nloc, unsigned& nx) {
    const unsigned G = gridDim.x * gridDim.y * gridDim.z;
    unsigned sum, cnt, mine, sp = 0u;
    for (;;) {
        sum = 0u; cnt = 0u; mine = 0u;
#pragma unroll
        for (unsigned j = 0; j < 16; ++j) { const unsigned c = xb_ld(&bar[XB_XCNT(j)]); sum += c; cnt += (c > 0u) ? 1u : 0u; mine = (j == x) ? c : mine; }
        if (sum == G) break;
        __builtin_amdgcn_s_sleep(1);
        if ((++sp & 255u) == 0u) { if (xb_ld(&bar[XB_TMO])) break; if (sp > XB_SPIN_CAP) { atomicAdd(&bar[XB_TMO], 1u); break; } }
    }
    nloc = mine > 0u ? mine : 1u; nx = cnt > 0u ? cnt : 1u;
}
__device__ __forceinline__ void xcd_barrier(const XcdBarrier& b) {
    asm volatile("s_waitcnt vmcnt(0)" ::: "memory");
    __syncthreads();
    if (threadIdx.x == 0) {
        unsigned* bar = b.bar;
        __builtin_amdgcn_s_waitcnt(0);
        unsigned nloc = b.st[0], nx = b.st[1];
        if (nloc == 0u) { xcd_barrier_complete(bar, b.x, nloc, nx); b.st[0] = nloc; b.st[1] = nx; }
        const unsigned old = xb_add(&bar[XB_XSUB(b.x)], 1u);
        const unsigned gen = old / nloc;
        if (old + 1u == (gen + 1u) * nloc) {
            __builtin_amdgcn_fence(__ATOMIC_RELEASE, "agent");
            asm volatile("s_waitcnt vmcnt(0)" ::: "memory");
            const unsigned og = xb_add(&bar[XB_TOP], 1u);
            const unsigned tg = og / nx;
            if (og + 1u == (tg + 1u) * nx) xb_add(&bar[XB_TOPGEN], 1u);
            else XB_SPIN(xb_ld(&bar[XB_TOPGEN]) == tg, bar);
            __builtin_amdgcn_fence(__ATOMIC_ACQUIRE, "agent");
            xb_add(&bar[XB_XGEN(b.x)], 1u);
            asm volatile("s_waitcnt vmcnt(0)" ::: "memory");
        } else {
            XB_SPIN(xb_ld(&bar[XB_XGEN(b.x)]) == gen, bar);
            __builtin_amdgcn_fence(__ATOMIC_ACQUIRE, "agent");
            asm volatile("s_waitcnt vmcnt(0)" ::: "memory");
        }
    }
    __syncthreads();
}

__global__ void __launch_bounds__(512, 2) hymba_fwd(Args args) {
    extern __shared__ __attribute__((aligned(16))) unsigned char lds_raw[];
    LAS unsigned char* lds = (LAS unsigned char*)lds_raw;
    cg::grid_group grid = cg::this_grid();
    Frame F;
#pragma unroll
    for (int i = 0; i < 30; ++i) F.in[i] = args.in[i];
    F.out = args.out; F.ws = args.ws;
    unsigned char* ws = args.ws;
    F.WIN = (bf16_t*)(ws + WS_WIN); F.WGLU = (bf16_t*)(ws + WS_WGLU); F.WOUT = (bf16_t*)(ws + WS_WOUT); F.WFF1 = (bf16_t*)(ws + WS_WFF1); F.WFF2 = (bf16_t*)(ws + WS_WFF2);
    F.XN = (bf16_t*)(ws + WS_XN); F.PROJ = (bf16_t*)(ws + WS_PROJ); F.ST = (bf16_t*)(ws + WS_ST); F.HID = (bf16_t*)(ws + WS_HID);
    F.BBT = (bf16_t*)(ws + WS_BBT); F.CM = (bf16_t*)(ws + WS_CM);
    F.SS5 = (float*)(ws + WS_SS5); F.SSF = (float*)(ws + WS_SSF); F.CD = (float*)(ws + WS_CD); F.DT = (float*)(ws + WS_DT);
    F.AB = (f32x2*)(ws + WS_AB); F.AQ = (f32x2*)(ws + WS_AQ); F.SE = (f32x2*)(ws + WS_SE);
    const int tid = threadIdx.x, wid = __builtin_amdgcn_readfirstlane(tid >> 6), lane = tid & 63;
    const int G = gridDim.x, gt = blockIdx.x * 512 + tid, GT = G * 512, gw = blockIdx.x * 8 + wid, NGW = G * 8;
    const int lo = args.ph_lo, hi = args.ph_hi;
    if (lo < 0) grid.sync();
    if (tid < 2) ((LAS unsigned*)(lds + LDS_BYTES - 16))[tid] = 0u;
    __syncthreads();
    XcdBarrier bar = xcd_barrier_post((unsigned*)(ws + WS_BAR), (volatile LAS unsigned*)(lds + LDS_BYTES - 16));
#define IN(k) (lo <= (k) && (k) < hi)
#ifndef PROBE_SYNCS
#define PROBE_SYNCS 1
#endif
#ifndef PROBE_REP
#define PROBE_REP 0
#endif
#define SEAM(k) do { if (IN(k) && IN((k) + 1)) { for (int _s = 0; _s < PROBE_SYNCS; ++_s) xcd_barrier(bar); } } while (0)
#define REPS(k) (((PROBE_REP >> (k)) & 1) + 1)

    if (IN(0)) for (int _rep = 0; _rep < REPS(0); ++_rep) { if (_rep) xcd_barrier(bar);
        for (int i = gt; i < TT; i += GT) { F.SS5[i] = 0.f; F.SSF[i] = 0.f; }
        LAS float* scr = (LAS float*)(lds + wid * 8448);
        constexpr int I_IN = 16 * (N1 / 32), I_GLU = 16 * 32, I_OUT = 32 * 32, I_FF1 = 16 * 128, I_FF2 = 64 * 32, I_ALL = I_IN + I_GLU + I_OUT + I_FF1 + I_FF2;
        for (int it = gw; it < I_ALL; it += NGW) { int r = it;
            if (r < I_IN) { p0_transpose_item(F.in[7], 1024, N1V, N1, F.WIN, nullptr, scr, r, lane); continue; } r -= I_IN;
            if (r < I_GLU) { p0_transpose_item(F.in[16], 1024, 1024, 1024, F.WGLU, nullptr, scr, r, lane); continue; } r -= I_GLU;
            if (r < I_OUT) { const int k0 = 64 * (r / 32); p0_transpose_item(F.in[25], 2048, 1024, 1024, F.WOUT, k0 < 1024 ? F.in[18] : F.in[24] - 1024, scr, r, lane); continue; } r -= I_OUT;
            if (r < I_FF1) { p0_transpose_item(F.in[27], 1024, 4096, 4096, F.WFF1, F.in[26], scr, r, lane); continue; } r -= I_FF1;
            p0_transpose_item(F.in[28], 4096, 1024, 1024, F.WFF2, nullptr, scr, r, lane);
        }
        for (int m = gw; m < TT; m += NGW) { const float* src = m < MP ? F.in[0] + (size_t)m * DM : F.in[1] + (size_t)(m - MP) * DM;
            f32x4 v[4]; float s = 0.f;
#pragma unroll
            for (int j = 0; j < 4; ++j) { v[j] = *(const f32x4*)(src + 4 * lane + 256 * j); s += (v[j][0] * v[j][0] + v[j][1] * v[j][1]) + (v[j][2] * v[j][2] + v[j][3] * v[j][3]); }
            const float rs = rs_from_ss(wave_sum(s), 1024.f);
#pragma unroll
            for (int j = 0; j < 4; ++j) { const f32x4 gn = *(const f32x4*)(F.in[6] + 4 * lane + 256 * j);
                *(u32x2*)(F.XN + (size_t)m * DM + 4 * lane + 256 * j) = (u32x2){pk2(v[j][0] * rs * gn[0], v[j][1] * rs * gn[1]), pk2(v[j][2] * rs * gn[2], v[j][3] * rs * gn[3])}; } }
        for (int idx = gt; idx < 4096; idx += GT) { const int g = idx >> 6, p = idx & 63;
            const float dt = expf(F.in[10][g]), lr = F.in[8][idx], li = F.in[9][idx];
            const float mag = expf(lr * dt), ang = li * dt; float abr = mag * cosf(ang), abi = mag * sinf(ang);
            const float den = lr * lr + li * li, nr = abr - 1.f, ni = abi, fre = (nr * lr + ni * li) / den, fim = (ni * lr - nr * li) / den;
            F.AB[idx] = (f32x2){abr, abi};
            float qr = abr, qi = abi;
#pragma unroll
            for (int k = 0; k < 7; ++k) { const float tr = qr * qr - qi * qi, ti = 2.f * qr * qi; qr = tr; qi = ti; }
            F.AQ[idx] = (f32x2){qr, qi};
#pragma unroll 4
            for (int c = 0; c < 16; ++c) { const float br = F.in[11][(size_t)idx * 16 + c], bi = F.in[12][(size_t)idx * 16 + c];
                F.BBT[(size_t)(g * 128 + 2 * p) * 16 + c] = (bf16_t)(pk2(fre * br - fim * bi, 0.f) & 0xffffu); F.BBT[(size_t)(g * 128 + 2 * p + 1) * 16 + c] = (bf16_t)(pk2(fre * bi + fim * br, 0.f) & 0xffffu);
                const float cr = F.in[13][(size_t)(g * 16 + c) * 64 + p], ci = F.in[14][(size_t)(g * 16 + c) * 64 + p];
                *(unsigned*)(F.CM + (size_t)(g * 16 + c) * 128 + 2 * p) = pk2(cr, -ci); } }
    }
    SEAM(0);

    if (IN(1)) for (int _rep = 0; _rep < REPS(1); ++_rep) { if (_rep) xcd_barrier(bar);
        pg8::Gemm gm{F.XN, F.WIN, DM, DM, DM}; pg8::StaticOrder S; S.init(MP, N1, G, (int)blockIdx.x);
        EpiProj E{F.PROJ, F.DT};
        pg8::gemm_phase<EpiProj, pg8::StaticOrder, true, true>(lds, gm, S, E);
        bf16_t* P = F.PROJ; float* DTp = F.DT;
        skinny_gemm(lds, F.XN + (size_t)MP * DM, DM, F.WIN, DM, DM, 113, [=](int row, int col, float lo0, float hi0, float lo1, float hi1) {
            const float v0 = lo0 + hi0, v1 = lo1 + hi1; const size_t r = (size_t)MP + row;
            if (col < PJ) *(unsigned*)(P + r * PJ + col) = pk2(v0, v1); else if (col < N1V) { DTp[r * 16 + col - PJ] = v0; DTp[r * 16 + col - PJ + 1] = v1; } });
    }
    SEAM(1);

    if (IN(2)) {
        for (int tile = blockIdx.x; tile < NB * NCH * 2; tile += G) ssd_states_tile(lds, F, tile >> 5, (tile >> 1) & 15, tile & 1);
        __syncthreads();
        for (int job = gw; job < NB * NCH * 64; job += NGW) s5_chunk_job<false>(lds + wid * 16896, F, job >> 10, job & 63, (job >> 6) & 15, lane);
        __syncthreads();
        for (int j = blockIdx.x; j < NSAMP * 2; j += G) ssd_sample_job(lds, F, j >> 1, j & 1);
        for (int job = gw; job < NSAMP * 64; job += NGW) s5_sample_job(F, job >> 6, job & 63, lane);
    }
    SEAM(2);

    if (IN(3)) {
        for (int idx = gt; idx < NB * 16 * 64 * 16; idx += GT) { const int n8 = idx & 15, p = (idx >> 4) & 63, h = (idx >> 10) & 15, b = idx >> 14;
            bf16_t* base = F.ST + ((size_t)(b * 16 * 16 + h) * 64 + p) * 128 + n8 * 8; const size_t cstep = (size_t)16 * 64 * 128;
            u32x4 v[NCH];
#pragma unroll
            for (int c = 0; c < NCH; ++c) v[c] = *(const u32x4*)(base + c * cstep);
            float hs[8];
#pragma unroll
            for (int i = 0; i < 8; ++i) hs[i] = 0.f;
#pragma unroll
            for (int c = 0; c < NCH; ++c) { const float cd = F.CD[(b * 16 + c) * 16 + h];
                *(u32x4*)(base + c * cstep) = (u32x4){pk2(hs[0], hs[1]), pk2(hs[2], hs[3]), pk2(hs[4], hs[5]), pk2(hs[6], hs[7])};
                hs[0] = cd * hs[0] + bflo(v[c].x); hs[1] = cd * hs[1] + bfhi(v[c].x); hs[2] = cd * hs[2] + bflo(v[c].y); hs[3] = cd * hs[3] + bfhi(v[c].y);
                hs[4] = cd * hs[4] + bflo(v[c].z); hs[5] = cd * hs[5] + bfhi(v[c].z); hs[6] = cd * hs[6] + bflo(v[c].w); hs[7] = cd * hs[7] + bfhi(v[c].w); }
            float* o = F.out + O_SSDP + ((size_t)(b * 16 + h) * 64 + p) * 128 + n8 * 8;
            *(f32x4*)o = (f32x4){hs[0], hs[1], hs[2], hs[3]}; *(f32x4*)(o + 4) = (f32x4){hs[4], hs[5], hs[6], hs[7]}; }
        for (int idx = gt; idx < NB * 64 * 64; idx += GT) { const int p = idx & 63, bg = idx >> 6, g = bg & 63;
            const f32x2 aq = F.AQ[g * 64 + p]; f32x2* sp = F.SE + (size_t)bg * 16 * 64 + p; float hr = 0.f, hi_ = 0.f;
#pragma unroll 4
            for (int c = 0; c < NCH; ++c) { const f32x2 t = sp[c * 64]; sp[c * 64] = (f32x2){hr, hi_}; const float nr = aq.x * hr - aq.y * hi_ + t.x, ni = aq.x * hi_ + aq.y * hr + t.y; hr = nr; hi_ = ni; }
            F.out[O_S5RP + idx] = hr; F.out[O_S5IP + idx] = hi_; }
    }
    SEAM(3);

    if (IN(4)) {
        for (int tile = blockIdx.x; tile < NB * NCH * 2; tile += G) ssd_y_tile(lds, F, tile >> 5, (tile >> 1) & 15, tile & 1);
        __syncthreads();
        for (int job = gw; job < NB * NCH * 64; job += NGW) s5_chunk_job<true>(lds + wid * 16896, F, job >> 10, job & 63, (job >> 6) & 15, lane);
        __syncthreads();
    }
    SEAM(4);

    if (IN(5)) {
        pg8::Gemm gm{F.XN, F.WGLU, DM, DM, DM}; pg8::StaticOrder S; S.init(MP, DM, G, (int)blockIdx.x);
        EpiGlu E{F.XN, F.PROJ, F.in[17], F.SS5};
        pg8::gemm_phase<EpiGlu, pg8::StaticOrder, false, true>(lds, gm, S, E);
        const bf16_t* Gp = F.XN; bf16_t* P = F.PROJ; const float* bias = F.in[17]; float* SS = F.SS5;
        skinny_gemm(lds, F.XN + (size_t)MP * DM, DM, F.WGLU, DM, DM, 32, [=](int row, int col, float lo0, float hi0, float lo1, float hi1) {
            const size_t r = (size_t)MP + row; const unsigned gw_ = *(const unsigned*)(Gp + r * DM + col);
            const float o0 = bflo(gw_) * sigmoidf_(lo0 + hi0 + bias[col]), o1 = bfhi(gw_) * sigmoidf_(lo1 + hi1 + bias[col + 1]);
            *(unsigned*)(P + r * PJ + col) = pk2(o0, o1);
            const float ss = red16(o0 * o0 + o1 * o1); if ((threadIdx.x & 15) == 0) atomicAdd(SS + r, ss); });
    }
    SEAM(5);

    if (IN(6)) {
        pg8::Gemm gm{F.PROJ, F.WOUT, PJ, 2048, 2048}; pg8::StaticOrder S; S.init(MP, DM, G, (int)blockIdx.x);
        EpiOut E{F.in[0], F.out, F.XN, F.SSF, F.SS5};
        pg8::gemm_phase<EpiOut, pg8::StaticOrder, false, true>(lds, gm, S, E);
        const float* xs = F.in[1]; float* X1 = F.out; bf16_t* X1B = F.XN; float* SSF = F.SSF; const float* SS5 = F.SS5;
        skinny_gemm(lds, F.PROJ + (size_t)MP * PJ, PJ, F.WOUT, 2048, 2048, 32, [=](int row, int col, float lo0, float hi0, float lo1, float hi1) {
            const size_t r = (size_t)MP + row; const float s = rs_from_ss(SS5[r], 1024.f);
            const float v0 = xs[(size_t)row * DM + col] + lo0 * s + hi0, v1 = xs[(size_t)row * DM + col + 1] + lo1 * s + hi1;
            X1[r * DM + col] = v0; X1[r * DM + col + 1] = v1; *(unsigned*)(X1B + r * DM + col) = pk2(v0, v1);
            const float ss = red16(v0 * v0 + v1 * v1); if ((threadIdx.x & 15) == 0) atomicAdd(SSF + r, ss); });
    }
    SEAM(6);

    if (IN(7)) for (int _rep = 0; _rep < REPS(7); ++_rep) { if (_rep) xcd_barrier(bar);
        pg8::Gemm gm{F.XN, F.WFF1, DM, DM, DM}; pg8::StaticOrder S; S.init(MP, DFF, G, (int)blockIdx.x);
        EpiFF1 E{F.HID, F.SSF};
        pg8::gemm_phase<EpiFF1, pg8::StaticOrder, true, true>(lds, gm, S, E);
        bf16_t* H = F.HID; const float* SSF = F.SSF;
        skinny_gemm(lds, F.XN + (size_t)MP * DM, DM, F.WFF1, DM, DM, 128, [=](int row, int col, float lo0, float hi0, float lo1, float hi1) {
            const size_t r = (size_t)MP + row; const float s = rs_from_ss(SSF[r], 1024.f);
            const float a = fmaxf((lo0 + hi0) * s, 0.f), b = fmaxf((lo1 + hi1) * s, 0.f); *(unsigned*)(H + r * DFF + col) = pk2(a * a, b * b); });
    }
    SEAM(7);

    if (IN(8)) {
        pg8::Gemm gm{F.HID, F.WFF2, DFF, DFF, DFF}; pg8::StaticOrder S; S.init(MP, DM, G, (int)blockIdx.x);
        EpiFF2 E{F.out};
        pg8::gemm_phase<EpiFF2, pg8::StaticOrder, false, true>(lds, gm, S, E);
        float* X1 = F.out;
        skinny_gemm(lds, F.HID + (size_t)MP * DFF, DFF, F.WFF2, DFF, DFF, 32, [=](int row, int col, float lo0, float hi0, float lo1, float hi1) {
            const size_t r = (size_t)MP + row; X1[r * DM + col] += lo0 + hi0; X1[r * DM + col + 1] += lo1 + hi1; });
    }
    SEAM(8);

    if (IN(9)) {
        for (int m = gw; m < TT; m += NGW) { float* src = F.out + (size_t)m * DM;
            f32x4 v[4]; float s = 0.f;
#pragma unroll
            for (int j = 0; j < 4; ++j) { v[j] = *(const f32x4*)(src + 4 * lane + 256 * j); s += (v[j][0] * v[j][0] + v[j][1] * v[j][1]) + (v[j][2] * v[j][2] + v[j][3] * v[j][3]); }
            const float rs = rs_from_ss(wave_sum(s), 1024.f);
#pragma unroll
            for (int j = 0; j < 4; ++j) { const f32x4 gn = *(const f32x4*)(F.in[29] + 4 * lane + 256 * j); *(f32x4*)(src + 4 * lane + 256 * j) = v[j] * rs * gn; } }
    }
#undef IN
#undef SEAM
}

#ifndef N_LAUNCHES
#define N_LAUNCHES 1
#endif
extern "C" void kernel_launch(void* const* d_in, const int* in_sizes, int n_in, void* d_out, int out_size, void* d_ws, size_t ws_size, hipStream_t stream) {
    static int grid = 0;
    if (grid == 0) {
        if (n_in != 30 || (size_t)out_size != O_END || ws_size < WS_END) { fprintf(stderr, "kernel_launch: unexpected shapes: n_in %d out_size %d ws %zu\n", n_in, out_size, ws_size); grid = -1; return; }
        int dev = 0, cus = 0, per_cu = 0;
        (void)hipGetDevice(&dev); (void)hipDeviceGetAttribute(&cus, hipDeviceAttributeMultiprocessorCount, dev);
        if (hipFuncSetAttribute((const void*)hymba_fwd, hipFuncAttributeMaxDynamicSharedMemorySize, LDS_BYTES) != hipSuccess) { fprintf(stderr, "kernel_launch: hipFuncSetAttribute failed\n"); grid = -1; return; }
        if (hipOccupancyMaxActiveBlocksPerMultiprocessor(&per_cu, (const void*)hymba_fwd, 512, LDS_BYTES) != hipSuccess || per_cu < 1) { fprintf(stderr, "kernel_launch: occupancy query says %d\n", per_cu); per_cu = 1; }
        (void)hipGetLastError();
        grid = cus * per_cu;
    }
    if (grid < 0) return;
    if (hipMemsetAsync((char*)d_ws + WS_BAR, 0, XCD_BAR_WORDS * 4, stream) != hipSuccess) { fprintf(stderr, "kernel_launch: memset failed\n"); return; }
    Args a{};
    for (int i = 0; i < 30; ++i) a.in[i] = (const float*)d_in[i];
    a.out = (float*)d_out; a.ws = (unsigned char*)d_ws;
    constexpr int NPH = 10;
    for (int li = 0; li < N_LAUNCHES; ++li) {
        a.ph_lo = (N_LAUNCHES == 1) ? 0 : li; a.ph_hi = (N_LAUNCHES == 1) ? NPH : li + 1;
        void* kargs[] = {&a};
        const hipError_t e = hipLaunchCooperativeKernel((const void*)hymba_fwd, dim3(grid), dim3(512), kargs, LDS_BYTES, stream);
        if (e != hipSuccess) { fprintf(stderr, "kernel_launch: cooperative launch %d failed: %s (grid %d)\n", li, hipGetErrorString(e), grid); break; }
    }
}
```

```cpp
#include <hip/hip_runtime.h>
#include <hip/hip_cooperative_groups.h>
#include <cstdio>
#include <cstdint>
namespace cg = cooperative_groups;

namespace pg8 {
#define PG8_LAS __attribute__((address_space(3)))
typedef unsigned short bf16_t;
typedef short bf16x8 __attribute__((ext_vector_type(8)));
typedef float f32x4 __attribute__((ext_vector_type(4)));
typedef unsigned u32x4 __attribute__((ext_vector_type(4)));
typedef unsigned u32x2 __attribute__((ext_vector_type(2)));
constexpr int BM = 256, BK = 64, HALF = 128, HTB = HALF * BK * 2  , STAGE_BYTES = 8 * HTB, NXCD = 8, WGM = 8;

__host__ __device__ __forceinline__ int lds_byte(int r, int c) { const int st = (r >> 4) * 2 + (c >> 5), rr = r & 15, cc = c & 31, ob = rr * 64 + cc * 2; return st * 1024 + (ob ^ (((ob >> 9) & 1) << 5)); }
__host__ __device__ __forceinline__ void stage_rc(int b, int& R, int& C) { const int st = b / 1024, sb = b % 1024, swz = sb ^ (((sb >> 9) & 1) << 5); R = (st >> 1) * 16 + swz / 64; C = (st & 1) * 32 + (swz % 64) / 2; }
__host__ __device__ __forceinline__ int perm32(int rho) { const int n = rho >> 4, i = rho & 15; return 8 * (i >> 2) + 4 * n + (i & 3); }

struct Unit { int pm, pn; };
struct Gemm { const bf16_t* A; const bf16_t* Bt; int lda, ldb, K; };

struct StaticOrder {
    int nM, nN, nwg, G, c;
    __host__ __device__ void init(int M, int N, int G_, int c_) { nM = M / BM; nN = N / BM; nwg = nM * nN; G = G_; c = c_; }
    __host__ __device__ bool next(int i, Unit& u) const {
        const long L = (long)i * G + c; if (L >= nwg) return false;
        int wgid = (int)L; { const int q = nwg / NXCD, r = nwg % NXCD, xcd = wgid % NXCD, off = wgid / NXCD; wgid = (xcd < r ? xcd * (q + 1) : r * (q + 1) + (xcd - r) * q) + off; }
        const int nig = WGM * nN, gid = wgid / nig, fm = gid * WGM, gsz = (nM - fm) < WGM ? (nM - fm) : WGM;
        u.pm = fm + ((wgid % nig) % gsz); u.pn = (wgid % nig) / gsz; return true;
    }
};

__device__ __forceinline__ unsigned cvt_pk_bf16(float lo, float hi) { unsigned r; asm volatile("v_cvt_pk_bf16_f32 %0, %1, %2" : "=v"(r) : "v"(lo), "v"(hi)); return r; }

template <class Epi, class Sched, bool ALIGN_EPI = false, bool SP2 = false>
__device__ __forceinline__ void gemm_phase(PG8_LAS unsigned char* lds, const Gemm g, const Sched& S, const Epi& E) {
    const int tid = threadIdx.x, wid = __builtin_amdgcn_readfirstlane(tid >> 6), lane = tid & 63, wr = wid >> 2, wc = wid & 3, fr = lane & 15, fq = lane >> 4;
    const int K = g.K, nt = K / BK;
    unsigned voffA[2], voffB[2];
#pragma unroll
    for (int i = 0; i < 2; ++i) { int R, C; stage_rc(tid * 16 + i * 8192, R, C); const int Rb = Epi::PERM ? ((R & ~31) + perm32(R & 31)) : R;
        voffA[i] = (unsigned)(R * g.lda + C) * 2u; voffB[i] = (unsigned)(Rb * g.ldb + C) * 2u; }
    const size_t kstep = (size_t)(BK * 2);
    const size_t hstepA = (size_t)HALF * g.lda * 2, hstepB = (size_t)HALF * g.ldb * 2;
    const size_t tstepA = 2 * hstepA, tstepB = 2 * hstepB;
    const unsigned ldsw = (unsigned)wid * 1024u;
    const int aoff = lds_byte(wr * 64 + fr, fq * 8), boff = lds_byte(wc * 32 + fr, fq * 8);
#define PG8_SA(b, h) (((b) * 2 + (h)) * HTB)
#define PG8_SB(b, h) ((4 + (b) * 2 + (h)) * HTB)
#define PG8_STAGE(bufoff, gbase, voff) do { _Pragma("unroll") for (int _i = 0; _i < 2; ++_i) \
        __builtin_amdgcn_global_load_lds((const unsigned*)((const char*)(gbase) + (voff)[_i]), (PG8_LAS unsigned*)(lds + (bufoff) + ldsw + _i * 8192), 16, 0, 0); } while (0)
#define PG8_LDA(dst, b, h) do { _Pragma("unroll") for (int m = 0; m < 4; ++m) _Pragma("unroll") for (int k = 0; k < 2; ++k) dst[m][k] = *(const PG8_LAS bf16x8*)(lds + PG8_SA(b, h) + aoff + m * 2048 + k * 1024); } while (0)
#define PG8_LDB(dst, b, h) do { _Pragma("unroll") for (int n = 0; n < 2; ++n) _Pragma("unroll") for (int k = 0; k < 2; ++k) dst[n][k] = *(const PG8_LAS bf16x8*)(lds + PG8_SB(b, h) + boff + n * 2048 + k * 1024); } while (0)
#define PG8_MMA(ai, bj, At, Bt) do { __builtin_amdgcn_s_setprio(1); _Pragma("unroll") for (int m = 0; m < 4; ++m) _Pragma("unroll") for (int n = 0; n < 2; ++n) _Pragma("unroll") for (int k = 0; k < 2; ++k) \
        acc[ai][bj][m][n] = __builtin_amdgcn_mfma_f32_16x16x32_bf16(Bt[n][k], At[m][k], acc[ai][bj][m][n], 0, 0, 0); __builtin_amdgcn_s_setprio(0); } while (0)
#define PG8_WAIT_V(n) asm volatile("s_waitcnt vmcnt(" #n ")" ::: "memory")
#define PG8_WAIT_L(n) asm volatile("s_waitcnt lgkmcnt(" #n ")" ::: "memory")
#define PG8_BAR __builtin_amdgcn_s_barrier()
#define PG8_SCHED __builtin_amdgcn_sched_barrier(0)
    Unit cur, nxt; int ui = 0;
    if (!S.next(0, cur)) return;
    f32x4 acc[2][2][4][2];
#pragma unroll
    for (int a = 0; a < 2; ++a)
#pragma unroll
        for (int b = 0; b < 2; ++b)
#pragma unroll
            for (int m = 0; m < 4; ++m)
#pragma unroll
                for (int n = 0; n < 2; ++n) acc[a][b][m][n] = (f32x4){0.f, 0.f, 0.f, 0.f};
    bf16x8 At[4][2], B0[2][2], B1[2][2];
    const char* cA = (const char*)g.A + (size_t)cur.pm * tstepA; const char* cB = (const char*)g.Bt + (size_t)cur.pn * tstepB;
    if constexpr (SP2) {
        PG8_STAGE(PG8_SB(0, 0), cB, voffB); PG8_STAGE(PG8_SB(0, 1), cB + hstepB, voffB); PG8_STAGE(PG8_SA(0, 0), cA, voffA); PG8_STAGE(PG8_SA(0, 1), cA + hstepA, voffA);
        if (wr == 1) PG8_BAR;
        PG8_WAIT_V(2); PG8_BAR;
        PG8_STAGE(PG8_SB(1, 0), cB + kstep, voffB); PG8_STAGE(PG8_SA(1, 0), cA + kstep, voffA); PG8_STAGE(PG8_SB(1, 1), cB + hstepB + kstep, voffB);
        PG8_WAIT_V(6); PG8_BAR;
    } else {
        PG8_STAGE(PG8_SB(0, 0), cB, voffB); PG8_STAGE(PG8_SA(0, 0), cA, voffA); PG8_STAGE(PG8_SB(0, 1), cB + hstepB, voffB); PG8_STAGE(PG8_SA(0, 1), cA + hstepA, voffA);
        if (wr == 1) PG8_BAR;
        PG8_WAIT_V(4); PG8_BAR;
        PG8_STAGE(PG8_SB(1, 0), cB + kstep, voffB); PG8_STAGE(PG8_SA(1, 0), cA + kstep, voffA); PG8_STAGE(PG8_SB(1, 1), cB + hstepB + kstep, voffB);
        PG8_WAIT_V(6); PG8_BAR;
    }
    for (;;) {
        const bool has_next = S.next(ui + 1, nxt);
        const char* nA = has_next ? (const char*)g.A + (size_t)nxt.pm * tstepA : cA; const char* nB = has_next ? (const char*)g.Bt + (size_t)nxt.pn * tstepB : cB;
        for (int t = 0; t < nt; t += 2) {
            const bool last = (t == nt - 2);
            const char* a1 = cA + (size_t)(t + 1) * kstep;
            const char* a2 = last ? nA : cA + (size_t)(t + 2) * kstep; const char* b2 = last ? nB : cB + (size_t)(t + 2) * kstep;
            const char* a3 = a2 + kstep; const char* b3 = b2 + kstep;
            if constexpr (Epi::MID) { if (t == (nt >> 1)) E.mid(acc, cur, wr, wc, fr, fq); }
            if constexpr (SP2) {
            PG8_LDB(B0, 0, 0); PG8_LDB(B1, 0, 1); PG8_SCHED; PG8_LDA(At, 0, 0); PG8_STAGE(PG8_SA(1, 1), a1 + hstepA, voffA);
            PG8_WAIT_V(8); PG8_WAIT_L(0); PG8_BAR; PG8_MMA(0, 0, At, B0); PG8_MMA(0, 1, At, B1); PG8_BAR; PG8_SCHED;
            PG8_LDA(At, 0, 1); PG8_STAGE(PG8_SB(0, 0), b2, voffB); PG8_STAGE(PG8_SB(0, 1), b2 + hstepB, voffB); PG8_STAGE(PG8_SA(0, 0), a2, voffA);
            PG8_WAIT_V(8); PG8_WAIT_L(0); PG8_BAR; PG8_MMA(1, 0, At, B0); PG8_MMA(1, 1, At, B1); PG8_BAR; PG8_SCHED;
            PG8_LDB(B0, 1, 0); PG8_LDB(B1, 1, 1); PG8_SCHED; PG8_LDA(At, 1, 0); PG8_STAGE(PG8_SA(0, 1), a2 + hstepA, voffA);
            PG8_WAIT_V(8); PG8_WAIT_L(0); PG8_BAR; PG8_MMA(0, 0, At, B0); PG8_MMA(0, 1, At, B1); PG8_BAR; PG8_SCHED;
            PG8_LDA(At, 1, 1); PG8_STAGE(PG8_SB(1, 0), b3, voffB); PG8_STAGE(PG8_SB(1, 1), b3 + hstepB, voffB); PG8_STAGE(PG8_SA(1, 0), a3, voffA);
            PG8_WAIT_V(8); PG8_WAIT_L(0); PG8_BAR; PG8_MMA(1, 0, At, B0); PG8_MMA(1, 1, At, B1); PG8_BAR; PG8_SCHED;
            } else {
            PG8_LDB(B0, 0, 0); PG8_SCHED; PG8_LDA(At, 0, 0); PG8_STAGE(PG8_SA(1, 1), a1 + hstepA, voffA);
            PG8_WAIT_L(8); PG8_BAR; PG8_WAIT_L(0); PG8_MMA(0, 0, At, B0); PG8_BAR; PG8_SCHED;
            PG8_LDB(B1, 0, 1); PG8_STAGE(PG8_SB(0, 0), b2, voffB);
            PG8_BAR; PG8_WAIT_L(0); PG8_MMA(0, 1, At, B1); PG8_BAR;
            PG8_LDA(At, 0, 1); PG8_STAGE(PG8_SA(0, 0), a2, voffA);
            PG8_BAR; PG8_WAIT_L(0); PG8_MMA(1, 0, At, B0); PG8_BAR; PG8_SCHED;
            PG8_STAGE(PG8_SB(0, 1), b2 + hstepB, voffB);
            PG8_WAIT_V(6); PG8_BAR; PG8_MMA(1, 1, At, B1); PG8_BAR;
            PG8_LDB(B0, 1, 0); PG8_SCHED; PG8_LDA(At, 1, 0); PG8_STAGE(PG8_SA(0, 1), a2 + hstepA, voffA);
            PG8_WAIT_L(8); PG8_BAR; PG8_WAIT_L(0); PG8_MMA(0, 0, At, B0); PG8_BAR; PG8_SCHED;
            PG8_LDB(B1, 1, 1); PG8_STAGE(PG8_SB(1, 0), b3, voffB);
            PG8_BAR; PG8_WAIT_L(0); PG8_MMA(0, 1, At, B1); PG8_BAR;
            PG8_LDA(At, 1, 1); PG8_STAGE(PG8_SA(1, 0), a3, voffA);
            PG8_BAR; PG8_WAIT_L(0); PG8_MMA(1, 0, At, B0); PG8_BAR; PG8_SCHED;
            PG8_STAGE(PG8_SB(1, 1), b3 + hstepB, voffB);
            PG8_WAIT_V(6); PG8_BAR; PG8_MMA(1, 1, At, B1); PG8_BAR;
            }
        }
        if constexpr (ALIGN_EPI) { if (wr == 0) PG8_BAR; }
        E(acc, cur, wr, wc, fr, fq);
        if (!has_next) break;
#pragma unroll
        for (int a = 0; a < 2; ++a)
#pragma unroll
            for (int b = 0; b < 2; ++b)
#pragma unroll
                for (int m = 0; m < 4; ++m)
#pragma unroll
                    for (int n = 0; n < 2; ++n) acc[a][b][m][n] = (f32x4){0.f, 0.f, 0.f, 0.f};
        cur = nxt; cA = nA; cB = nB; ++ui;
        if constexpr (ALIGN_EPI) { if (wr == 1) PG8_BAR; }
    }
    PG8_WAIT_V(0);
    if constexpr (!ALIGN_EPI) { if (wr == 0) PG8_BAR; }
    PG8_BAR;
#undef PG8_SA
#undef PG8_SB
#undef PG8_STAGE
#undef PG8_LDA
#undef PG8_LDB
#undef PG8_MMA
#undef PG8_WAIT_V
#undef PG8_WAIT_L
#undef PG8_BAR
#undef PG8_SCHED
}
}

#define LAS __attribute__((address_space(3)))
typedef unsigned short bf16_t;
typedef short bf16x8 __attribute__((ext_vector_type(8)));
typedef float f32x4 __attribute__((ext_vector_type(4)));
typedef float f32x2 __attribute__((ext_vector_type(2)));
typedef float f32x16 __attribute__((ext_vector_type(16)));
typedef unsigned u32x4 __attribute__((ext_vector_type(4)));
typedef unsigned u32x2 __attribute__((ext_vector_type(2)));

constexpr int DM = 1024, NB = 8, SEQ = 2048, MP = NB * SEQ, NSAMP = 128, TT = MP + NSAMP;
constexpr int NCH = SEQ / 128;
constexpr int PJ = 3584;
constexpr int N1 = 3840, N1V = 3600;
constexpr int DCONV = 1536, DFF = 4096;
constexpr float EPS = 1e-5f;
constexpr int XT_P = 136;

constexpr size_t MiB = 1u << 20;
constexpr size_t WS_SS5 = 0, WS_SSF = 128 * 1024, WS_CD = 384 * 1024, WS_BAR = 448 * 1024, WS_AB = 512 * 1024, WS_AQ = 576 * 1024;
constexpr size_t WS_BBT = 1 * MiB, WS_CM = 1 * MiB + 256 * 1024, WS_DT = 2 * MiB, WS_SE = 4 * MiB;
constexpr size_t WS_WIN = 8 * MiB, WS_WGLU = WS_WIN + (size_t)N1 * DM * 2, WS_WOUT = WS_WGLU + (size_t)DM * DM * 2, WS_WFF1 = WS_WOUT + (size_t)DM * 2048 * 2, WS_WFF2 = WS_WFF1 + (size_t)DFF * DM * 2;
constexpr size_t WS_XN = 38 * MiB;
constexpr size_t WS_PROJ = 71 * MiB;
constexpr size_t WS_ST = 184 * MiB;
constexpr size_t WS_HID = 71 * MiB;
constexpr size_t WS_PW = 216 * MiB, WS_A32 = 217 * MiB, WS_BBS = 217 * MiB + 256 * 1024;
constexpr size_t WS_END = 218 * MiB;
static_assert(WS_WFF2 + (size_t)DM * DFF * 2 <= WS_XN && WS_XN + (size_t)TT * DM * 2 <= WS_PROJ && WS_PROJ + (size_t)TT * PJ * 2 <= WS_ST && WS_HID + (size_t)TT * DFF * 2 <= WS_PW, "ws map");

constexpr size_t O_YS = (size_t)MP * DM, O_S5RP = O_YS + (size_t)NSAMP * DM, O_S5IP = O_S5RP + 32768, O_SSDP = O_S5IP + 32768, O_CVP = O_SSDP + 1048576,
                 O_S5RS = O_CVP + 36864, O_S5IS = O_S5RS + 524288, O_SSDS = O_S5IS + 524288, O_CVS = O_SSDS + 16777216, O_END = O_CVS + 589824;

constexpr int LDS_BYTES = 147456;

struct Args { const float* in[30]; float* out; unsigned char* ws; int ph_lo, ph_hi; };

__device__ __forceinline__ float bf2f(unsigned short b) { return __builtin_bit_cast(float, (unsigned)b << 16); }
__device__ __forceinline__ float bflo(unsigned w) { return __builtin_bit_cast(float, w << 16); }
__device__ __forceinline__ float bfhi(unsigned w) { return __builtin_bit_cast(float, w & 0xffff0000u); }
__device__ __forceinline__ unsigned pk2(float lo, float hi) { return pg8::cvt_pk_bf16(lo, hi); }
__device__ __forceinline__ float wave_sum(float v) {
#pragma unroll
    for (int o = 1; o < 64; o <<= 1) v += __shfl_xor(v, o);
    return v;
}
__device__ __forceinline__ float sigmoidf_(float v) { return __builtin_amdgcn_rcpf(1.f + __expf(-v)); }
__device__ __forceinline__ float siluf_(float v) { return v * sigmoidf_(v); }
__device__ __forceinline__ float gelu_tanh(float v) { const float u = 1.5957691216057308f * (v + 0.044715f * v * v * v); return v * sigmoidf_(u); }
__device__ __forceinline__ float softplusf_(float x) { return fmaxf(x, 0.f) + log1pf(__expf(-fabsf(x))); }
__device__ __forceinline__ float rs_from_ss(float ss, float n) { return 1.0f / sqrtf(ss / n + EPS); }

struct EpiProj {
    static constexpr bool PERM = true, MID = false;
    bf16_t* P; float* DT;
    __device__ __forceinline__ void operator()(const f32x4 (&acc)[2][2][4][2], const pg8::Unit& u, int wr, int wc, int fr, int fq) const {
        const int row0 = u.pm * 256 + wr * 64 + fr, col0 = u.pn * 256 + wc * 32 + 8 * fq;
#pragma unroll
        for (int ai = 0; ai < 2; ++ai)
#pragma unroll
            for (int m = 0; m < 4; ++m) { const int row = row0 + ai * 128 + m * 16;
#pragma unroll
                for (int bj = 0; bj < 2; ++bj) { const int col = col0 + bj * 128; const f32x4 v0 = acc[ai][bj][m][0], v1 = acc[ai][bj][m][1];
                    if (col < PJ) { u32x4 w; w.x = pk2(v0[0], v0[1]); w.y = pk2(v0[2], v0[3]); w.z = pk2(v1[0], v1[1]); w.w = pk2(v1[2], v1[3]); *(u32x4*)(P + (size_t)row * PJ + col) = w; }
                    else if (col < N1V) { float* d = DT + (size_t)row * 16 + (col - PJ); *(f32x4*)d = v0; *(f32x4*)(d + 4) = v1; } } }
    }
};
struct EpiGlu {
    static constexpr bool PERM = true, MID = false;
    const bf16_t* G; bf16_t* P; const float* bias; float* SS;
    __device__ __forceinline__ void operator()(const f32x4 (&acc)[2][2][4][2], const pg8::Unit& u, int wr, int wc, int fr, int fq) const {
        const int row0 = u.pm * 256 + wr * 64 + fr, col0 = u.pn * 256 + wc * 32 + 8 * fq;
        f32x4 bv[2][2];
#pragma unroll
        for (int bj = 0; bj < 2; ++bj) { bv[bj][0] = *(const f32x4*)(bias + col0 + bj * 128); bv[bj][1] = *(const f32x4*)(bias + col0 + bj * 128 + 4); }
#pragma unroll
        for (int ai = 0; ai < 2; ++ai)
#pragma unroll
            for (int m = 0; m < 4; ++m) { const int row = row0 + ai * 128 + m * 16; float ss = 0.f;
#pragma unroll
                for (int bj = 0; bj < 2; ++bj) { const int col = col0 + bj * 128; const u32x4 gw = *(const u32x4*)(G + (size_t)row * DM + col);
                    const f32x4 v0 = acc[ai][bj][m][0] + bv[bj][0], v1 = acc[ai][bj][m][1] + bv[bj][1]; float o[8];
                    o[0] = bflo(gw.x) * sigmoidf_(v0[0]); o[1] = bfhi(gw.x) * sigmoidf_(v0[1]); o[2] = bflo(gw.y) * sigmoidf_(v0[2]); o[3] = bfhi(gw.y) * sigmoidf_(v0[3]);
                    o[4] = bflo(gw.z) * sigmoidf_(v1[0]); o[5] = bfhi(gw.z) * sigmoidf_(v1[1]); o[6] = bflo(gw.w) * sigmoidf_(v1[2]); o[7] = bfhi(gw.w) * sigmoidf_(v1[3]);
#pragma unroll
                    for (int i = 0; i < 8; ++i) ss += o[i] * o[i];
                    u32x4 w; w.x = pk2(o[0], o[1]); w.y = pk2(o[2], o[3]); w.z = pk2(o[4], o[5]); w.w = pk2(o[6], o[7]); *(u32x4*)(P + (size_t)row * PJ + col) = w; }
                ss += __shfl_xor(ss, 16); ss += __shfl_xor(ss, 32);
                if (fq == 0) atomicAdd(SS + row, ss); }
    }
};
struct EpiOut {
    static constexpr bool PERM = true, MID = true;
    const float* X; float* X1; bf16_t* X1B; float* SSF; const float* SS5;
    __device__ __forceinline__ void mid(f32x4 (&acc)[2][2][4][2], const pg8::Unit& u, int wr, int wc, int fr, int fq) const {
        const int row0 = u.pm * 256 + wr * 64 + fr;
#pragma unroll
        for (int ai = 0; ai < 2; ++ai)
#pragma unroll
            for (int m = 0; m < 4; ++m) { const float s = rs_from_ss(SS5[row0 + ai * 128 + m * 16], 1024.f);
#pragma unroll
                for (int bj = 0; bj < 2; ++bj) { acc[ai][bj][m][0] *= s; acc[ai][bj][m][1] *= s; } }
    }
    __device__ __forceinline__ void operator()(const f32x4 (&acc)[2][2][4][2], const pg8::Unit& u, int wr, int wc, int fr, int fq) const {
        const int row0 = u.pm * 256 + wr * 64 + fr, col0 = u.pn * 256 + wc * 32 + 8 * fq;
#pragma unroll
        for (int ai = 0; ai < 2; ++ai)
#pragma unroll
            for (int m = 0; m < 4; ++m) { const int row = row0 + ai * 128 + m * 16; float ss = 0.f;
#pragma unroll
                for (int bj = 0; bj < 2; ++bj) { const size_t off = (size_t)row * DM + col0 + bj * 128;
                    const f32x4 v0 = *(const f32x4*)(X + off) + acc[ai][bj][m][0], v1 = *(const f32x4*)(X + off + 4) + acc[ai][bj][m][1];
                    ss += (v0[0] * v0[0] + v0[1] * v0[1]) + (v0[2] * v0[2] + v0[3] * v0[3]) + (v1[0] * v1[0] + v1[1] * v1[1]) + (v1[2] * v1[2] + v1[3] * v1[3]);
                    *(f32x4*)(X1 + off) = v0; *(f32x4*)(X1 + off + 4) = v1;
                    u32x4 w; w.x = pk2(v0[0], v0[1]); w.y = pk2(v0[2], v0[3]); w.z = pk2(v1[0], v1[1]); w.w = pk2(v1[2], v1[3]); *(u32x4*)(X1B + off) = w; }
                ss += __shfl_xor(ss, 16); ss += __shfl_xor(ss, 32);
                if (fq == 0) atomicAdd(SSF + row, ss); }
    }
};
struct EpiFF1 {
    static constexpr bool PERM = true, MID = false;
    bf16_t* H; const float* SSF;
    __device__ __forceinline__ void operator()(const f32x4 (&acc)[2][2][4][2], const pg8::Unit& u, int wr, int wc, int fr, int fq) const {
        const int row0 = u.pm * 256 + wr * 64 + fr, col0 = u.pn * 256 + wc * 32 + 8 * fq;
#pragma unroll
        for (int ai = 0; ai < 2; ++ai)
#pragma unroll
            for (int m = 0; m < 4; ++m) { const int row = row0 + ai * 128 + m * 16; const float s = rs_from_ss(SSF[row], 1024.f);
#pragma unroll
                for (int bj = 0; bj < 2; ++bj) { f32x4 v0 = acc[ai][bj][m][0] * s, v1 = acc[ai][bj][m][1] * s;
#pragma unroll
                    for (int i = 0; i < 4; ++i) { const float a = fmaxf(v0[i], 0.f), b = fmaxf(v1[i], 0.f); v0[i] = a * a; v1[i] = b * b; }
                    u32x4 w; w.x = pk2(v0[0], v0[1]); w.y = pk2(v0[2], v0[3]); w.z = pk2(v1[0], v1[1]); w.w = pk2(v1[2], v1[3]); *(u32x4*)(H + (size_t)row * DFF + col0 + bj * 128) = w; } }
    }
};
struct EpiFF2 {
    static constexpr bool PERM = true, MID = false;
    float* X1;
    __device__ __forceinline__ void operator()(const f32x4 (&acc)[2][2][4][2], const pg8::Unit& u, int wr, int wc, int fr, int fq) const {
        const int row0 = u.pm * 256 + wr * 64 + fr, col0 = u.pn * 256 + wc * 32 + 8 * fq;
#pragma unroll
        for (int ai = 0; ai < 2; ++ai)
#pragma unroll
            for (int m = 0; m < 4; ++m) { const int row = row0 + ai * 128 + m * 16;
#pragma unroll
                for (int bj = 0; bj < 2; ++bj) { float* p = X1 + (size_t)row * DM + col0 + bj * 128;
                    const f32x4 v0 = *(const f32x4*)p + acc[ai][bj][m][0], v1 = *(const f32x4*)(p + 4) + acc[ai][bj][m][1]; *(f32x4*)p = v0; *(f32x4*)(p + 4) = v1; } }
    }
};

template <class F>
__device__ __forceinline__ void skinny_gemm(LAS unsigned char* lds, const bf16_t* A, int lda, const bf16_t* Bt, int ldb, int K, int nct, const F& f) {
    const int tid = threadIdx.x, wid = tid >> 6, lane = tid & 63;
    LAS float* red = (LAS float*)lds;
    const int nunits = 4 * nct, kw = K >> 3;
    for (int u = blockIdx.x; u < nunits; u += gridDim.x) {
        const int rt = u & 3, ct = u >> 2;
        const bf16_t* ap = A + (size_t)(rt * 32 + (lane & 31)) * lda + wid * kw + (lane >> 5) * 8;
        const bf16_t* bp = Bt + (size_t)(ct * 32 + (lane & 31)) * ldb + wid * kw + (lane >> 5) * 8;
        f32x16 acc;
#pragma unroll
        for (int i = 0; i < 16; ++i) acc[i] = 0.f;
#pragma unroll 8
        for (int kk = 0; kk < kw; kk += 16) { const bf16x8 a = *(const bf16x8*)(ap + kk), b = *(const bf16x8*)(bp + kk); acc = __builtin_amdgcn_mfma_f32_32x32x16_bf16(a, b, acc, 0, 0, 0); }
#pragma unroll
        for (int r = 0; r < 16; ++r) red[wid * 1056 + ((r & 3) + 8 * (r >> 2) + 4 * (lane >> 5)) * 33 + (lane & 31)] = acc[r];
        __syncthreads();
        const int row = tid >> 4, c = (tid & 15) * 2;
        float lo0 = 0.f, lo1 = 0.f, hi0 = 0.f, hi1 = 0.f;
#pragma unroll
        for (int w = 0; w < 4; ++w) { lo0 += red[w * 1056 + row * 33 + c]; lo1 += red[w * 1056 + row * 33 + c + 1]; hi0 += red[(w + 4) * 1056 + row * 33 + c]; hi1 += red[(w + 4) * 1056 + row * 33 + c + 1]; }
        f(rt * 32 + row, ct * 32 + c, lo0, hi0, lo1, hi1);
        __syncthreads();
    }
}
__device__ __forceinline__ float red16(float v) { v += __shfl_xor(v, 1); v += __shfl_xor(v, 2); v += __shfl_xor(v, 4); v += __shfl_xor(v, 8); return v; }

__device__ __forceinline__ void p0_transpose_item(const float* W, int K, int Nsrc, int N, bf16_t* WT, const float* gain, LAS float* scr, int item, int lane) {
    const int nblk = N / 32, kb = item / nblk, nb = item % nblk, k0 = 64 * kb, n0 = 32 * nb;
    const int n = n0 + (lane & 31); const bool ok = n < Nsrc;
#pragma unroll 8
    for (int i = 0; i < 32; ++i) { const int kk = 2 * i + (lane >> 5); float v = ok ? W[(size_t)(k0 + kk) * Nsrc + n] : 0.f; if (gain) v *= gain[k0 + kk]; scr[kk * 33 + (lane & 31)] = v; }
    asm volatile("s_waitcnt lgkmcnt(0)" ::: "memory");
    const int c = lane & 7;
#pragma unroll
    for (int j = 0; j < 4; ++j) { const int nn = (lane >> 3) + 8 * j; const LAS float* s = scr + (8 * c) * 33 + nn;
        u32x4 o; o.x = pk2(s[0 * 33], s[1 * 33]); o.y = pk2(s[2 * 33], s[3 * 33]); o.z = pk2(s[4 * 33], s[5 * 33]); o.w = pk2(s[6 * 33], s[7 * 33]);
        *(u32x4*)(WT + (size_t)(n0 + nn) * K + k0 + 8 * c) = o; }
    asm volatile("s_waitcnt lgkmcnt(0)" ::: "memory");
}

__device__ __forceinline__ void conv4x4(const bf16_t* xcol, long rowg, bool zero_hist3, const float* cw, const float* cbias, int ch, float (&out)[4][4]) {
    float xin[7][4];
#pragma unroll
    for (int rr = 0; rr < 7; ++rr) {
        if (rr < 3 && zero_hist3) { xin[rr][0] = xin[rr][1] = xin[rr][2] = xin[rr][3] = 0.f; }
        else { const u32x2 w = *(const u32x2*)(xcol + (rowg - 3 + rr) * PJ); xin[rr][0] = bflo(w.x); xin[rr][1] = bfhi(w.x); xin[rr][2] = bflo(w.y); xin[rr][3] = bfhi(w.y); }
    }
    const f32x4 b = *(const f32x4*)(cbias + ch);
    f32x4 w[4];
#pragma unroll
    for (int k = 0; k < 4; ++k) w[k] = *(const f32x4*)(cw + k * DCONV + ch);
#pragma unroll
    for (int i = 0; i < 4; ++i)
#pragma unroll
        for (int j = 0; j < 4; ++j) { float v = b[j];
#pragma unroll
            for (int k = 0; k < 4; ++k) v += w[k][j] * xin[i + k][j];
            out[i][j] = siluf_(v); }
}

__device__ __forceinline__ void ssd_dt_acum(LAS float* dtv, LAS float* acu, const float* DT, long r0, int g, const float* dt_bias, const float* a_log, int wid, int lane) {
    const int h = g * 8 + wid; const float bias = dt_bias[h], A = -__expf(a_log[h]); const int t0 = 2 * lane;
    const float d0 = softplusf_(DT[(r0 + t0) * 16 + h] + bias), d1 = softplusf_(DT[(r0 + t0 + 1) * 16 + h] + bias);
    const float a0 = d0 * A, s = a0 + d1 * A; float inc = s;
#pragma unroll
    for (int o = 1; o < 64; o <<= 1) { const float v = __shfl_up(inc, o); if (lane >= o) inc += v; }
    const float exc = inc - s;
    dtv[wid * 128 + t0] = d0; dtv[wid * 128 + t0 + 1] = d1; acu[wid * 128 + t0] = exc + a0; acu[wid * 128 + t0 + 1] = exc + s;
}

struct Frame {
    const float* in[30]; float* out; unsigned char* ws;
    bf16_t *WIN, *WGLU, *WOUT, *WFF1, *WFF2, *XN, *PROJ, *ST, *HID, *BBT, *CM;
    float *SS5, *SSF, *CD, *DT; f32x2 *AB, *AQ, *SE, *PW, *A32; bf16_t* BBS;
};
#define MFMA16(a, b, c) __builtin_amdgcn_mfma_f32_16x16x32_bf16((a), (b), (c), 0, 0, 0)
#define MFMA32(a, b, c) __builtin_amdgcn_mfma_f32_32x32x16_bf16((a), (b), (c), 0, 0, 0)

__device__ __forceinline__ void ssd_states_tile(LAS unsigned char* lds, const Frame& F, int b, int c, int g) {
    const int tid = threadIdx.x, wid = __builtin_amdgcn_readfirstlane(tid >> 6), lane = tid & 63, fr = lane & 15, fq = lane >> 4;
    LAS bf16_t* Bt = (LAS bf16_t*)lds; LAS bf16_t* Xt = (LAS bf16_t*)(lds + 34816);
    LAS float* dtv = (LAS float*)(lds + 52224); LAS float* acu = dtv + 1024;
    const long r0 = (long)b * SEQ + c * 128;
    const float* cw = F.in[19]; const float* cbias = F.in[20];
    ssd_dt_acum(dtv, acu, F.DT, r0, g, F.in[22], F.in[21], wid, lane);
#pragma unroll 1
    for (int q = tid; q < 1024; q += 512) { const int cgp = q & 31, tg = q >> 5, ch = 1024 + g * 128 + cgp * 4; float o[4][4];
        conv4x4(F.PROJ + 2048 + ch, r0 + tg * 4, c == 0 && tg == 0, cw, cbias, ch, o);
#pragma unroll
        for (int j = 0; j < 4; ++j) *(LAS u32x2*)(Bt + (cgp * 4 + j) * XT_P + tg * 4) = (u32x2){pk2(o[0][j], o[1][j]), pk2(o[2][j], o[3][j])}; }
    __syncthreads();
#pragma unroll 1
    for (int hh = 0; hh < 8; ++hh) { const int h = g * 8 + hh; const float a_last = acu[hh * 128 + 127];
        { const int cgp = tid & 15, tg = tid >> 4, ch = h * 64 + cgp * 4; float o[4][4], f[4];
          conv4x4(F.PROJ + 2048 + ch, r0 + tg * 4, c == 0 && tg == 0, cw, cbias, ch, o);
#pragma unroll
          for (int i = 0; i < 4; ++i) f[i] = dtv[hh * 128 + tg * 4 + i] * __expf(a_last - acu[hh * 128 + tg * 4 + i]);
#pragma unroll
          for (int j = 0; j < 4; ++j) *(LAS u32x2*)(Xt + (cgp * 4 + j) * XT_P + tg * 4) = (u32x2){pk2(o[0][j] * f[0], o[1][j] * f[1]), pk2(o[2][j] * f[2], o[3][j] * f[3])}; }
        __syncthreads();
        f32x4 acc[4];
#pragma unroll
        for (int i = 0; i < 4; ++i) acc[i] = (f32x4){0.f, 0.f, 0.f, 0.f};
#pragma unroll
        for (int ks = 0; ks < 4; ++ks) { const bf16x8 bfr = *(const LAS bf16x8*)(Bt + (16 * wid + fr) * XT_P + ks * 32 + fq * 8);
#pragma unroll
            for (int i = 0; i < 4; ++i) { const bf16x8 afr = *(const LAS bf16x8*)(Xt + (16 * i + fr) * XT_P + ks * 32 + fq * 8); acc[i] = MFMA16(bfr, afr, acc[i]); } }
        bf16_t* st = F.ST + ((size_t)((b * 16 + c) * 16 + h) * 64) * 128;
#pragma unroll
        for (int i = 0; i < 4; ++i) *(u32x2*)(st + (size_t)(16 * i + fr) * 128 + 16 * wid + 4 * fq) = (u32x2){pk2(acc[i][0], acc[i][1]), pk2(acc[i][2], acc[i][3])};
        if (tid == 0) F.CD[(b * 16 + c) * 16 + h] = __expf(a_last);
        __syncthreads();
    }
    if (c == NCH - 1) {
        for (int e = tid; e < 3 * 768; e += 512) { const int k = e / 768, ch = g * 768 + e % 768;
            F.out[O_CVP + (size_t)(b * 3 + k) * DCONV + ch] = bf2f(F.PROJ[(size_t)(b * SEQ + SEQ - 3 + k) * PJ + 2048 + ch]); }
    }
}

__device__ __forceinline__ void ssd_y_tile(LAS unsigned char* lds, const Frame& F, int b, int c, int g) {
    const int tid = threadIdx.x, wid = __builtin_amdgcn_readfirstlane(tid >> 6), lane = tid & 63, fr = lane & 15, fq = lane >> 4;
    LAS bf16_t* Bs = (LAS bf16_t*)lds; LAS bf16_t* Ps = Bs; LAS bf16_t* Cs = (LAS bf16_t*)(lds + 34816);
    LAS bf16_t* Xt = (LAS bf16_t*)(lds + 69632); LAS bf16_t* Hs = (LAS bf16_t*)(lds + 87040);
    LAS float* dtv = (LAS float*)(lds + 104448); LAS float* acu = dtv + 1024;
    const long r0 = (long)b * SEQ + c * 128;
    const float* cw = F.in[19]; const float* cbias = F.in[20];
    ssd_dt_acum(dtv, acu, F.DT, r0, g, F.in[22], F.in[21], wid, lane);
#pragma unroll 1
    for (int q = tid; q < 2048; q += 512) { const int qq = q & 1023, cgp = qq & 31, tg = qq >> 5, isC = q >> 10, ch = 1024 + isC * 256 + g * 128 + cgp * 4; float o[4][4];
        conv4x4(F.PROJ + 2048 + ch, r0 + tg * 4, c == 0 && tg == 0, cw, cbias, ch, o);
        LAS bf16_t* dst = isC ? Cs : Bs;
#pragma unroll
        for (int i = 0; i < 4; ++i) *(LAS u32x2*)(dst + (tg * 4 + i) * XT_P + cgp * 4) = (u32x2){pk2(o[i][0], o[i][1]), pk2(o[i][2], o[i][3])}; }
    __syncthreads();
    f32x4 cb[8]; bf16x8 cfr[4];
#pragma unroll
    for (int st = 0; st < 8; ++st) cb[st] = (f32x4){0.f, 0.f, 0.f, 0.f};
#pragma unroll
    for (int ks = 0; ks < 4; ++ks) cfr[ks] = *(const LAS bf16x8*)(Cs + (16 * wid + fr) * XT_P + ks * 32 + fq * 8);
#pragma unroll
    for (int st = 0; st < 8; ++st) if (st <= wid) {
#pragma unroll
        for (int ks = 0; ks < 4; ++ks) { const bf16x8 bfr = *(const LAS bf16x8*)(Bs + (16 * st + fr) * XT_P + ks * 32 + fq * 8); cb[st] = MFMA16(bfr, cfr[ks], cb[st]); } }
    __syncthreads();
    float ss = 0.f; const int l = 16 * wid + fr;
    bf16_t* zrow = F.PROJ + (size_t)(r0 + l) * PJ + 1024 + g * 512 + 4 * fq;
#pragma unroll 1
    for (int hh = 0; hh < 8; ++hh) { const int h = g * 8 + hh;
        { const int cgp = tid & 15, tg = tid >> 4, ch = h * 64 + cgp * 4; float o[4][4], f[4];
          conv4x4(F.PROJ + 2048 + ch, r0 + tg * 4, c == 0 && tg == 0, cw, cbias, ch, o);
#pragma unroll
          for (int i = 0; i < 4; ++i) f[i] = dtv[hh * 128 + tg * 4 + i];
#pragma unroll
          for (int j = 0; j < 4; ++j) *(LAS u32x2*)(Xt + (cgp * 4 + j) * XT_P + tg * 4) = (u32x2){pk2(o[0][j] * f[0], o[1][j] * f[1]), pk2(o[2][j] * f[2], o[3][j] * f[3])}; }
        { const int e = tid * 16, p = e >> 7, n0 = e & 127; const bf16_t* src = F.ST + ((size_t)((b * 16 + c) * 16 + h) * 64 + p) * 128 + n0;
          const u32x4 v0 = *(const u32x4*)src, v1 = *(const u32x4*)(src + 8); *(LAS u32x4*)(Hs + p * XT_P + n0) = v0; *(LAS u32x4*)(Hs + p * XT_P + n0 + 8) = v1; }
        const float al = acu[hh * 128 + l];
#pragma unroll
        for (int st = 0; st < 8; ++st) if (st <= (wid | 1)) { const int s0 = 16 * st + 4 * fq; float v[4];
#pragma unroll
            for (int j = 0; j < 4; ++j) v[j] = (s0 + j <= l) ? cb[st][j] * __expf(al - acu[hh * 128 + s0 + j]) : 0.f;
            *(LAS u32x2*)(Ps + l * XT_P + s0) = (u32x2){pk2(v[0], v[1]), pk2(v[2], v[3])}; }
        __syncthreads();
        f32x4 accY[4], accO[4];
#pragma unroll
        for (int i = 0; i < 4; ++i) { accY[i] = (f32x4){0.f, 0.f, 0.f, 0.f}; accO[i] = (f32x4){0.f, 0.f, 0.f, 0.f}; }
#pragma unroll
        for (int ks = 0; ks < 4; ++ks) {
            if (ks <= (wid >> 1)) { const bf16x8 pfr = *(const LAS bf16x8*)(Ps + l * XT_P + ks * 32 + fq * 8);
#pragma unroll
                for (int pt = 0; pt < 4; ++pt) { const bf16x8 xfr = *(const LAS bf16x8*)(Xt + (16 * pt + fr) * XT_P + ks * 32 + fq * 8); accY[pt] = MFMA16(xfr, pfr, accY[pt]); } }
#pragma unroll
            for (int pt = 0; pt < 4; ++pt) { const bf16x8 hfr = *(const LAS bf16x8*)(Hs + (16 * pt + fr) * XT_P + ks * 32 + fq * 8); accO[pt] = MFMA16(hfr, cfr[ks], accO[pt]); } }
        const float el = __expf(al), rdt = 1.0f / dtv[hh * 128 + l], Dh = F.in[23][h];
#pragma unroll
        for (int pt = 0; pt < 4; ++pt) { bf16_t* zp = zrow + hh * 64 + 16 * pt; const u32x2 zw = *(const u32x2*)zp;
            const float z[4] = {bflo(zw.x), bfhi(zw.x), bflo(zw.y), bfhi(zw.y)}; float y[4];
#pragma unroll
            for (int j = 0; j < 4; ++j) { const float xs = bf2f(Xt[(16 * pt + 4 * fq + j) * XT_P + l]) * rdt; y[j] = (accY[pt][j] + el * accO[pt][j] + Dh * xs) * siluf_(z[j]); ss += y[j] * y[j]; }
            *(u32x2*)zp = (u32x2){pk2(y[0], y[1]), pk2(y[2], y[3])}; }
        __syncthreads();
    }
    ss += __shfl_xor(ss, 16); ss += __shfl_xor(ss, 32);
    const float rs = rs_from_ss(ss, 512.f);
    asm volatile("s_waitcnt vmcnt(0)" ::: "memory");
#pragma unroll 4
    for (int i = 0; i < 32; ++i) { bf16_t* zp = zrow + 16 * i; const u32x2 w = *(const u32x2*)zp;
        *(u32x2*)zp = (u32x2){pk2(bflo(w.x) * rs, bfhi(w.x) * rs), pk2(bflo(w.y) * rs, bfhi(w.y) * rs)}; }
}

__device__ __forceinline__ void s5_pass_a(const Frame& F, int gw, int NGW, int lane) {
    const int p0 = lane & 31, half = lane >> 5;
#pragma unroll 1
    for (int job = gw; job < NB * NCH * 64; job += NGW) { const int g = job & 63, bc = job >> 6;
        const bf16_t* ap = F.PROJ + (size_t)(bc * 128 + p0) * PJ + g * 16 + half * 8;
        bf16x8 afr[4];
#pragma unroll
        for (int rt = 0; rt < 4; ++rt) afr[rt] = *(const bf16x8*)(ap + (size_t)rt * 32 * PJ);
        float sr[2], si[2];
#pragma unroll
        for (int pp = 0; pp < 2; ++pp) { const int p = p0 + 32 * pp;
            const bf16x8 bre = *(const bf16x8*)(F.BBS + (size_t)(g * 128 + p) * 16 + half * 8), bim = *(const bf16x8*)(F.BBS + (size_t)(g * 128 + 64 + p) * 16 + half * 8);
            f32x2 w[16];
#pragma unroll
            for (int r = 0; r < 16; ++r) w[r] = F.PW[(size_t)((g * 2 + half) * 16 + r) * 64 + p];
            const f32x2 q = F.A32[g * 64 + p];
            float s_r = 0.f, s_i = 0.f;
#pragma unroll
            for (int rt = 0; rt < 4; ++rt) { f32x16 z;
#pragma unroll
                for (int r = 0; r < 16; ++r) z[r] = 0.f;
                const f32x16 are = MFMA32(afr[rt], bre, z), aim = MFMA32(afr[rt], bim, z);
                float tr = 0.f, ti = 0.f;
#pragma unroll
                for (int r = 0; r < 16; ++r) { tr += w[r].x * are[r] - w[r].y * aim[r]; ti += w[r].x * aim[r] + w[r].y * are[r]; }
                tr += __shfl_xor(tr, 32); ti += __shfl_xor(ti, 32);
                const float nr = q.x * s_r - q.y * s_i + tr, ni = q.x * s_i + q.y * s_r + ti; s_r = nr; s_i = ni; }
            sr[pp] = s_r; si[pp] = s_i; __builtin_amdgcn_sched_barrier(0); }
        F.SE[((size_t)((bc >> 4) * 64 + g) * 16 + (bc & 15)) * 64 + lane] = half ? (f32x2){sr[1], si[1]} : (f32x2){sr[0], si[0]};
    }
}
__device__ __forceinline__ void s5_pass_b(LAS unsigned char* wl, const Frame& F, int gw, int NGW, int lane) {
    int gcur = -1; bf16x8 bfr[4], cfr[4]; f32x4 d4; f32x2 a;
#pragma unroll 1
    for (int job = gw; job < NB * NCH * 64; job += NGW) { const int g = job & 63, bc = job >> 6;
        if (g != gcur) { gcur = g;
#pragma unroll
            for (int j = 0; j < 4; ++j) bfr[j] = *(const bf16x8*)(F.BBT + (size_t)(g * 128 + j * 32 + (lane & 31)) * 16 + (lane >> 5) * 8);
#pragma unroll
            for (int ks = 0; ks < 4; ++ks) cfr[ks] = *(const bf16x8*)(F.CM + (size_t)(g * 16 + (lane & 15)) * 128 + ks * 32 + (lane >> 4) * 8);
            d4 = *(const f32x4*)(F.in[15] + g * 16 + 4 * (lane >> 4)); a = F.AB[g * 64 + lane]; }
        const size_t r0 = (size_t)bc * 128;
        const bf16_t* ap = F.PROJ + (r0 + (lane & 31)) * PJ + g * 16 + (lane >> 5) * 8;
        const bf16_t* up = F.PROJ + (r0 + (lane & 15)) * PJ + g * 16 + 4 * (lane >> 4);
        bf16x8 afr[4]; u32x2 uw[8];
#pragma unroll
        for (int rt = 0; rt < 4; ++rt) afr[rt] = *(const bf16x8*)(ap + (size_t)rt * 32 * PJ);
#pragma unroll
        for (int i = 0; i < 8; ++i) uw[i] = *(const u32x2*)(up + (size_t)i * 16 * PJ);
        const f32x2 h0 = F.SE[((size_t)((bc >> 4) * 64 + g) * 16 + (bc & 15)) * 64 + lane]; float hr = h0.x, hi = h0.y;
#pragma unroll
        for (int rt = 0; rt < 4; ++rt) {
#pragma unroll
            for (int j = 0; j < 4; ++j) { f32x16 acc;
#pragma unroll
                for (int r = 0; r < 16; ++r) acc[r] = 0.f;
                acc = MFMA32(afr[rt], bfr[j], acc);
#pragma unroll
                for (int r = 0; r < 16; ++r) *(LAS float*)(wl + ((r & 3) + 8 * (r >> 2) + 4 * (lane >> 5)) * 528 + (j * 32 + (lane & 31)) * 4) = acc[r]; }
#pragma unroll 8
            for (int t = 0; t < 32; ++t) { const f32x2 bu = *(const LAS f32x2*)(wl + t * 528 + lane * 8);
                const float nr = a.x * hr - a.y * hi + bu.x, ni = a.x * hi + a.y * hr + bu.y; hr = nr; hi = ni;
                *(LAS unsigned*)(wl + t * 528 + lane * 4) = pk2(hr, hi); }
#pragma unroll
            for (int half = 0; half < 2; ++half) { f32x4 accy = (f32x4){0.f, 0.f, 0.f, 0.f};
#pragma unroll
                for (int ks = 0; ks < 4; ++ks) { const bf16x8 hfr = *(const LAS bf16x8*)(wl + (half * 16 + (lane & 15)) * 528 + (ks * 32 + (lane >> 4) * 8) * 2); accy = MFMA16(cfr[ks], hfr, accy); }
                const size_t row = r0 + rt * 32 + half * 16 + (lane & 15); const u32x2 u2 = uw[rt * 2 + half];
                const float y0 = gelu_tanh(accy[0] + d4[0] * bflo(u2.x)), y1 = gelu_tanh(accy[1] + d4[1] * bfhi(u2.x)), y2 = gelu_tanh(accy[2] + d4[2] * bflo(u2.y)), y3 = gelu_tanh(accy[3] + d4[3] * bfhi(u2.y));
                *(u32x2*)(F.XN + row * DM + g * 16 + 4 * (lane >> 4)) = (u32x2){pk2(y0, y1), pk2(y2, y3)}; }
        }
    }
}

__device__ __forceinline__ void s5_sample_job(const Frame& F, int bs, int g, int lane) {
    const size_t row = (size_t)MP + bs;
    const bf16_t* up = F.PROJ + row * PJ + g * 16;
    const u32x4 u0 = *(const u32x4*)up, u1 = *(const u32x4*)(up + 8);
    const float u[16] = {bflo(u0.x), bfhi(u0.x), bflo(u0.y), bfhi(u0.y), bflo(u0.z), bfhi(u0.z), bflo(u0.w), bfhi(u0.w), bflo(u1.x), bfhi(u1.x), bflo(u1.y), bfhi(u1.y), bflo(u1.z), bfhi(u1.z), bflo(u1.w), bfhi(u1.w)};
    const bf16_t* bp = F.BBT + (size_t)(g * 128 + 2 * lane) * 16;
    float bre = 0.f, bim = 0.f;
#pragma unroll
    for (int q = 0; q < 2; ++q) { const u32x4 wr_ = *(const u32x4*)(bp + q * 8), wi_ = *(const u32x4*)(bp + 16 + q * 8);
        bre += bflo(wr_.x) * u[q * 8 + 0] + bfhi(wr_.x) * u[q * 8 + 1] + bflo(wr_.y) * u[q * 8 + 2] + bfhi(wr_.y) * u[q * 8 + 3] + bflo(wr_.z) * u[q * 8 + 4] + bfhi(wr_.z) * u[q * 8 + 5] + bflo(wr_.w) * u[q * 8 + 6] + bfhi(wr_.w) * u[q * 8 + 7];
        bim += bflo(wi_.x) * u[q * 8 + 0] + bfhi(wi_.x) * u[q * 8 + 1] + bflo(wi_.y) * u[q * 8 + 2] + bfhi(wi_.y) * u[q * 8 + 3] + bflo(wi_.z) * u[q * 8 + 4] + bfhi(wi_.z) * u[q * 8 + 5] + bflo(wi_.w) * u[q * 8 + 6] + bfhi(wi_.w) * u[q * 8 + 7]; }
    const size_t si = (size_t)(bs * 64 + g) * 64 + lane;
    const float h0r = F.in[2][si], h0i = F.in[3][si]; const f32x2 a = F.AB[g * 64 + lane];
    const float hr = a.x * h0r - a.y * h0i + bre, hi = a.x * h0i + a.y * h0r + bim;
    F.out[O_S5RS + si] = hr; F.out[O_S5IS + si] = hi;
    float yv = 0.f;
#pragma unroll
    for (int c = 0; c < 16; ++c) { const unsigned cm = *(const unsigned*)(F.CM + (size_t)(g * 16 + c) * 128 + 2 * lane); const float tot = wave_sum(bflo(cm) * hr + bfhi(cm) * hi); if (lane == c) yv = tot; }
    if (lane < 16) { const float y = gelu_tanh(yv + F.in[15][g * 16 + lane] * bf2f(up[lane])); F.XN[row * DM + g * 16 + lane] = (bf16_t)(pk2(y, 0.f) & 0xffffu); }
}

__device__ __forceinline__ float conv1_sample(const Frame& F, int bs, int ch, bool write_state) {
    const float* sc = F.in[5] + (size_t)bs * 3 * DCONV + ch;
    const float x0 = sc[0], x1 = sc[DCONV], x2 = sc[2 * DCONV], x3 = bf2f(F.PROJ[((size_t)MP + bs) * PJ + 2048 + ch]);
    const float* cw = F.in[19] + ch;
    const float v = F.in[20][ch] + cw[0] * x0 + cw[DCONV] * x1 + cw[2 * DCONV] * x2 + cw[3 * DCONV] * x3;
    if (write_state) { float* o = F.out + O_CVS + (size_t)bs * 3 * DCONV + ch; o[0] = x1; o[DCONV] = x2; o[2 * DCONV] = x3; }
    return siluf_(v);
}
__device__ __forceinline__ void ssd_sample_job(LAS unsigned char* lds, const Frame& F, int bs, int g) {
    const int tid = threadIdx.x, wid = __builtin_amdgcn_readfirstlane(tid >> 6), lane = tid & 63, h = g * 8 + wid;
    LAS float* red = (LAS float*)lds;
    const size_t row = (size_t)MP + bs;
    const float xs = conv1_sample(F, bs, h * 64 + lane, true);
    const float B0 = conv1_sample(F, bs, 1024 + g * 128 + 2 * lane, wid == 0), B1 = conv1_sample(F, bs, 1024 + g * 128 + 2 * lane + 1, wid == 0);
    const float C0 = conv1_sample(F, bs, 1280 + g * 128 + 2 * lane, wid == 0), C1 = conv1_sample(F, bs, 1280 + g * 128 + 2 * lane + 1, wid == 0);
    const float dt = softplusf_(F.DT[row * 16 + h] + F.in[22][h]), dA = __expf(-dt * __expf(F.in[21][h]));
    const float* sp = F.in[4] + ((size_t)(bs * 16 + h) * 64) * 128 + 2 * lane;
    float* op = F.out + O_SSDS + ((size_t)(bs * 16 + h) * 64) * 128 + 2 * lane;
    float y = 0.f;
#pragma unroll 8
    for (int p = 0; p < 64; ++p) { const float xp = __shfl(xs, p) * dt; const f32x2 h0 = *(const f32x2*)(sp + p * 128);
        const f32x2 hn = (f32x2){dA * h0.x + xp * B0, dA * h0.y + xp * B1}; *(f32x2*)(op + p * 128) = hn;
        const float tot = wave_sum(C0 * hn.x + C1 * hn.y); if (lane == p) y = tot; }
    bf16_t* zp = F.PROJ + row * PJ + 1024 + h * 64 + lane;
    y = (y + F.in[23][h] * xs) * siluf_(bf2f(*zp));
    const float ssw = wave_sum(y * y);
    if (lane == 0) red[wid] = ssw;
    __syncthreads();
    float tot = 0.f;
#pragma unroll
    for (int w = 0; w < 8; ++w) tot += red[w];
    *zp = (bf16_t)(pk2(y * rs_from_ss(tot, 512.f), 0.f) & 0xffffu);
    __syncthreads();
}


#define XB_TMO      128
#define XB_XCNT(j)  (256  + 64 * (j))
#define XB_XSUB(j)  (1280 + 64 * (j))
#define XB_XGEN(j)  (2304 + 64 * (j))
#define XB_TOP      3328
#define XB_TOPGEN   3392
#define XCD_BAR_WORDS 3456
#define XB_SPIN_CAP (1u << 18)
__device__ __forceinline__ unsigned xb_ld(unsigned* p)              { return __hip_atomic_load(p, __ATOMIC_RELAXED, __HIP_MEMORY_SCOPE_AGENT); }
__device__ __forceinline__ unsigned xb_add(unsigned* p, unsigned v) { return __hip_atomic_fetch_add(p, v, __ATOMIC_RELAXED, __HIP_MEMORY_SCOPE_AGENT); }
__device__ __forceinline__ unsigned xb_xcc_id() { return (unsigned)__builtin_amdgcn_s_getreg((3 << 11) | 20) & 0xFu; }
#define XB_SPIN(cond, bar) do { unsigned _sp = 0; while (cond) { __builtin_amdgcn_s_sleep(1); \
    if ((++_sp & 255u) == 0u) { if (xb_ld(&(bar)[XB_TMO])) break; if (_sp > XB_SPIN_CAP) { atomicAdd(&(bar)[XB_TMO], 1u); break; } } } } while (0)
struct XcdBarrier { unsigned* bar; unsigned x; volatile LAS unsigned* st; };
__device__ __forceinline__ XcdBarrier xcd_barrier_post(unsigned* bar, volatile LAS unsigned* st) {
    XcdBarrier b; b.bar = bar; b.x = xb_xcc_id(); b.st = st;
    if (threadIdx.x == 0) (void)xb_add(&bar[XB_XCNT(b.x)], 1u);
    return b;
}
__device__ __forceinline__ void xcd_barrier_complete(unsigned* bar, unsigned x, unsigned& nloc, unsigned& nx) {
    const unsigned G = gridDim.x * gridDim.y * gridDim.z;
    unsigned sum, cnt, mine, sp = 0u;
    for (;;) {
        sum = 0u; cnt = 0u; mine = 0u;
#pragma unroll
        for (unsigned j = 0; j < 16; ++j) { const unsigned c = xb_ld(&bar[XB_XCNT(j)]); sum += c; cnt += (c > 0u) ? 1u : 0u; mine = (j == x) ? c : mine; }
        if (sum == G) break;
        __builtin_amdgcn_s_sleep(1);
        if ((++sp & 255u) == 0u) { if (xb_ld(&bar[XB_TMO])) break; if (sp > XB_SPIN_CAP) { atomicAdd(&bar[XB_TMO], 1u); break; } }
    }
    nloc = mine > 0u ? mine : 1u; nx = cnt > 0u ? cnt : 1u;
}
__device__ __forceinline__ void xcd_barrier(const XcdBarrier& b) {
    asm volatile("s_waitcnt vmcnt(0)" ::: "memory");
    __syncthreads();
    if (threadIdx.x == 0) {
        unsigned* bar = b.bar;
        __builtin_amdgcn_s_waitcnt(0);
        unsigned nloc = b.st[0], nx = b.st[1];
        if (nloc == 0u) { xcd_barrier_complete(bar, b.x, nloc, nx); b.st[0] = nloc; b.st[1] = nx; }
        const unsigned old = xb_add(&bar[XB_XSUB(b.x)], 1u);
        const unsigned gen = old / nloc;
        if (old + 1u == (gen + 1u) * nloc) {
            __builtin_amdgcn_fence(__ATOMIC_RELEASE, "agent");
            asm volatile("s_waitcnt vmcnt(0)" ::: "memory");
            const unsigned og = xb_add(&bar[XB_TOP], 1u);
            const unsigned tg = og / nx;
            if (og + 1u == (tg + 1u) * nx) xb_add(&bar[XB_TOPGEN], 1u);
            else XB_SPIN(xb_ld(&bar[XB_TOPGEN]) == tg, bar);
            __builtin_amdgcn_fence(__ATOMIC_ACQUIRE, "agent");
            xb_add(&bar[XB_XGEN(b.x)], 1u);
            asm volatile("s_waitcnt vmcnt(0)" ::: "memory");
        } else {
            XB_SPIN(xb_ld(&bar[XB_XGEN(b.x)]) == gen, bar);
            __builtin_amdgcn_fence(__ATOMIC_ACQUIRE, "agent");
            asm volatile("s_waitcnt vmcnt(0)" ::: "memory");
        }
    }
    __syncthreads();
}

__global__ void __launch_bounds__(512, 2) hymba_fwd(Args args) {
    extern __shared__ __attribute__((aligned(16))) unsigned char lds_raw[];
    LAS unsigned char* lds = (LAS unsigned char*)lds_raw;
    cg::grid_group grid = cg::this_grid();
    Frame F;
#pragma unroll
    for (int i = 0; i < 30; ++i) F.in[i] = args.in[i];
    F.out = args.out; F.ws = args.ws;
    unsigned char* ws = args.ws;
    F.WIN = (bf16_t*)(ws + WS_WIN); F.WGLU = (bf16_t*)(ws + WS_WGLU); F.WOUT = (bf16_t*)(ws + WS_WOUT); F.WFF1 = (bf16_t*)(ws + WS_WFF1); F.WFF2 = (bf16_t*)(ws + WS_WFF2);
    F.XN = (bf16_t*)(ws + WS_XN); F.PROJ = (bf16_t*)(ws + WS_PROJ); F.ST = (bf16_t*)(ws + WS_ST); F.HID = (bf16_t*)(ws + WS_HID);
    F.BBT = (bf16_t*)(ws + WS_BBT); F.CM = (bf16_t*)(ws + WS_CM);
    F.SS5 = (float*)(ws + WS_SS5); F.SSF = (float*)(ws + WS_SSF); F.CD = (float*)(ws + WS_CD); F.DT = (float*)(ws + WS_DT);
    F.PW = (f32x2*)(ws + WS_PW); F.A32 = (f32x2*)(ws + WS_A32); F.BBS = (bf16_t*)(ws + WS_BBS); F.AB = (f32x2*)(ws + WS_AB); F.AQ = (f32x2*)(ws + WS_AQ); F.SE = (f32x2*)(ws + WS_SE);
    const int tid = threadIdx.x, wid = __builtin_amdgcn_readfirstlane(tid >> 6), lane = tid & 63;
    const int G = gridDim.x, gt = blockIdx.x * 512 + tid, GT = G * 512, gw = blockIdx.x * 8 + wid, NGW = G * 8;
    const int lo = args.ph_lo, hi = args.ph_hi;
    if (lo < 0) grid.sync();
    if (tid < 2) ((LAS unsigned*)(lds + LDS_BYTES - 16))[tid] = 0u;
    __syncthreads();
    XcdBarrier bar = xcd_barrier_post((unsigned*)(ws + WS_BAR), (volatile LAS unsigned*)(lds + LDS_BYTES - 16));
#define IN(k) (lo <= (k) && (k) < hi)
#ifndef PROBE_SYNCS
#define PROBE_SYNCS 1
#endif
#ifndef PROBE_REP
#define PROBE_REP 0
#endif
#define SEAM(k) do { if (IN(k) && IN((k) + 1)) { for (int _s = 0; _s < PROBE_SYNCS; ++_s) xcd_barrier(bar); } } while (0)
#define REPS(k) (((PROBE_REP >> (k)) & 1) + 1)

    if (IN(0)) for (int _rep = 0; _rep < REPS(0); ++_rep) { if (_rep) xcd_barrier(bar);
        for (int i = gt; i < TT; i += GT) { F.SS5[i] = 0.f; F.SSF[i] = 0.f; }
        LAS float* scr = (LAS float*)(lds + wid * 8448);
        constexpr int I_IN = 16 * (N1 / 32), I_GLU = 16 * 32, I_OUT = 32 * 32, I_FF1 = 16 * 128, I_FF2 = 64 * 32, I_ALL = I_IN + I_GLU + I_OUT + I_FF1 + I_FF2;
        for (int it = gw; it < I_ALL; it += NGW) { int r = it;
            if (r < I_IN) { p0_transpose_item(F.in[7], 1024, N1V, N1, F.WIN, nullptr, scr, r, lane); continue; } r -= I_IN;
            if (r < I_GLU) { p0_transpose_item(F.in[16], 1024, 1024, 1024, F.WGLU, nullptr, scr, r, lane); continue; } r -= I_GLU;
            if (r < I_OUT) { const int k0 = 64 * (r / 32); p0_transpose_item(F.in[25], 2048, 1024, 1024, F.WOUT, k0 < 1024 ? F.in[18] : F.in[24] - 1024, scr, r, lane); continue; } r -= I_OUT;
            if (r < I_FF1) { p0_transpose_item(F.in[27], 1024, 4096, 4096, F.WFF1, F.in[26], scr, r, lane); continue; } r -= I_FF1;
            p0_transpose_item(F.in[28], 4096, 1024, 1024, F.WFF2, nullptr, scr, r, lane);
        }
        for (int m = gw; m < TT; m += NGW) { const float* src = m < MP ? F.in[0] + (size_t)m * DM : F.in[1] + (size_t)(m - MP) * DM;
            f32x4 v[4]; float s = 0.f;
#pragma unroll
            for (int j = 0; j < 4; ++j) { v[j] = *(const f32x4*)(src + 4 * lane + 256 * j); s += (v[j][0] * v[j][0] + v[j][1] * v[j][1]) + (v[j][2] * v[j][2] + v[j][3] * v[j][3]); }
            const float rs = rs_from_ss(wave_sum(s), 1024.f);
#pragma unroll
            for (int j = 0; j < 4; ++j) { const f32x4 gn = *(const f32x4*)(F.in[6] + 4 * lane + 256 * j);
                *(u32x2*)(F.XN + (size_t)m * DM + 4 * lane + 256 * j) = (u32x2){pk2(v[j][0] * rs * gn[0], v[j][1] * rs * gn[1]), pk2(v[j][2] * rs * gn[2], v[j][3] * rs * gn[3])}; } }
        for (int idx = gt; idx < 4096; idx += GT) { const int g = idx >> 6, p = idx & 63;
            const float dt = expf(F.in[10][g]), lr = F.in[8][idx], li = F.in[9][idx];
            const float mag = expf(lr * dt), ang = li * dt; float abr = mag * cosf(ang), abi = mag * sinf(ang);
            const float den = lr * lr + li * li, nr = abr - 1.f, ni = abi, fre = (nr * lr + ni * li) / den, fim = (ni * lr - nr * li) / den;
            F.AB[idx] = (f32x2){abr, abi};
            float qr = abr, qi = abi;
#pragma unroll
            for (int k = 0; k < 7; ++k) { const float tr = qr * qr - qi * qi, ti = 2.f * qr * qi; qr = tr; qi = ti; }
            F.AQ[idx] = (f32x2){qr, qi};
            { float pr = 1.f, pi = 0.f;
#pragma unroll 4
              for (int k = 0; k < 32; ++k) { const int t = 31 - k, hf = (t >> 2) & 1, r = (t & 3) + 4 * (t >> 3);
                  F.PW[(size_t)((g * 2 + hf) * 16 + r) * 64 + p] = (f32x2){pr, pi}; const float tr = pr * abr - pi * abi, ti = pr * abi + pi * abr; pr = tr; pi = ti; }
              F.A32[idx] = (f32x2){pr, pi}; }
#pragma unroll 4
            for (int c = 0; c < 16; ++c) { const float br = F.in[11][(size_t)idx * 16 + c], bi = F.in[12][(size_t)idx * 16 + c];
                { const bf16_t vr = (bf16_t)(pk2(fre * br - fim * bi, 0.f) & 0xffffu), vi = (bf16_t)(pk2(fre * bi + fim * br, 0.f) & 0xffffu);
                  F.BBT[(size_t)(g * 128 + 2 * p) * 16 + c] = vr; F.BBT[(size_t)(g * 128 + 2 * p + 1) * 16 + c] = vi; F.BBS[(size_t)(g * 128 + p) * 16 + c] = vr; F.BBS[(size_t)(g * 128 + 64 + p) * 16 + c] = vi; }
                const float cr = F.in[13][(size_t)(g * 16 + c) * 64 + p], ci = F.in[14][(size_t)(g * 16 + c) * 64 + p];
                *(unsigned*)(F.CM + (size_t)(g * 16 + c) * 128 + 2 * p) = pk2(cr, -ci); } }
    }
    SEAM(0);

    if (IN(1)) for (int _rep = 0; _rep < REPS(1); ++_rep) { if (_rep) xcd_barrier(bar);
        pg8::Gemm gm{F.XN, F.WIN, DM, DM, DM}; pg8::StaticOrder S; S.init(MP, N1, G, (int)blockIdx.x);
        EpiProj E{F.PROJ, F.DT};
        pg8::gemm_phase<EpiProj, pg8::StaticOrder, true, true>(lds, gm, S, E);
        bf16_t* P = F.PROJ; float* DTp = F.DT;
        skinny_gemm(lds, F.XN + (size_t)MP * DM, DM, F.WIN, DM, DM, 113, [=](int row, int col, float lo0, float hi0, float lo1, float hi1) {
            const float v0 = lo0 + hi0, v1 = lo1 + hi1; const size_t r = (size_t)MP + row;
            if (col < PJ) *(unsigned*)(P + r * PJ + col) = pk2(v0, v1); else if (col < N1V) { DTp[r * 16 + col - PJ] = v0; DTp[r * 16 + col - PJ + 1] = v1; } });
    }
    SEAM(1);

    if (IN(2)) {
        for (int tile = blockIdx.x; tile < NB * NCH * 2; tile += G) ssd_states_tile(lds, F, tile >> 5, (tile >> 1) & 15, tile & 1);
        __syncthreads();
        s5_pass_a(F, gw, NGW, lane);
        __syncthreads();
        for (int j = blockIdx.x; j < NSAMP * 2; j += G) ssd_sample_job(lds, F, j >> 1, j & 1);
        for (int job = gw; job < NSAMP * 64; job += NGW) s5_sample_job(F, job >> 6, job & 63, lane);
    }
    SEAM(2);

    if (IN(3)) {
        for (int idx = gt; idx < NB * 16 * 64 * 16; idx += GT) { const int n8 = idx & 15, p = (idx >> 4) & 63, h = (idx >> 10) & 15, b = idx >> 14;
            bf16_t* base = F.ST + ((size_t)(b * 16 * 16 + h) * 64 + p) * 128 + n8 * 8; const size_t cstep = (size_t)16 * 64 * 128;
            u32x4 v[NCH];
#pragma unroll
            for (int c = 0; c < NCH; ++c) v[c] = *(const u32x4*)(base + c * cstep);
            float hs[8];
#pragma unroll
            for (int i = 0; i < 8; ++i) hs[i] = 0.f;
#pragma unroll
            for (int c = 0; c < NCH; ++c) { const float cd = F.CD[(b * 16 + c) * 16 + h];
                *(u32x4*)(base + c * cstep) = (u32x4){pk2(hs[0], hs[1]), pk2(hs[2], hs[3]), pk2(hs[4], hs[5]), pk2(hs[6], hs[7])};
                hs[0] = cd * hs[0] + bflo(v[c].x); hs[1] = cd * hs[1] + bfhi(v[c].x); hs[2] = cd * hs[2] + bflo(v[c].y); hs[3] = cd * hs[3] + bfhi(v[c].y);
                hs[4] = cd * hs[4] + bflo(v[c].z); hs[5] = cd * hs[5] + bfhi(v[c].z); hs[6] = cd * hs[6] + bflo(v[c].w); hs[7] = cd * hs[7] + bfhi(v[c].w); }
            float* o = F.out + O_SSDP + ((size_t)(b * 16 + h) * 64 + p) * 128 + n8 * 8;
            *(f32x4*)o = (f32x4){hs[0], hs[1], hs[2], hs[3]}; *(f32x4*)(o + 4) = (f32x4){hs[4], hs[5], hs[6], hs[7]}; }
        for (int idx = gt; idx < NB * 64 * 64; idx += GT) { const int p = idx & 63, bg = idx >> 6, g = bg & 63;
            const f32x2 aq = F.AQ[g * 64 + p]; f32x2* sp = F.SE + (size_t)bg * 16 * 64 + p; float hr = 0.f, hi_ = 0.f;
#pragma unroll 4
            for (int c = 0; c < NCH; ++c) { const f32x2 t = sp[c * 64]; sp[c * 64] = (f32x2){hr, hi_}; const float nr = aq.x * hr - aq.y * hi_ + t.x, ni = aq.x * hi_ + aq.y * hr + t.y; hr = nr; hi_ = ni; }
            F.out[O_S5RP + idx] = hr; F.out[O_S5IP + idx] = hi_; }
    }
    SEAM(3);

    if (IN(4)) {
        for (int tile = blockIdx.x; tile < NB * NCH * 2; tile += G) ssd_y_tile(lds, F, tile >> 5, (tile >> 1) & 15, tile & 1);
        __syncthreads();
        s5_pass_b(lds + wid * 16896, F, gw, NGW, lane);
        __syncthreads();
    }
    SEAM(4);

    if (IN(5)) {
        pg8::Gemm gm{F.XN, F.WGLU, DM, DM, DM}; pg8::StaticOrder S; S.init(MP, DM, G, (int)blockIdx.x);
        EpiGlu E{F.XN, F.PROJ, F.in[17], F.SS5};
        pg8::gemm_phase<EpiGlu, pg8::StaticOrder, false, true>(lds, gm, S, E);
        const bf16_t* Gp = F.XN; bf16_t* P = F.PROJ; const float* bias = F.in[17]; float* SS = F.SS5;
        skinny_gemm(lds, F.XN + (size_t)MP * DM, DM, F.WGLU, DM, DM, 32, [=](int row, int col, float lo0, float hi0, float lo1, float hi1) {
            const size_t r = (size_t)MP + row; const unsigned gw_ = *(const unsigned*)(Gp + r * DM + col);
            const float o0 = bflo(gw_) * sigmoidf_(lo0 + hi0 + bias[col]), o1 = bfhi(gw_) * sigmoidf_(lo1 + hi1 + bias[col + 1]);
            *(unsigned*)(P + r * PJ + col) = pk2(o0, o1);
            const float ss = red16(o0 * o0 + o1 * o1); if ((threadIdx.x & 15) == 0) atomicAdd(SS + r, ss); });
    }
    SEAM(5);

    if (IN(6)) {
        pg8::Gemm gm{F.PROJ, F.WOUT, PJ, 2048, 2048}; pg8::StaticOrder S; S.init(MP, DM, G, (int)blockIdx.x);
        EpiOut E{F.in[0], F.out, F.XN, F.SSF, F.SS5};
        pg8::gemm_phase<EpiOut, pg8::StaticOrder, false, true>(lds, gm, S, E);
        const float* xs = F.in[1]; float* X1 = F.out; bf16_t* X1B = F.XN; float* SSF = F.SSF; const float* SS5 = F.SS5;
        skinny_gemm(lds, F.PROJ + (size_t)MP * PJ, PJ, F.WOUT, 2048, 2048, 32, [=](int row, int col, float lo0, float hi0, float lo1, float hi1) {
            const size_t r = (size_t)MP + row; const float s = rs_from_ss(SS5[r], 1024.f);
            const float v0 = xs[(size_t)row * DM + col] + lo0 * s + hi0, v1 = xs[(size_t)row * DM + col + 1] + lo1 * s + hi1;
            X1[r * DM + col] = v0; X1[r * DM + col + 1] = v1; *(unsigned*)(X1B + r * DM + col) = pk2(v0, v1);
            const float ss = red16(v0 * v0 + v1 * v1); if ((threadIdx.x & 15) == 0) atomicAdd(SSF + r, ss); });
    }
    SEAM(6);

    if (IN(7)) for (int _rep = 0; _rep < REPS(7); ++_rep) { if (_rep) xcd_barrier(bar);
        pg8::Gemm gm{F.XN, F.WFF1, DM, DM, DM}; pg8::StaticOrder S; S.init(MP, DFF, G, (int)blockIdx.x);
        EpiFF1 E{F.HID, F.SSF};
        pg8::gemm_phase<EpiFF1, pg8::StaticOrder, true, true>(lds, gm, S, E);
        bf16_t* H = F.HID; const float* SSF = F.SSF;
        skinny_gemm(lds, F.XN + (size_t)MP * DM, DM, F.WFF1, DM, DM, 128, [=](int row, int col, float lo0, float hi0, float lo1, float hi1) {
            const size_t r = (size_t)MP + row; const float s = rs_from_ss(SSF[r], 1024.f);
            const float a = fmaxf((lo0 + hi0) * s, 0.f), b = fmaxf((lo1 + hi1) * s, 0.f); *(unsigned*)(H + r * DFF + col) = pk2(a * a, b * b); });
    }
    SEAM(7);

    if (IN(8)) {
        pg8::Gemm gm{F.HID, F.WFF2, DFF, DFF, DFF}; pg8::StaticOrder S; S.init(MP, DM, G, (int)blockIdx.x);
        EpiFF2 E{F.out};
        pg8::gemm_phase<EpiFF2, pg8::StaticOrder, false, true>(lds, gm, S, E);
        float* X1 = F.out;
        skinny_gemm(lds, F.HID + (size_t)MP * DFF, DFF, F.WFF2, DFF, DFF, 32, [=](int row, int col, float lo0, float hi0, float lo1, float hi1) {
            const size_t r = (size_t)MP + row; X1[r * DM + col] += lo0 + hi0; X1[r * DM + col + 1] += lo1 + hi1; });
    }
    SEAM(8);

    if (IN(9)) {
        for (int m = gw; m < TT; m += NGW) { float* src = F.out + (size_t)m * DM;
            f32x4 v[4]; float s = 0.f;
#pragma unroll
            for (int j = 0; j < 4; ++j) { v[j] = *(const f32x4*)(src + 4 * lane + 256 * j); s += (v[j][0] * v[j][0] + v[j][1] * v[j][1]) + (v[j][2] * v[j][2] + v[j][3] * v[j][3]); }
            const float rs = rs_from_ss(wave_sum(s), 1024.f);
#pragma unroll
            for (int j = 0; j < 4; ++j) { const f32x4 gn = *(const f32x4*)(F.in[29] + 4 * lane + 256 * j); *(f32x4*)(src + 4 * lane + 256 * j) = v[j] * rs * gn; } }
    }
#undef IN
#undef SEAM
}

#ifndef N_LAUNCHES
#define N_LAUNCHES 1
#endif
extern "C" void kernel_launch(void* const* d_in, const int* in_sizes, int n_in, void* d_out, int out_size, void* d_ws, size_t ws_size, hipStream_t stream) {
    static int grid = 0;
    if (grid == 0) {
        if (n_in != 30 || (size_t)out_size != O_END || ws_size < WS_END) { fprintf(stderr, "kernel_launch: unexpected shapes: n_in %d out_size %d ws %zu\n", n_in, out_size, ws_size); grid = -1; return; }
        int dev = 0, cus = 0, per_cu = 0;
        (void)hipGetDevice(&dev); (void)hipDeviceGetAttribute(&cus, hipDeviceAttributeMultiprocessorCount, dev);
        if (hipFuncSetAttribute((const void*)hymba_fwd, hipFuncAttributeMaxDynamicSharedMemorySize, LDS_BYTES) != hipSuccess) { fprintf(stderr, "kernel_launch: hipFuncSetAttribute failed\n"); grid = -1; return; }
        if (hipOccupancyMaxActiveBlocksPerMultiprocessor(&per_cu, (const void*)hymba_fwd, 512, LDS_BYTES) != hipSuccess || per_cu < 1) { fprintf(stderr, "kernel_launch: occupancy query says %d\n", per_cu); per_cu = 1; }
        (void)hipGetLastError();
        grid = cus * per_cu;
    }
    if (grid < 0) return;
    if (hipMemsetAsync((char*)d_ws + WS_BAR, 0, XCD_BAR_WORDS * 4, stream) != hipSuccess) { fprintf(stderr, "kernel_launch: memset failed\n"); return; }
    Args a{};
    for (int i = 0; i < 30; ++i) a.in[i] = (const float*)d_in[i];
    a.out = (float*)d_out; a.ws = (unsigned char*)d_ws;
    constexpr int NPH = 10;
    for (int li = 0; li < N_LAUNCHES; ++li) {
        a.ph_lo = (N_LAUNCHES == 1) ? 0 : li; a.ph_hi = (N_LAUNCHES == 1) ? NPH : li + 1;
        void* kargs[] = {&a};
        const hipError_t e = hipLaunchCooperativeKernel((const void*)hymba_fwd, dim3(grid), dim3(512), kargs, LDS_BYTES, stream);
        if (e != hipSuccess) { fprintf(stderr, "kernel_launch: cooperative launch %d failed: %s (grid %d)\n", li, hipGetErrorString(e), grid); break; }
    }
}
```

```cpp
#include <hip/hip_runtime.h>
#include <hip/hip_cooperative_groups.h>
#include <cstdio>
#include <cstdint>
namespace cg = cooperative_groups;

namespace pg8 {
#define PG8_LAS __attribute__((address_space(3)))
typedef unsigned short bf16_t;
typedef short bf16x8 __attribute__((ext_vector_type(8)));
typedef float f32x4 __attribute__((ext_vector_type(4)));
typedef unsigned u32x4 __attribute__((ext_vector_type(4)));
typedef unsigned u32x2 __attribute__((ext_vector_type(2)));
constexpr int BM = 256, BK = 64, HALF = 128, HTB = HALF * BK * 2  , STAGE_BYTES = 8 * HTB, NXCD = 8, WGM = 8;

__host__ __device__ __forceinline__ int lds_byte(int r, int c) { const int st = (r >> 4) * 2 + (c >> 5), rr = r & 15, cc = c & 31, ob = rr * 64 + cc * 2; return st * 1024 + (ob ^ (((ob >> 9) & 1) << 5)); }
__host__ __device__ __forceinline__ void stage_rc(int b, int& R, int& C) { const int st = b / 1024, sb = b % 1024, swz = sb ^ (((sb >> 9) & 1) << 5); R = (st >> 1) * 16 + swz / 64; C = (st & 1) * 32 + (swz % 64) / 2; }
__host__ __device__ __forceinline__ int perm32(int rho) { const int n = rho >> 4, i = rho & 15; return 8 * (i >> 2) + 4 * n + (i & 3); }

struct Unit { int pm, pn; };
struct Gemm { const bf16_t* A; const bf16_t* Bt; int lda, ldb, K; };

struct StaticOrder {
    int nM, nN, nwg, G, c;
    __host__ __device__ void init(int M, int N, int G_, int c_) { nM = M / BM; nN = N / BM; nwg = nM * nN; G = G_; c = c_; }
    __host__ __device__ bool next(int i, Unit& u) const {
        const long L = (long)i * G + c; if (L >= nwg) return false;
        int wgid = (int)L; { const int q = nwg / NXCD, r = nwg % NXCD, xcd = wgid % NXCD, off = wgid / NXCD; wgid = (xcd < r ? xcd * (q + 1) : r * (q + 1) + (xcd - r) * q) + off; }
        const int nig = WGM * nN, gid = wgid / nig, fm = gid * WGM, gsz = (nM - fm) < WGM ? (nM - fm) : WGM;
        u.pm = fm + ((wgid % nig) % gsz); u.pn = (wgid % nig) / gsz; return true;
    }
};

__device__ __forceinline__ unsigned cvt_pk_bf16(float lo, float hi) { unsigned r; asm volatile("v_cvt_pk_bf16_f32 %0, %1, %2" : "=v"(r) : "v"(lo), "v"(hi)); return r; }

template <class Epi, class Sched, bool ALIGN_EPI = false, bool SP2 = false>
__device__ __forceinline__ void gemm_phase(PG8_LAS unsigned char* lds, const Gemm g, const Sched& S, const Epi& E) {
    const int tid = threadIdx.x, wid = __builtin_amdgcn_readfirstlane(tid >> 6), lane = tid & 63, wr = wid >> 2, wc = wid & 3, fr = lane & 15, fq = lane >> 4;
    const int K = g.K, nt = K / BK;
    unsigned voffA[2], voffB[2];
#pragma unroll
    for (int i = 0; i < 2; ++i) { int R, C; stage_rc(tid * 16 + i * 8192, R, C); const int Rb = Epi::PERM ? ((R & ~31) + perm32(R & 31)) : R;
        voffA[i] = (unsigned)(R * g.lda + C) * 2u; voffB[i] = (unsigned)(Rb * g.ldb + C) * 2u; }
    const size_t kstep = (size_t)(BK * 2);
    const size_t hstepA = (size_t)HALF * g.lda * 2, hstepB = (size_t)HALF * g.ldb * 2;
    const size_t tstepA = 2 * hstepA, tstepB = 2 * hstepB;
    const unsigned ldsw = (unsigned)wid * 1024u;
    const int aoff = lds_byte(wr * 64 + fr, fq * 8), boff = lds_byte(wc * 32 + fr, fq * 8);
#define PG8_SA(b, h) (((b) * 2 + (h)) * HTB)
#define PG8_SB(b, h) ((4 + (b) * 2 + (h)) * HTB)
#define PG8_STAGE(bufoff, gbase, voff) do { _Pragma("unroll") for (int _i = 0; _i < 2; ++_i) \
        __builtin_amdgcn_global_load_lds((const unsigned*)((const char*)(gbase) + (voff)[_i]), (PG8_LAS unsigned*)(lds + (bufoff) + ldsw + _i * 8192), 16, 0, 0); } while (0)
#define PG8_LDA(dst, b, h) do { _Pragma("unroll") for (int m = 0; m < 4; ++m) _Pragma("unroll") for (int k = 0; k < 2; ++k) dst[m][k] = *(const PG8_LAS bf16x8*)(lds + PG8_SA(b, h) + aoff + m * 2048 + k * 1024); } while (0)
#define PG8_LDB(dst, b, h) do { _Pragma("unroll") for (int n = 0; n < 2; ++n) _Pragma("unroll") for (int k = 0; k < 2; ++k) dst[n][k] = *(const PG8_LAS bf16x8*)(lds + PG8_SB(b, h) + boff + n * 2048 + k * 1024); } while (0)
#define PG8_MMA(ai, bj, At, Bt) do { __builtin_amdgcn_s_setprio(1); _Pragma("unroll") for (int m = 0; m < 4; ++m) _Pragma("unroll") for (int n = 0; n < 2; ++n) _Pragma("unroll") for (int k = 0; k < 2; ++k) \
        acc[ai][bj][m][n] = __builtin_amdgcn_mfma_f32_16x16x32_bf16(Bt[n][k], At[m][k], acc[ai][bj][m][n], 0, 0, 0); __builtin_amdgcn_s_setprio(0); } while (0)
#define PG8_WAIT_V(n) asm volatile("s_waitcnt vmcnt(" #n ")" ::: "memory")
#define PG8_WAIT_L(n) asm volatile("s_waitcnt lgkmcnt(" #n ")" ::: "memory")
#define PG8_BAR __builtin_amdgcn_s_barrier()
#define PG8_SCHED __builtin_amdgcn_sched_barrier(0)
    Unit cur, nxt; int ui = 0;
    if (!S.next(0, cur)) return;
    f32x4 acc[2][2][4][2];
#pragma unroll
    for (int a = 0; a < 2; ++a)
#pragma unroll
        for (int b = 0; b < 2; ++b)
#pragma unroll
            for (int m = 0; m < 4; ++m)
#pragma unroll
                for (int n = 0; n < 2; ++n) acc[a][b][m][n] = (f32x4){0.f, 0.f, 0.f, 0.f};
    bf16x8 At[4][2], B0[2][2], B1[2][2];
    const char* cA = (const char*)g.A + (size_t)cur.pm * tstepA; const char* cB = (const char*)g.Bt + (size_t)cur.pn * tstepB;
    if constexpr (SP2) {
        PG8_STAGE(PG8_SB(0, 0), cB, voffB); PG8_STAGE(PG8_SB(0, 1), cB + hstepB, voffB); PG8_STAGE(PG8_SA(0, 0), cA, voffA); PG8_STAGE(PG8_SA(0, 1), cA + hstepA, voffA);
        if (wr == 1) PG8_BAR;
        PG8_WAIT_V(2); PG8_BAR;
        PG8_STAGE(PG8_SB(1, 0), cB + kstep, voffB); PG8_STAGE(PG8_SA(1, 0), cA + kstep, voffA); PG8_STAGE(PG8_SB(1, 1), cB + hstepB + kstep, voffB);
        PG8_WAIT_V(6); PG8_BAR;
    } else {
        PG8_STAGE(PG8_SB(0, 0), cB, voffB); PG8_STAGE(PG8_SA(0, 0), cA, voffA); PG8_STAGE(PG8_SB(0, 1), cB + hstepB, voffB); PG8_STAGE(PG8_SA(0, 1), cA + hstepA, voffA);
        if (wr == 1) PG8_BAR;
        PG8_WAIT_V(4); PG8_BAR;
        PG8_STAGE(PG8_SB(1, 0), cB + kstep, voffB); PG8_STAGE(PG8_SA(1, 0), cA + kstep, voffA); PG8_STAGE(PG8_SB(1, 1), cB + hstepB + kstep, voffB);
        PG8_WAIT_V(6); PG8_BAR;
    }
    for (;;) {
        const bool has_next = S.next(ui + 1, nxt);
        const char* nA = has_next ? (const char*)g.A + (size_t)nxt.pm * tstepA : cA; const char* nB = has_next ? (const char*)g.Bt + (size_t)nxt.pn * tstepB : cB;
        for (int t = 0; t < nt; t += 2) {
            const bool last = (t == nt - 2);
            const char* a1 = cA + (size_t)(t + 1) * kstep;
            const char* a2 = last ? nA : cA + (size_t)(t + 2) * kstep; const char* b2 = last ? nB : cB + (size_t)(t + 2) * kstep;
            const char* a3 = a2 + kstep; const char* b3 = b2 + kstep;
            if constexpr (Epi::MID) { if (t == (nt >> 1)) E.mid(acc, cur, wr, wc, fr, fq, 0); else if (t == (nt >> 1) + (nt >> 2)) E.mid(acc, cur, wr, wc, fr, fq, 1); }
            if constexpr (SP2) {
            PG8_LDB(B0, 0, 0); PG8_LDB(B1, 0, 1); PG8_SCHED; PG8_LDA(At, 0, 0); PG8_STAGE(PG8_SA(1, 1), a1 + hstepA, voffA);
            PG8_WAIT_V(8); PG8_WAIT_L(0); PG8_BAR; PG8_MMA(0, 0, At, B0); PG8_MMA(0, 1, At, B1); PG8_BAR; PG8_SCHED;
            PG8_LDA(At, 0, 1); PG8_STAGE(PG8_SB(0, 0), b2, voffB); PG8_STAGE(PG8_SB(0, 1), b2 + hstepB, voffB); PG8_STAGE(PG8_SA(0, 0), a2, voffA);
            PG8_WAIT_V(8); PG8_WAIT_L(0); PG8_BAR; PG8_MMA(1, 0, At, B0); PG8_MMA(1, 1, At, B1); PG8_BAR; PG8_SCHED;
            PG8_LDB(B0, 1, 0); PG8_LDB(B1, 1, 1); PG8_SCHED; PG8_LDA(At, 1, 0); PG8_STAGE(PG8_SA(0, 1), a2 + hstepA, voffA);
            PG8_WAIT_V(8); PG8_WAIT_L(0); PG8_BAR; PG8_MMA(0, 0, At, B0); PG8_MMA(0, 1, At, B1); PG8_BAR; PG8_SCHED;
            PG8_LDA(At, 1, 1); PG8_STAGE(PG8_SB(1, 0), b3, voffB); PG8_STAGE(PG8_SB(1, 1), b3 + hstepB, voffB); PG8_STAGE(PG8_SA(1, 0), a3, voffA);
            PG8_WAIT_V(8); PG8_WAIT_L(0); PG8_BAR; PG8_MMA(1, 0, At, B0); PG8_MMA(1, 1, At, B1); PG8_BAR; PG8_SCHED;
            } else {
            PG8_LDB(B0, 0, 0); PG8_SCHED; PG8_LDA(At, 0, 0); PG8_STAGE(PG8_SA(1, 1), a1 + hstepA, voffA);
            PG8_WAIT_L(8); PG8_BAR; PG8_WAIT_L(0); PG8_MMA(0, 0, At, B0); PG8_BAR; PG8_SCHED;
            PG8_LDB(B1, 0, 1); PG8_STAGE(PG8_SB(0, 0), b2, voffB);
            PG8_BAR; PG8_WAIT_L(0); PG8_MMA(0, 1, At, B1); PG8_BAR;
            PG8_LDA(At, 0, 1); PG8_STAGE(PG8_SA(0, 0), a2, voffA);
            PG8_BAR; PG8_WAIT_L(0); PG8_MMA(1, 0, At, B0); PG8_BAR; PG8_SCHED;
            PG8_STAGE(PG8_SB(0, 1), b2 + hstepB, voffB);
            PG8_WAIT_V(6); PG8_BAR; PG8_MMA(1, 1, At, B1); PG8_BAR;
            PG8_LDB(B0, 1, 0); PG8_SCHED; PG8_LDA(At, 1, 0); PG8_STAGE(PG8_SA(0, 1), a2 + hstepA, voffA);
            PG8_WAIT_L(8); PG8_BAR; PG8_WAIT_L(0); PG8_MMA(0, 0, At, B0); PG8_BAR; PG8_SCHED;
            PG8_LDB(B1, 1, 1); PG8_STAGE(PG8_SB(1, 0), b3, voffB);
            PG8_BAR; PG8_WAIT_L(0); PG8_MMA(0, 1, At, B1); PG8_BAR;
            PG8_LDA(At, 1, 1); PG8_STAGE(PG8_SA(1, 0), a3, voffA);
            PG8_BAR; PG8_WAIT_L(0); PG8_MMA(1, 0, At, B0); PG8_BAR; PG8_SCHED;
            PG8_STAGE(PG8_SB(1, 1), b3 + hstepB, voffB);
            PG8_WAIT_V(6); PG8_BAR; PG8_MMA(1, 1, At, B1); PG8_BAR;
            }
        }
        if constexpr (ALIGN_EPI) { if (wr == 0) PG8_BAR; }
        if constexpr (!Epi::AFTER_DRAIN) E(acc, cur, wr, wc, fr, fq);
        if (!has_next) break;
#pragma unroll
        for (int a = 0; a < 2; ++a)
#pragma unroll
            for (int b = 0; b < 2; ++b)
#pragma unroll
                for (int m = 0; m < 4; ++m)
#pragma unroll
                    for (int n = 0; n < 2; ++n) acc[a][b][m][n] = (f32x4){0.f, 0.f, 0.f, 0.f};
        cur = nxt; cA = nA; cB = nB; ++ui;
        if constexpr (ALIGN_EPI) { if (wr == 1) PG8_BAR; }
    }
    PG8_WAIT_V(0);
    if constexpr (!ALIGN_EPI) { if (wr == 0) PG8_BAR; }
    PG8_BAR;
    if constexpr (Epi::AFTER_DRAIN) E.fused(acc, cur, wr, wc, fr, fq, lds, tid);
#undef PG8_SA
#undef PG8_SB
#undef PG8_STAGE
#undef PG8_LDA
#undef PG8_LDB
#undef PG8_MMA
#undef PG8_WAIT_V
#undef PG8_WAIT_L
#undef PG8_BAR
#undef PG8_SCHED
}
}

#define LAS __attribute__((address_space(3)))
typedef unsigned short bf16_t;
typedef short bf16x8 __attribute__((ext_vector_type(8)));
typedef float f32x4 __attribute__((ext_vector_type(4)));
typedef float f32x2 __attribute__((ext_vector_type(2)));
typedef float f32x16 __attribute__((ext_vector_type(16)));
typedef unsigned u32x4 __attribute__((ext_vector_type(4)));
typedef unsigned u32x2 __attribute__((ext_vector_type(2)));

constexpr int DM = 1024, NB = 8, SEQ = 2048, MP = NB * SEQ, NSAMP = 128, TT = MP + NSAMP;
constexpr int NCH = SEQ / 128;
constexpr int PJ = 3584;
constexpr int N1 = 3840, N1V = 3600;
constexpr int DCONV = 1536, DFF = 4096;
constexpr float EPS = 1e-5f;
constexpr int XT_P = 136;

constexpr size_t MiB = 1u << 20;
constexpr size_t WS_SS5 = 0, WS_SSF = 128 * 1024, WS_SSG = 256 * 1024, WS_CD = 384 * 1024, WS_BAR = 448 * 1024, WS_CNT = 448 * 1024 + 16384, WS_CNT2 = 448 * 1024 + 32768, WS_TS = 448 * 1024 + 40960, WS_AB = 512 * 1024, WS_AQ = 576 * 1024;
constexpr size_t WS_BBT = 1 * MiB, WS_CM = 1 * MiB + 256 * 1024, WS_DT = 2 * MiB, WS_SE = 4 * MiB;
constexpr size_t WS_WIN = 8 * MiB, WS_WGLU = WS_WIN + (size_t)N1 * DM * 2, WS_WOUT = WS_WGLU + (size_t)DM * DM * 2, WS_WFF1 = WS_WOUT + (size_t)DM * 2048 * 2, WS_WFF2 = WS_WFF1 + (size_t)DFF * DM * 2;
constexpr size_t WS_XN = 38 * MiB;
constexpr size_t WS_PROJ = 71 * MiB;
constexpr size_t WS_ST = 184 * MiB;
constexpr size_t WS_HID = 71 * MiB;
constexpr size_t WS_PW = 216 * MiB, WS_A32 = 217 * MiB, WS_BBS = 217 * MiB + 256 * 1024;
constexpr size_t WS_SLOT = 218 * MiB;
constexpr size_t WS_XS = 219 * MiB;
constexpr size_t WS_END = 251 * MiB;
static_assert(WS_WFF2 + (size_t)DM * DFF * 2 <= WS_XN && WS_XN + (size_t)TT * DM * 2 <= WS_PROJ && WS_PROJ + (size_t)TT * PJ * 2 <= WS_ST && WS_HID + (size_t)TT * DFF * 2 <= WS_PW, "ws map");

constexpr size_t O_YS = (size_t)MP * DM, O_S5RP = O_YS + (size_t)NSAMP * DM, O_S5IP = O_S5RP + 32768, O_SSDP = O_S5IP + 32768, O_CVP = O_SSDP + 1048576,
                 O_S5RS = O_CVP + 36864, O_S5IS = O_S5RS + 524288, O_SSDS = O_S5IS + 524288, O_CVS = O_SSDS + 16777216, O_END = O_CVS + 589824;

constexpr int LDS_MAIN = 155648;
constexpr int LDS_BYTES = LDS_MAIN + 64;

struct Args { const float* in[30]; float* out; unsigned char* ws; int ph_lo, ph_hi; };

__device__ __forceinline__ float bf2f(unsigned short b) { return __builtin_bit_cast(float, (unsigned)b << 16); }
__device__ __forceinline__ float bflo(unsigned w) { return __builtin_bit_cast(float, w << 16); }
__device__ __forceinline__ float bfhi(unsigned w) { return __builtin_bit_cast(float, w & 0xffff0000u); }
__device__ __forceinline__ unsigned pk2(float lo, float hi) { return pg8::cvt_pk_bf16(lo, hi); }
__device__ __forceinline__ float wave_sum(float v) {
#pragma unroll
    for (int o = 1; o < 64; o <<= 1) v += __shfl_xor(v, o);
    return v;
}
template <int CTRL, int ROWMASK> __device__ __forceinline__ float dpp_add(float v) {
    return v + __builtin_bit_cast(float, __builtin_amdgcn_update_dpp(0, __builtin_bit_cast(int, v), CTRL, ROWMASK, 0xf, false)); }
__device__ __forceinline__ float half_sum_dpp(float v) { v = dpp_add<0x111, 0xf>(v); v = dpp_add<0x112, 0xf>(v); v = dpp_add<0x114, 0xf>(v); v = dpp_add<0x118, 0xf>(v); v = dpp_add<0x142, 0xa>(v); return v; }
__device__ __forceinline__ float sigmoidf_(float v) { return __builtin_amdgcn_rcpf(1.f + __expf(-v)); }
__device__ __forceinline__ float siluf_(float v) { return v * sigmoidf_(v); }
__device__ __forceinline__ float gelu_tanh(float v) { const float u = 1.5957691216057308f * (v + 0.044715f * v * v * v); return v * sigmoidf_(u); }
__device__ __forceinline__ float softplusf_(float x) { return fmaxf(x, 0.f) + log1pf(__expf(-fabsf(x))); }
__device__ __forceinline__ float rs_from_ss(float ss, float n) { return 1.0f / sqrtf(ss / n + EPS); }

struct EpiProj {
    static constexpr bool PERM = true, MID = false, AFTER_DRAIN = false;
    bf16_t* P; float* DT;
    __device__ __forceinline__ void operator()(const f32x4 (&acc)[2][2][4][2], const pg8::Unit& u, int wr, int wc, int fr, int fq) const {
        const int row0 = u.pm * 256 + wr * 64 + fr, col0 = u.pn * 256 + wc * 32 + 8 * fq;
#pragma unroll
        for (int ai = 0; ai < 2; ++ai)
#pragma unroll
            for (int m = 0; m < 4; ++m) { const int row = row0 + ai * 128 + m * 16;
#pragma unroll
                for (int bj = 0; bj < 2; ++bj) { const int col = col0 + bj * 128; const f32x4 v0 = acc[ai][bj][m][0], v1 = acc[ai][bj][m][1];
                    if (col < PJ) { u32x4 w; w.x = pk2(v0[0], v0[1]); w.y = pk2(v0[2], v0[3]); w.z = pk2(v1[0], v1[1]); w.w = pk2(v1[2], v1[3]); *(u32x4*)(P + (size_t)row * PJ + col) = w; }
                    else if (col < N1V) { float* d = DT + (size_t)row * 16 + (col - PJ); *(f32x4*)d = v0; *(f32x4*)(d + 4) = v1; } } }
    }
};
struct EpiGlu {
    static constexpr bool PERM = true, MID = false, AFTER_DRAIN = false;
    const bf16_t* G; bf16_t* P; const float* bias; float* SS;
    __device__ __forceinline__ void operator()(const f32x4 (&acc)[2][2][4][2], const pg8::Unit& u, int wr, int wc, int fr, int fq) const {
        const int row0 = u.pm * 256 + wr * 64 + fr, col0 = u.pn * 256 + wc * 32 + 8 * fq;
        f32x4 bv[2][2];
#pragma unroll
        for (int bj = 0; bj < 2; ++bj) { bv[bj][0] = *(const f32x4*)(bias + col0 + bj * 128); bv[bj][1] = *(const f32x4*)(bias + col0 + bj * 128 + 4); }
#pragma unroll
        for (int ai = 0; ai < 2; ++ai) {
            u32x4 gw[4][2];
#pragma unroll
            for (int m = 0; m < 4; ++m)
#pragma unroll
                for (int bj = 0; bj < 2; ++bj) gw[m][bj] = *(const u32x4*)(G + (size_t)(row0 + ai * 128 + m * 16) * DM + col0 + bj * 128);
#pragma unroll
            for (int m = 0; m < 4; ++m) { const int row = row0 + ai * 128 + m * 16; float ss = 0.f;
#pragma unroll
                for (int bj = 0; bj < 2; ++bj) { const int col = col0 + bj * 128; const u32x4 g4 = gw[m][bj];
                    const f32x4 v0 = acc[ai][bj][m][0] + bv[bj][0], v1 = acc[ai][bj][m][1] + bv[bj][1]; float o[8];
                    o[0] = bflo(g4.x) * sigmoidf_(v0[0]); o[1] = bfhi(g4.x) * sigmoidf_(v0[1]); o[2] = bflo(g4.y) * sigmoidf_(v0[2]); o[3] = bfhi(g4.y) * sigmoidf_(v0[3]);
                    o[4] = bflo(g4.z) * sigmoidf_(v1[0]); o[5] = bfhi(g4.z) * sigmoidf_(v1[1]); o[6] = bflo(g4.w) * sigmoidf_(v1[2]); o[7] = bfhi(g4.w) * sigmoidf_(v1[3]);
#pragma unroll
                    for (int i = 0; i < 8; ++i) ss += o[i] * o[i];
                    u32x4 w; w.x = pk2(o[0], o[1]); w.y = pk2(o[2], o[3]); w.z = pk2(o[4], o[5]); w.w = pk2(o[6], o[7]); *(u32x4*)(P + (size_t)row * PJ + col) = w; }
                ss += __shfl_xor(ss, 16); ss += __shfl_xor(ss, 32);
                if (fq == 0) atomicAdd(SS + row, ss); } }
    }
};
template <bool TAB> struct EpiOut {
    static constexpr bool PERM = true, MID = true, AFTER_DRAIN = false;
    const float* X; float* X1; bf16_t* X1B; float* SSF; const float* SS5; const LAS float* tab;
    __device__ __forceinline__ void mid(f32x4 (&acc)[2][2][4][2], const pg8::Unit& u, int wr, int wc, int fr, int fq, int which) const {
        if constexpr (TAB) {
#pragma unroll
            for (int ai = 0; ai < 2; ++ai)
#pragma unroll
                for (int m = 0; m < 4; ++m) { const float s = tab[which * 256 + ai * 128 + wr * 64 + m * 16 + fr];
#pragma unroll
                    for (int bj = 0; bj < 2; ++bj) { acc[ai][bj][m][0] *= s; acc[ai][bj][m][1] *= s; } }
            return; }
        else { if (which != 0) return;
        const int row0 = u.pm * 256 + wr * 64 + fr;
#pragma unroll
        for (int ai = 0; ai < 2; ++ai)
#pragma unroll
            for (int m = 0; m < 4; ++m) { const float s = rs_from_ss(SS5[row0 + ai * 128 + m * 16], 1024.f);
#pragma unroll
                for (int bj = 0; bj < 2; ++bj) { acc[ai][bj][m][0] *= s; acc[ai][bj][m][1] *= s; } } }
    }
    __device__ __forceinline__ void operator()(const f32x4 (&acc)[2][2][4][2], const pg8::Unit& u, int wr, int wc, int fr, int fq) const {
        const int row0 = u.pm * 256 + wr * 64 + fr, col0 = u.pn * 256 + wc * 32 + 8 * fq;
#pragma unroll
        for (int ai = 0; ai < 2; ++ai) {
            f32x4 xr[4][2][2];
#pragma unroll
            for (int m = 0; m < 4; ++m)
#pragma unroll
                for (int bj = 0; bj < 2; ++bj) { const size_t off = (size_t)(row0 + ai * 128 + m * 16) * DM + col0 + bj * 128; xr[m][bj][0] = __builtin_nontemporal_load((const f32x4*)(X + off)); xr[m][bj][1] = __builtin_nontemporal_load((const f32x4*)(X + off + 4)); }
#pragma unroll
            for (int m = 0; m < 4; ++m) { const int row = row0 + ai * 128 + m * 16; float ss = 0.f; const float sfin = TAB ? tab[512 + ai * 128 + wr * 64 + m * 16 + fr] : 1.0f;
#pragma unroll
                for (int bj = 0; bj < 2; ++bj) { const size_t off = (size_t)row * DM + col0 + bj * 128;
                    const f32x4 v0 = xr[m][bj][0] + acc[ai][bj][m][0] * sfin, v1 = xr[m][bj][1] + acc[ai][bj][m][1] * sfin;
                    ss += (v0[0] * v0[0] + v0[1] * v0[1]) + (v0[2] * v0[2] + v0[3] * v0[3]) + (v1[0] * v1[0] + v1[1] * v1[1]) + (v1[2] * v1[2] + v1[3] * v1[3]);
                    u32x4 w; w.x = pk2(v0[0], v0[1]); w.y = pk2(v0[2], v0[3]); w.z = pk2(v1[0], v1[1]); w.w = pk2(v1[2], v1[3]); *(u32x4*)(X1B + off) = w; }
                ss += __shfl_xor(ss, 16); ss += __shfl_xor(ss, 32);
                if (fq == 0) atomicAdd(SSF + row, ss); } }
    }
};
struct EpiFF1 {
    static constexpr bool PERM = true, MID = false, AFTER_DRAIN = false;
    bf16_t* H; const float* SSF;
    __device__ __forceinline__ void operator()(const f32x4 (&acc)[2][2][4][2], const pg8::Unit& u, int wr, int wc, int fr, int fq) const {
        const int row0 = u.pm * 256 + wr * 64 + fr, col0 = u.pn * 256 + wc * 32 + 8 * fq;
        float sv[2][4];
#pragma unroll
        for (int ai = 0; ai < 2; ++ai)
#pragma unroll
            for (int m = 0; m < 4; ++m) sv[ai][m] = SSF[row0 + ai * 128 + m * 16];
#pragma unroll
        for (int ai = 0; ai < 2; ++ai)
#pragma unroll
            for (int m = 0; m < 4; ++m) { const int row = row0 + ai * 128 + m * 16; const float s = rs_from_ss(sv[ai][m], 1024.f);
#pragma unroll
                for (int bj = 0; bj < 2; ++bj) { f32x4 v0 = acc[ai][bj][m][0] * s, v1 = acc[ai][bj][m][1] * s;
#pragma unroll
                    for (int i = 0; i < 4; ++i) { const float a = fmaxf(v0[i], 0.f), b = fmaxf(v1[i], 0.f); v0[i] = a * a; v1[i] = b * b; }
                    u32x4 w; w.x = pk2(v0[0], v0[1]); w.y = pk2(v0[2], v0[3]); w.z = pk2(v1[0], v1[1]); w.w = pk2(v1[2], v1[3]); *(u32x4*)(H + (size_t)row * DFF + col0 + bj * 128) = w; } }
    }
};
struct EpiFF2 {
    static constexpr bool PERM = true, MID = false, AFTER_DRAIN = false;
    float* X1; const bf16_t* X1B;
    __device__ __forceinline__ void operator()(const f32x4 (&acc)[2][2][4][2], const pg8::Unit& u, int wr, int wc, int fr, int fq) const {
        const int row0 = u.pm * 256 + wr * 64 + fr, col0 = u.pn * 256 + wc * 32 + 8 * fq;
#pragma unroll
        for (int ai = 0; ai < 2; ++ai)
#pragma unroll
            for (int m = 0; m < 4; ++m) { const int row = row0 + ai * 128 + m * 16;
#pragma unroll
                for (int bj = 0; bj < 2; ++bj) { float* p = X1 + (size_t)row * DM + col0 + bj * 128; const u32x4 xw = *(const u32x4*)(X1B + (size_t)row * DM + col0 + bj * 128);
                    const f32x4 v0 = (f32x4){bflo(xw.x), bfhi(xw.x), bflo(xw.y), bfhi(xw.y)} + acc[ai][bj][m][0], v1 = (f32x4){bflo(xw.z), bfhi(xw.z), bflo(xw.w), bfhi(xw.w)} + acc[ai][bj][m][1]; *(f32x4*)p = v0; *(f32x4*)(p + 4) = v1; } }
    }
};

struct EpiFF2Norm {
    static constexpr bool PERM = true, MID = false, AFTER_DRAIN = true;
    float* X1; const bf16_t* X1B; const float* gain; float* slots; unsigned* cnt;
    __device__ __forceinline__ void fused(f32x4 (&acc)[2][2][4][2], const pg8::Unit& u, int wr, int wc, int fr, int fq, LAS unsigned char* lds, int tid) const {
        LAS float* P = (LAS float*)lds;
        const int row0 = u.pm * 256 + wr * 64 + fr, col0 = u.pn * 256 + wc * 32 + 8 * fq;
#pragma unroll
        for (int ai = 0; ai < 2; ++ai)
#pragma unroll
            for (int m = 0; m < 4; ++m) { const int row = row0 + ai * 128 + m * 16; float ss = 0.f;
#pragma unroll
                for (int bj = 0; bj < 2; ++bj) { const u32x4 xw = *(const u32x4*)(X1B + (size_t)row * DM + col0 + bj * 128);
                    const f32x4 v0 = (f32x4){bflo(xw.x), bfhi(xw.x), bflo(xw.y), bfhi(xw.y)} + acc[ai][bj][m][0], v1 = (f32x4){bflo(xw.z), bfhi(xw.z), bflo(xw.w), bfhi(xw.w)} + acc[ai][bj][m][1]; acc[ai][bj][m][0] = v0; acc[ai][bj][m][1] = v1;
                    ss += (v0[0] * v0[0] + v0[1] * v0[1]) + (v0[2] * v0[2] + v0[3] * v0[3]) + (v1[0] * v1[0] + v1[1] * v1[1]) + (v1[2] * v1[2] + v1[3] * v1[3]); }
                ss += __shfl_xor(ss, 16); ss += __shfl_xor(ss, 32);
                if (fq == 0) P[(ai * 128 + wr * 64 + m * 16 + fr) * 4 + wc] = ss; }
        __syncthreads();
        if (tid < 256) { const f32x4 q = *(const LAS f32x4*)(P + tid * 4); const float s = (q[0] + q[1]) + (q[2] + q[3]);
            __hip_atomic_store(slots + (size_t)(u.pm * 256 + tid) * 4 + u.pn, s, __ATOMIC_RELAXED, __HIP_MEMORY_SCOPE_AGENT); }
        asm volatile("s_waitcnt vmcnt(0)" ::: "memory");
        __syncthreads();
        if (tid == 0) { unsigned* c = cnt + 64 * u.pm; __hip_atomic_fetch_add(c, 1u, __ATOMIC_RELAXED, __HIP_MEMORY_SCOPE_AGENT);
            unsigned sp = 0; while (__hip_atomic_load(c, __ATOMIC_RELAXED, __HIP_MEMORY_SCOPE_AGENT) < 4u && ++sp < (1u << 22)) __builtin_amdgcn_s_sleep(1); }
        __syncthreads();
        if (tid < 256) { const float* sl = slots + (size_t)(u.pm * 256 + tid) * 4; float t = 0.f;
#pragma unroll
            for (int k = 0; k < 4; ++k) t += __hip_atomic_load(sl + k, __ATOMIC_RELAXED, __HIP_MEMORY_SCOPE_AGENT);
            P[1024 + tid] = rs_from_ss(t, 1024.f); }
        __syncthreads();
        f32x4 gv[2][2];
#pragma unroll
        for (int bj = 0; bj < 2; ++bj) { gv[bj][0] = *(const f32x4*)(gain + col0 + bj * 128); gv[bj][1] = *(const f32x4*)(gain + col0 + bj * 128 + 4); }
#pragma unroll
        for (int ai = 0; ai < 2; ++ai)
#pragma unroll
            for (int m = 0; m < 4; ++m) { const int rl = ai * 128 + wr * 64 + m * 16 + fr; const float rs = P[1024 + rl];
#pragma unroll
                for (int bj = 0; bj < 2; ++bj) { float* p = X1 + (size_t)(u.pm * 256 + rl) * DM + col0 + bj * 128;
                    __builtin_nontemporal_store(acc[ai][bj][m][0] * rs * gv[bj][0], (f32x4*)p); __builtin_nontemporal_store(acc[ai][bj][m][1] * rs * gv[bj][1], (f32x4*)(p + 4)); } }
        __syncthreads();
    }
};

template <int KSPLIT = 1, int NCT = 1, class F>
__device__ __forceinline__ void skinny_gemm(LAS unsigned char* lds, const bf16_t* A, int lda, const bf16_t* Bt, int ldb, int K, int nct, const F& f) {
    const int tid = threadIdx.x, wid = tid >> 6, lane = tid & 63;
    LAS float* red = (LAS float*)lds;
    const int ncu = (nct + NCT - 1) / NCT, nunits = 4 * ncu * KSPLIT, kw = (K / KSPLIT) >> 3;
    for (int uu = blockIdx.x; uu < nunits; uu += gridDim.x) {
        const int u = uu / KSPLIT, ksl = uu % KSPLIT;
        const int rt = u & 3, ct = (u >> 2) * NCT;
        const bf16_t* ap = A + (size_t)(rt * 32 + (lane & 31)) * lda + ksl * (K / KSPLIT) + wid * kw + (lane >> 5) * 8;
        const bf16_t* bp = Bt + (size_t)(ct * 32 + (lane & 31)) * ldb + ksl * (K / KSPLIT) + wid * kw + (lane >> 5) * 8;
        f32x16 acc[NCT];
#pragma unroll
        for (int c = 0; c < NCT; ++c)
#pragma unroll
            for (int i = 0; i < 16; ++i) acc[c][i] = 0.f;
#pragma unroll 8
        for (int kk = 0; kk < kw; kk += 16) { const bf16x8 a = *(const bf16x8*)(ap + kk);
#pragma unroll
            for (int c = 0; c < NCT; ++c) { const bf16x8 b = *(const bf16x8*)(bp + (size_t)c * 32 * ldb + kk); acc[c] = __builtin_amdgcn_mfma_f32_32x32x16_bf16(a, b, acc[c], 0, 0, 0); } }
#pragma unroll
        for (int c = 0; c < NCT; ++c)
#pragma unroll
            for (int r = 0; r < 16; ++r) red[(c * 8 + wid) * 1056 + ((r & 3) + 8 * (r >> 2) + 4 * (lane >> 5)) * 33 + (lane & 31)] = acc[c][r];
        __syncthreads();
        const int row = tid >> 4, cc = (tid & 15) * 2;
#pragma unroll
        for (int c = 0; c < NCT; ++c) { float lo0 = 0.f, lo1 = 0.f, hi0 = 0.f, hi1 = 0.f;
#pragma unroll
            for (int w = 0; w < 4; ++w) { lo0 += red[(c * 8 + w) * 1056 + row * 33 + cc]; lo1 += red[(c * 8 + w) * 1056 + row * 33 + cc + 1]; hi0 += red[(c * 8 + w + 4) * 1056 + row * 33 + cc]; hi1 += red[(c * 8 + w + 4) * 1056 + row * 33 + cc + 1]; }
            f(rt * 32 + row, (ct + c) * 32 + cc, lo0, hi0, lo1, hi1); }
        __syncthreads();
    }
}
__device__ __forceinline__ float red16(float v) { v += __shfl_xor(v, 1); v += __shfl_xor(v, 2); v += __shfl_xor(v, 4); v += __shfl_xor(v, 8); return v; }

__device__ __forceinline__ void p0_transpose_item(const float* W, int K, int Nsrc, int N, bf16_t* WT, const float* gain, LAS float* scr, int item, int lane) {
    const int nblk = N / 32, kb = item / nblk, nb = item % nblk, k0 = 64 * kb, n0 = 32 * nb;
    const int n = n0 + (lane & 31); const bool ok = n < Nsrc;
    float tv[32];
#pragma unroll
    for (int i = 0; i < 32; ++i) { const int kk = 2 * i + (lane >> 5); tv[i] = ok ? W[(size_t)(k0 + kk) * Nsrc + n] : 0.f; }
    if (gain) {
#pragma unroll
        for (int i = 0; i < 32; ++i) tv[i] *= gain[k0 + 2 * i + (lane >> 5)]; }
#pragma unroll
    for (int i = 0; i < 32; ++i) scr[(2 * i + (lane >> 5)) * 33 + (lane & 31)] = tv[i];
    asm volatile("s_waitcnt lgkmcnt(0)" ::: "memory");
    const int c = lane & 7;
#pragma unroll
    for (int j = 0; j < 4; ++j) { const int nn = (lane >> 3) + 8 * j; const LAS float* s = scr + (8 * c) * 33 + nn;
        u32x4 o; o.x = pk2(s[0 * 33], s[1 * 33]); o.y = pk2(s[2 * 33], s[3 * 33]); o.z = pk2(s[4 * 33], s[5 * 33]); o.w = pk2(s[6 * 33], s[7 * 33]);
        *(u32x4*)(WT + (size_t)(n0 + nn) * K + k0 + 8 * c) = o; }
    asm volatile("s_waitcnt lgkmcnt(0)" ::: "memory");
}

__device__ __forceinline__ void conv4x4(const bf16_t* xcol, long rowg, bool zero_hist3, const float* cw, const float* cbias, int ch, float (&out)[4][4]) {
    float xin[7][4];
#pragma unroll
    for (int rr = 0; rr < 7; ++rr) {
        if (rr < 3 && zero_hist3) { xin[rr][0] = xin[rr][1] = xin[rr][2] = xin[rr][3] = 0.f; }
        else { const u32x2 w = *(const u32x2*)(xcol + (rowg - 3 + rr) * PJ); xin[rr][0] = bflo(w.x); xin[rr][1] = bfhi(w.x); xin[rr][2] = bflo(w.y); xin[rr][3] = bfhi(w.y); }
    }
    const f32x4 b = *(const f32x4*)(cbias + ch);
    f32x4 w[4];
#pragma unroll
    for (int k = 0; k < 4; ++k) w[k] = *(const f32x4*)(cw + k * DCONV + ch);
#pragma unroll
    for (int i = 0; i < 4; ++i)
#pragma unroll
        for (int j = 0; j < 4; ++j) { float v = b[j];
#pragma unroll
            for (int k = 0; k < 4; ++k) v += w[k][j] * xin[i + k][j];
            out[i][j] = siluf_(v); }
}

struct ConvIn { u32x2 x[7]; f32x4 w[4]; f32x4 b; };
__device__ __forceinline__ void conv_load(ConvIn& ci, const bf16_t* xcol, long rowg, const float* cw, const float* cbias, int ch) {
#pragma unroll
    for (int rr = 0; rr < 7; ++rr) ci.x[rr] = *(const u32x2*)(xcol + (rowg - 3 + rr) * PJ);
#pragma unroll
    for (int k = 0; k < 4; ++k) ci.w[k] = *(const f32x4*)(cw + k * DCONV + ch);
    ci.b = *(const f32x4*)(cbias + ch);
}
__device__ __forceinline__ void conv_compute(const ConvIn& ci, bool zero_hist3, float (&out)[4][4]) {
    float xin[7][4];
#pragma unroll
    for (int rr = 0; rr < 7; ++rr) { const bool z = rr < 3 && zero_hist3;
        xin[rr][0] = z ? 0.f : bflo(ci.x[rr].x); xin[rr][1] = z ? 0.f : bfhi(ci.x[rr].x); xin[rr][2] = z ? 0.f : bflo(ci.x[rr].y); xin[rr][3] = z ? 0.f : bfhi(ci.x[rr].y); }
#pragma unroll
    for (int i = 0; i < 4; ++i)
#pragma unroll
        for (int j = 0; j < 4; ++j) { float v = ci.b[j];
#pragma unroll
            for (int k = 0; k < 4; ++k) v += ci.w[k][j] * xin[i + k][j];
            out[i][j] = siluf_(v); }
}

__device__ __forceinline__ void ssd_dt_acum(LAS float* dtv, LAS float* acu, const float* DT, long r0, int g, const float* dt_bias, const float* a_log, int wid, int lane) {
    const int h = g * 8 + wid; const float bias = dt_bias[h], A = -__expf(a_log[h]); const int t0 = 2 * lane;
    const float d0 = softplusf_(DT[(r0 + t0) * 16 + h] + bias), d1 = softplusf_(DT[(r0 + t0 + 1) * 16 + h] + bias);
    const float a0 = d0 * A, s = a0 + d1 * A; float inc = s;
#pragma unroll
    for (int o = 1; o < 64; o <<= 1) { const float v = __shfl_up(inc, o); if (lane >= o) inc += v; }
    const float exc = inc - s;
    dtv[wid * 128 + t0] = d0; dtv[wid * 128 + t0 + 1] = d1; acu[wid * 128 + t0] = exc + a0; acu[wid * 128 + t0 + 1] = exc + s;
}

struct Frame {
    const float* in[30]; float* out; unsigned char* ws;
    bf16_t *WIN, *WGLU, *WOUT, *WFF1, *WFF2, *XN, *PROJ, *ST, *HID, *BBT, *CM, *XS;
    float *SS5, *SSF, *CD, *DT; f32x2 *AB, *AQ, *SE, *PW, *A32; bf16_t* BBS;
};
#define MFMA16(a, b, c) __builtin_amdgcn_mfma_f32_16x16x32_bf16((a), (b), (c), 0, 0, 0)
#define MFMA32(a, b, c) __builtin_amdgcn_mfma_f32_32x32x16_bf16((a), (b), (c), 0, 0, 0)

__device__ __forceinline__ void ssd_states_tile(LAS unsigned char* lds, const Frame& F, int b, int c, int g) {
    const int tid = threadIdx.x, wid = __builtin_amdgcn_readfirstlane(tid >> 6), lane = tid & 63, fr = lane & 15, fq = lane >> 4;
    LAS bf16_t* Bt = (LAS bf16_t*)lds; LAS bf16_t* Xt0 = (LAS bf16_t*)(lds + 34816);
    LAS float* dtv = (LAS float*)(lds + 69632); LAS float* acu = dtv + 1024;
    const long r0 = (long)b * SEQ + c * 128; const bool zh = (c == 0);
    const float* cw = F.in[19]; const float* cbias = F.in[20];
    const int xcg = tid & 15, xtg = tid >> 4;
    ConvIn cx, cb0, cb1;
    { const int q0 = tid, q1 = tid + 512;
      conv_load(cb0, F.PROJ + 2048 + 1024 + g * 128 + (q0 & 31) * 4, r0 + (q0 >> 5) * 4, cw, cbias, 1024 + g * 128 + (q0 & 31) * 4);
      conv_load(cb1, F.PROJ + 2048 + 1024 + g * 128 + (q1 & 31) * 4, r0 + (q1 >> 5) * 4, cw, cbias, 1024 + g * 128 + (q1 & 31) * 4); }
    conv_load(cx, F.PROJ + 2048 + g * 512 + xcg * 4, r0 + xtg * 4, cw, cbias, g * 512 + xcg * 4);
    ssd_dt_acum(dtv, acu, F.DT, r0, g, F.in[22], F.in[21], wid, lane);
    { float o[4][4]; int q = tid;
      conv_compute(cb0, zh && (q >> 5) == 0, o);
#pragma unroll
      for (int j = 0; j < 4; ++j) *(LAS u32x2*)(Bt + ((q & 31) * 4 + j) * XT_P + (q >> 5) * 4) = (u32x2){pk2(o[0][j], o[1][j]), pk2(o[2][j], o[3][j])};
      q = tid + 512; conv_compute(cb1, false, o);
#pragma unroll
      for (int j = 0; j < 4; ++j) *(LAS u32x2*)(Bt + ((q & 31) * 4 + j) * XT_P + (q >> 5) * 4) = (u32x2){pk2(o[0][j], o[1][j]), pk2(o[2][j], o[3][j])}; }
    __syncthreads();
#pragma unroll 1
    for (int hh = 0; hh < 8; ++hh) { const int h = g * 8 + hh; const float a_last = acu[hh * 128 + 127]; LAS bf16_t* Xt = Xt0 + (hh & 1) * (64 * XT_P);
        { float o[4][4], f[4];
          conv_compute(cx, zh && xtg == 0, o);
          if (hh < 7) conv_load(cx, F.PROJ + 2048 + h * 64 + 64 + xcg * 4, r0 + xtg * 4, cw, cbias, h * 64 + 64 + xcg * 4);
#pragma unroll
          for (int i = 0; i < 4; ++i) *(u32x2*)(F.XS + (size_t)(r0 + xtg * 4 + i) * DM + h * 64 + xcg * 4) = (u32x2){pk2(o[i][0], o[i][1]), pk2(o[i][2], o[i][3])};
#pragma unroll
          for (int i = 0; i < 4; ++i) f[i] = dtv[hh * 128 + xtg * 4 + i] * __expf(a_last - acu[hh * 128 + xtg * 4 + i]);
#pragma unroll
          for (int j = 0; j < 4; ++j) *(LAS u32x2*)(Xt + (xcg * 4 + j) * XT_P + xtg * 4) = (u32x2){pk2(o[0][j] * f[0], o[1][j] * f[1]), pk2(o[2][j] * f[2], o[3][j] * f[3])}; }
        __syncthreads();
        f32x4 acc[4];
#pragma unroll
        for (int i = 0; i < 4; ++i) acc[i] = (f32x4){0.f, 0.f, 0.f, 0.f};
#pragma unroll
        for (int ks = 0; ks < 4; ++ks) { const bf16x8 bfr = *(const LAS bf16x8*)(Bt + (16 * wid + fr) * XT_P + ks * 32 + fq * 8);
#pragma unroll
            for (int i = 0; i < 4; ++i) { const bf16x8 afr = *(const LAS bf16x8*)(Xt + (16 * i + fr) * XT_P + ks * 32 + fq * 8); acc[i] = MFMA16(bfr, afr, acc[i]); } }
        bf16_t* st = F.ST + ((size_t)((b * 16 + c) * 16 + h) * 64) * 128;
#pragma unroll
        for (int i = 0; i < 4; ++i) *(u32x2*)(st + (size_t)(16 * i + fr) * 128 + 16 * wid + 4 * fq) = (u32x2){pk2(acc[i][0], acc[i][1]), pk2(acc[i][2], acc[i][3])};
        if (tid == 0) F.CD[(b * 16 + c) * 16 + h] = __expf(a_last);
    }
    if (c == NCH - 1) {
        for (int e = tid; e < 3 * 768; e += 512) { const int k = e / 768, ch = g * 768 + e % 768;
            F.out[O_CVP + (size_t)(b * 3 + k) * DCONV + ch] = bf2f(F.PROJ[(size_t)(b * SEQ + SEQ - 3 + k) * PJ + 2048 + ch]); }
    }
    __syncthreads();
}

__device__ __forceinline__ void ssd_y_tile(LAS unsigned char* lds, const Frame& F, int b, int c, int g, bool defer_gn) {
    const int tid = threadIdx.x, wid = __builtin_amdgcn_readfirstlane(tid >> 6), lane = tid & 63, fr = lane & 15, fq = lane >> 4;
    LAS bf16_t* Bs = (LAS bf16_t*)lds; LAS bf16_t* Ps = Bs; LAS bf16_t* Cs = (LAS bf16_t*)(lds + 34816);
    LAS bf16_t* Xt0 = (LAS bf16_t*)(lds + 69632); LAS bf16_t* Hs0 = (LAS bf16_t*)(lds + 104448);
    LAS float* dtv = (LAS float*)(lds + 139264); LAS float* acu = dtv + 1024;
    LAS float* T0 = (LAS float*)(lds + 147456);
    const long r0 = (long)b * SEQ + c * 128; const bool zh = (c == 0);
    const float* cw = F.in[19]; const float* cbias = F.in[20];
    const int xcg = tid & 15, xtg = tid >> 4;
    const int l = 16 * wid + fr;
    bf16_t* zrow = F.PROJ + (size_t)(r0 + l) * PJ + 1024 + g * 512 + 4 * fq;
    const bf16_t* hsrc = F.ST + ((size_t)((b * 16 + c) * 16 + g * 8) * 64 + (tid >> 3)) * 128 + (tid & 7) * 16;
    const bf16_t* xsrc = F.XS + (size_t)(r0 + xtg * 4) * DM + g * 512 + xcg * 4;
    u32x2 xv[4]; u32x4 hv0, hv1; u32x2 zw[4];
    { ConvIn cq[2];
#pragma unroll
      for (int rnd = 0; rnd < 2; ++rnd) {
#pragma unroll
        for (int k = 0; k < 2; ++k) { const int q = tid + 512 * (rnd * 2 + k), qq = q & 1023, ch = 1024 + (q >> 10) * 256 + g * 128 + (qq & 31) * 4; conv_load(cq[k], F.PROJ + 2048 + ch, r0 + (qq >> 5) * 4, cw, cbias, ch); }
        if (rnd == 0) ssd_dt_acum(dtv, acu, F.DT, r0, g, F.in[22], F.in[21], wid, lane);
        if (rnd == 1) { hv0 = *(const u32x4*)hsrc; hv1 = *(const u32x4*)(hsrc + 8);
#pragma unroll
            for (int i = 0; i < 4; ++i) xv[i] = *(const u32x2*)(xsrc + (size_t)i * DM);
#pragma unroll
            for (int pt = 0; pt < 4; ++pt) zw[pt] = *(const u32x2*)(zrow + 16 * pt); }
#pragma unroll
        for (int k = 0; k < 2; ++k) { const int q = tid + 512 * (rnd * 2 + k), qq = q & 1023; float o[4][4]; conv_compute(cq[k], zh && (qq >> 5) == 0, o);
            LAS bf16_t* dst = (q >> 10) ? Cs : Bs;
#pragma unroll
            for (int i = 0; i < 4; ++i) *(LAS u32x2*)(dst + ((qq >> 5) * 4 + i) * XT_P + (qq & 31) * 4) = (u32x2){pk2(o[i][0], o[i][1]), pk2(o[i][2], o[i][3])}; } } }
    __syncthreads();
#pragma unroll
    for (int k = 0; k < 2; ++k) { const int idx = tid + 512 * k, w = idx >> 7, s = idx & 127; T0[idx] = (s < 16 * w) ? __expf(acu[16 * w] - acu[s]) : 0.f; }
    f32x4 cb[8]; bf16x8 cfr[4];
#pragma unroll
    for (int st = 0; st < 8; ++st) cb[st] = (f32x4){0.f, 0.f, 0.f, 0.f};
#pragma unroll
    for (int ks = 0; ks < 4; ++ks) cfr[ks] = *(const LAS bf16x8*)(Cs + (16 * wid + fr) * XT_P + ks * 32 + fq * 8);
#pragma unroll
    for (int st = 0; st < 8; ++st) if (st <= wid) {
#pragma unroll
        for (int ks = 0; ks < 4; ++ks) { const bf16x8 bfr = *(const LAS bf16x8*)(Bs + (16 * st + fr) * XT_P + ks * 32 + fq * 8); cb[st] = MFMA16(bfr, cfr[ks], cb[st]); } }
    __syncthreads();
    float ss = 0.f;
#pragma unroll 1
    for (int hh = 0; hh < 8; ++hh) { const int h = g * 8 + hh; LAS bf16_t* Xt = Xt0 + (hh & 1) * (64 * XT_P); LAS bf16_t* Hs = Hs0 + (hh & 1) * (64 * XT_P);
        LAS float* T = T0 + (hh & 1) * 1024; LAS float* Tn = T0 + ((hh + 1) & 1) * 1024;
        { float f[4], o[4][4];
#pragma unroll
          for (int i = 0; i < 4; ++i) { f[i] = dtv[hh * 128 + xtg * 4 + i]; o[i][0] = bflo(xv[i].x) * f[i]; o[i][1] = bfhi(xv[i].x) * f[i]; o[i][2] = bflo(xv[i].y) * f[i]; o[i][3] = bfhi(xv[i].y) * f[i]; }
#pragma unroll
          for (int j = 0; j < 4; ++j) *(LAS u32x2*)(Xt + (xcg * 4 + j) * XT_P + xtg * 4) = (u32x2){pk2(o[0][j], o[1][j]), pk2(o[2][j], o[3][j])}; }
        *(LAS u32x4*)(Hs + (tid >> 3) * XT_P + (tid & 7) * 16) = hv0; *(LAS u32x4*)(Hs + (tid >> 3) * XT_P + (tid & 7) * 16 + 8) = hv1;
        u32x2 zc[4];
#pragma unroll
        for (int pt = 0; pt < 4; ++pt) zc[pt] = zw[pt];
        if (hh < 7) {
            hv0 = __builtin_nontemporal_load((const u32x4*)(hsrc + (size_t)(hh + 1) * 8192)); hv1 = __builtin_nontemporal_load((const u32x4*)(hsrc + (size_t)(hh + 1) * 8192 + 8));
#pragma unroll
            for (int i = 0; i < 4; ++i) xv[i] = __builtin_nontemporal_load((const u32x2*)(xsrc + (size_t)i * DM + (hh + 1) * 64));
#pragma unroll
            for (int pt = 0; pt < 4; ++pt) zw[pt] = *(const u32x2*)(zrow + (hh + 1) * 64 + 16 * pt);
#pragma unroll
            for (int k = 0; k < 2; ++k) { const int idx = tid + 512 * k, w = idx >> 7, s = idx & 127; Tn[idx] = (s < 16 * w) ? __expf(acu[(hh + 1) * 128 + 16 * w] - acu[(hh + 1) * 128 + s]) : 0.f; } }
        const float al = acu[hh * 128 + l], elw = __expf(al - acu[hh * 128 + 16 * wid]);
#pragma unroll
        for (int st = 0; st < 8; ++st) if (st <= (wid | 1)) { const int s0 = 16 * st + 4 * fq; float v[4];
            if (st < wid) { const f32x4 tv = *(const LAS f32x4*)(T + wid * 128 + s0);
#pragma unroll
                for (int j = 0; j < 4; ++j) v[j] = cb[st][j] * elw * tv[j]; }
            else {
#pragma unroll
                for (int j = 0; j < 4; ++j) v[j] = (s0 + j <= l) ? cb[st][j] * __expf(al - acu[hh * 128 + s0 + j]) : 0.f; }
            *(LAS u32x2*)(Ps + l * XT_P + s0) = (u32x2){pk2(v[0], v[1]), pk2(v[2], v[3])}; }
        __syncthreads();
        f32x4 accY[4], accO[4];
#pragma unroll
        for (int i = 0; i < 4; ++i) { accY[i] = (f32x4){0.f, 0.f, 0.f, 0.f}; accO[i] = (f32x4){0.f, 0.f, 0.f, 0.f}; }
#pragma unroll
        for (int ks = 0; ks < 4; ++ks) {
            if (ks <= (wid >> 1)) { const bf16x8 pfr = *(const LAS bf16x8*)(Ps + l * XT_P + ks * 32 + fq * 8);
#pragma unroll
                for (int pt = 0; pt < 4; ++pt) { const bf16x8 xfr = *(const LAS bf16x8*)(Xt + (16 * pt + fr) * XT_P + ks * 32 + fq * 8); accY[pt] = MFMA16(xfr, pfr, accY[pt]); } }
#pragma unroll
            for (int pt = 0; pt < 4; ++pt) { const bf16x8 hfr = *(const LAS bf16x8*)(Hs + (16 * pt + fr) * XT_P + ks * 32 + fq * 8); accO[pt] = MFMA16(hfr, cfr[ks], accO[pt]); } }
        const float el = __expf(al), rdt = 1.0f / dtv[hh * 128 + l], Dh = F.in[23][h];
#pragma unroll
        for (int pt = 0; pt < 4; ++pt) { bf16_t* zp = zrow + hh * 64 + 16 * pt;
            const float z[4] = {bflo(zc[pt].x), bfhi(zc[pt].x), bflo(zc[pt].y), bfhi(zc[pt].y)}; float y[4];
#pragma unroll
            for (int j = 0; j < 4; ++j) { const float xs = bf2f(Xt[(16 * pt + 4 * fq + j) * XT_P + l]) * rdt; y[j] = (accY[pt][j] + el * accO[pt][j] + Dh * xs) * siluf_(z[j]); ss += y[j] * y[j]; }
            *(u32x2*)zp = (u32x2){pk2(y[0], y[1]), pk2(y[2], y[3])}; }
    }
    ss += __shfl_xor(ss, 16); ss += __shfl_xor(ss, 32);
    if (defer_gn) { if (fq == 0) ((float*)(F.ws + WS_SSG))[(size_t)(r0 + l) * 2 + g] = ss; __syncthreads(); return; }
    const float rs = rs_from_ss(ss, 512.f);
    asm volatile("s_waitcnt vmcnt(0)" ::: "memory");
    { u32x2 wv[32];
#pragma unroll
      for (int i = 0; i < 32; ++i) wv[i] = *(const u32x2*)(zrow + 16 * i);
#pragma unroll
      for (int i = 0; i < 32; ++i) *(u32x2*)(zrow + 16 * i) = (u32x2){pk2(bflo(wv[i].x) * rs, bfhi(wv[i].x) * rs), pk2(bflo(wv[i].y) * rs, bfhi(wv[i].y) * rs)}; }
    __syncthreads();
}

__device__ __forceinline__ void s5_pass_a(const Frame& F, int gw, int NGW, int lane) {
    const int p0 = lane & 31, half = lane >> 5;
    bf16x8 afr[4];
    if (gw < NB * NCH * 64) { const bf16_t* ap = F.PROJ + (size_t)((gw >> 6) * 128 + p0) * PJ + (gw & 63) * 16 + half * 8;
#pragma unroll
        for (int rt = 0; rt < 4; ++rt) afr[rt] = *(const bf16x8*)(ap + (size_t)rt * 32 * PJ); }
#pragma unroll 1
    for (int job = gw; job < NB * NCH * 64; job += NGW) { const int g = job & 63, bc = job >> 6;
        bf16x8 acur[4];
#pragma unroll
        for (int rt = 0; rt < 4; ++rt) acur[rt] = afr[rt];
        if (job + NGW < NB * NCH * 64) { const int nj = job + NGW; const bf16_t* ap = F.PROJ + (size_t)((nj >> 6) * 128 + p0) * PJ + (nj & 63) * 16 + half * 8;
#pragma unroll
            for (int rt = 0; rt < 4; ++rt) afr[rt] = *(const bf16x8*)(ap + (size_t)rt * 32 * PJ); }
        float sr[2], si[2];
#pragma unroll
        for (int pp = 0; pp < 2; ++pp) { const int p = p0 + 32 * pp;
            const bf16x8 bre = *(const bf16x8*)(F.BBS + (size_t)(g * 128 + p) * 16 + half * 8), bim = *(const bf16x8*)(F.BBS + (size_t)(g * 128 + 64 + p) * 16 + half * 8);
            f32x2 w[16];
#pragma unroll
            for (int r = 0; r < 16; ++r) w[r] = F.PW[(size_t)((g * 2 + half) * 16 + r) * 64 + p];
            const f32x2 q = F.A32[g * 64 + p];
            float s_r = 0.f, s_i = 0.f;
#pragma unroll
            for (int rt = 0; rt < 4; ++rt) { f32x16 z;
#pragma unroll
                for (int r = 0; r < 16; ++r) z[r] = 0.f;
                const f32x16 are = MFMA32(acur[rt], bre, z), aim = MFMA32(acur[rt], bim, z);
                float tr = 0.f, ti = 0.f;
#pragma unroll
                for (int r = 0; r < 16; ++r) { tr += w[r].x * are[r] - w[r].y * aim[r]; ti += w[r].x * aim[r] + w[r].y * are[r]; }
                tr += __shfl_xor(tr, 32); ti += __shfl_xor(ti, 32);
                const float nr = q.x * s_r - q.y * s_i + tr, ni = q.x * s_i + q.y * s_r + ti; s_r = nr; s_i = ni; }
            sr[pp] = s_r; si[pp] = s_i; __builtin_amdgcn_sched_barrier(0); }
        F.SE[((size_t)((bc >> 4) * 64 + g) * 16 + (bc & 15)) * 64 + lane] = half ? (f32x2){sr[1], si[1]} : (f32x2){sr[0], si[0]};
    }
}
__device__ __forceinline__ void s5_pass_b(LAS unsigned char* wl, const Frame& F, int gw, int NGW, int lane) {
    int gcur = -1; bf16x8 bfr[4], cfr[4]; f32x4 d4; f32x2 a;
#pragma unroll 1
    for (int job = gw; job < NB * NCH * 64; job += NGW) { const int g = job & 63, bc = job >> 6;
        if (g != gcur) { gcur = g;
#pragma unroll
            for (int j = 0; j < 4; ++j) bfr[j] = *(const bf16x8*)(F.BBT + (size_t)(g * 128 + j * 32 + (lane & 31)) * 16 + (lane >> 5) * 8);
#pragma unroll
            for (int ks = 0; ks < 4; ++ks) cfr[ks] = *(const bf16x8*)(F.CM + (size_t)(g * 16 + (lane & 15)) * 128 + ks * 32 + (lane >> 4) * 8);
            d4 = *(const f32x4*)(F.in[15] + g * 16 + 4 * (lane >> 4)); a = F.AB[g * 64 + lane]; }
        const size_t r0 = (size_t)bc * 128;
        const bf16_t* ap = F.PROJ + (r0 + (lane & 31)) * PJ + g * 16 + (lane >> 5) * 8;
        const bf16_t* up = F.PROJ + (r0 + (lane & 15)) * PJ + g * 16 + 4 * (lane >> 4);
        bf16x8 afr[4]; u32x2 uw[8];
#pragma unroll
        for (int rt = 0; rt < 4; ++rt) afr[rt] = *(const bf16x8*)(ap + (size_t)rt * 32 * PJ);
#pragma unroll
        for (int i = 0; i < 8; ++i) uw[i] = *(const u32x2*)(up + (size_t)i * 16 * PJ);
        const f32x2 h0 = F.SE[((size_t)((bc >> 4) * 64 + g) * 16 + (bc & 15)) * 64 + lane]; float hr = h0.x, hi = h0.y;
#pragma unroll
        for (int rt = 0; rt < 4; ++rt) {
#pragma unroll
            for (int j = 0; j < 4; ++j) { f32x16 acc;
#pragma unroll
                for (int r = 0; r < 16; ++r) acc[r] = 0.f;
                acc = MFMA32(afr[rt], bfr[j], acc);
#pragma unroll
                for (int r = 0; r < 16; ++r) *(LAS float*)(wl + ((r & 3) + 8 * (r >> 2) + 4 * (lane >> 5)) * 528 + (j * 32 + (lane & 31)) * 4) = acc[r]; }
#pragma unroll 8
            for (int t = 0; t < 32; ++t) { const f32x2 bu = *(const LAS f32x2*)(wl + t * 528 + lane * 8);
                const float nr = a.x * hr - a.y * hi + bu.x, ni = a.x * hi + a.y * hr + bu.y; hr = nr; hi = ni;
                *(LAS unsigned*)(wl + t * 528 + lane * 4) = pk2(hr, hi); }
#pragma unroll
            for (int half = 0; half < 2; ++half) { f32x4 accy = (f32x4){0.f, 0.f, 0.f, 0.f};
#pragma unroll
                for (int ks = 0; ks < 4; ++ks) { const bf16x8 hfr = *(const LAS bf16x8*)(wl + (half * 16 + (lane & 15)) * 528 + (ks * 32 + (lane >> 4) * 8) * 2); accy = MFMA16(cfr[ks], hfr, accy); }
                const size_t row = r0 + rt * 32 + half * 16 + (lane & 15); const u32x2 u2 = uw[rt * 2 + half];
                const float y0 = gelu_tanh(accy[0] + d4[0] * bflo(u2.x)), y1 = gelu_tanh(accy[1] + d4[1] * bfhi(u2.x)), y2 = gelu_tanh(accy[2] + d4[2] * bflo(u2.y)), y3 = gelu_tanh(accy[3] + d4[3] * bfhi(u2.y));
                *(u32x2*)(F.XN + row * DM + g * 16 + 4 * (lane >> 4)) = (u32x2){pk2(y0, y1), pk2(y2, y3)}; }
        }
    }
}

struct S5In { u32x4 u0, u1, br0, br1, bi0, bi1; float h0r, h0i, ul, dl; f32x2 a; unsigned cm[16]; };
__device__ __forceinline__ void s5_sample_load(S5In& q, const Frame& F, int bs, int g, int lane) {
    const bf16_t* up = F.PROJ + ((size_t)MP + bs) * PJ + g * 16; q.u0 = *(const u32x4*)up; q.u1 = *(const u32x4*)(up + 8); q.ul = bf2f(up[lane & 15]); q.dl = F.in[15][g * 16 + (lane & 15)];
    const bf16_t* bp = F.BBT + (size_t)(g * 128 + 2 * lane) * 16; q.br0 = *(const u32x4*)bp; q.br1 = *(const u32x4*)(bp + 8); q.bi0 = *(const u32x4*)(bp + 16); q.bi1 = *(const u32x4*)(bp + 24);
    const size_t si = (size_t)(bs * 64 + g) * 64 + lane; q.h0r = F.in[2][si]; q.h0i = F.in[3][si]; q.a = F.AB[g * 64 + lane];
#pragma unroll
    for (int c = 0; c < 16; ++c) q.cm[c] = *(const unsigned*)(F.CM + (size_t)(g * 16 + c) * 128 + 2 * lane);
}
__device__ __forceinline__ float dot8bf(const u32x4 w, const float* u) { return (bflo(w.x) * u[0] + bfhi(w.x) * u[1]) + (bflo(w.y) * u[2] + bfhi(w.y) * u[3]) + (bflo(w.z) * u[4] + bfhi(w.z) * u[5]) + (bflo(w.w) * u[6] + bfhi(w.w) * u[7]); }
__device__ __forceinline__ void s5_sample_compute(const S5In& q, const Frame& F, int bs, int g, int lane) {
    const float u[16] = {bflo(q.u0.x), bfhi(q.u0.x), bflo(q.u0.y), bfhi(q.u0.y), bflo(q.u0.z), bfhi(q.u0.z), bflo(q.u0.w), bfhi(q.u0.w), bflo(q.u1.x), bfhi(q.u1.x), bflo(q.u1.y), bfhi(q.u1.y), bflo(q.u1.z), bfhi(q.u1.z), bflo(q.u1.w), bfhi(q.u1.w)};
    const float bre = dot8bf(q.br0, u) + dot8bf(q.br1, u + 8), bim = dot8bf(q.bi0, u) + dot8bf(q.bi1, u + 8);
    const size_t si = (size_t)(bs * 64 + g) * 64 + lane;
    const float hr = q.a.x * q.h0r - q.a.y * q.h0i + bre, hi = q.a.x * q.h0i + q.a.y * q.h0r + bim;
    F.out[O_S5RS + si] = hr; F.out[O_S5IS + si] = hi;
    float yv = 0.f;
#pragma unroll
    for (int c = 0; c < 16; ++c) { const float v = half_sum_dpp(bflo(q.cm[c]) * hr + bfhi(q.cm[c]) * hi);
        const float tot = __builtin_bit_cast(float, __builtin_amdgcn_readlane(__builtin_bit_cast(int, v), 31)) + __builtin_bit_cast(float, __builtin_amdgcn_readlane(__builtin_bit_cast(int, v), 63)); if (lane == c) yv = tot; }
    if (lane < 16) { const float y = gelu_tanh(yv + q.dl * q.ul); F.XN[((size_t)MP + bs) * DM + g * 16 + lane] = (bf16_t)(pk2(y, 0.f) & 0xffffu); }
}
__device__ __forceinline__ void s5_sample_jobs(const Frame& F, int first, int stride, int lane) {
    if (first >= NSAMP * 64) return;
    S5In cur; s5_sample_load(cur, F, first >> 6, first & 63, lane);
#pragma unroll 1
    for (int job = first; job < NSAMP * 64; job += stride) { const int nj = job + stride; S5In nxt = cur;
        if (nj < NSAMP * 64) s5_sample_load(nxt, F, nj >> 6, nj & 63, lane);
        s5_sample_compute(cur, F, job >> 6, job & 63, lane); cur = nxt; }
}

__device__ __forceinline__ void ssd_sample_job(LAS unsigned char* lds, const Frame& F, int bs, int g) {
    const int tid = threadIdx.x, wid = __builtin_amdgcn_readfirstlane(tid >> 6), lane = tid & 63, h = g * 8 + wid, half = lane >> 5, n4 = (lane & 31) * 4;
    LAS float* red = (LAS float*)lds;
    const size_t row = (size_t)MP + bs;
    const int chx = h * 64 + lane, chb = 1024 + g * 128 + n4, chc = 1280 + g * 128 + n4;
    const float* sc = F.in[5] + (size_t)bs * 3 * DCONV; const float* cw = F.in[19]; const bf16_t* xr = F.PROJ + row * PJ + 2048;
    float xx[4], wx[4]; f32x4 xb[4], xc[4], wb[4], wc_[4];
#pragma unroll
    for (int k = 0; k < 3; ++k) { xx[k] = sc[k * DCONV + chx]; xb[k] = *(const f32x4*)(sc + k * DCONV + chb); xc[k] = *(const f32x4*)(sc + k * DCONV + chc); }
    { xx[3] = bf2f(xr[chx]); const u32x2 b2 = *(const u32x2*)(xr + chb), c2 = *(const u32x2*)(xr + chc);
      xb[3] = (f32x4){bflo(b2.x), bfhi(b2.x), bflo(b2.y), bfhi(b2.y)}; xc[3] = (f32x4){bflo(c2.x), bfhi(c2.x), bflo(c2.y), bfhi(c2.y)}; }
#pragma unroll
    for (int k = 0; k < 4; ++k) { wx[k] = cw[k * DCONV + chx]; wb[k] = *(const f32x4*)(cw + k * DCONV + chb); wc_[k] = *(const f32x4*)(cw + k * DCONV + chc); }
    const float bx = F.in[20][chx]; const f32x4 bb = *(const f32x4*)(F.in[20] + chb), bc = *(const f32x4*)(F.in[20] + chc);
    const float dtraw = F.DT[row * 16 + h], dtb = F.in[22][h], alog = F.in[21][h], dh = F.in[23][h];
    bf16_t* zp = F.PROJ + row * PJ + 1024 + h * 64 + lane; const float zv = bf2f(*zp);
    const float xs = siluf_(bx + (wx[0] * xx[0] + wx[1] * xx[1]) + (wx[2] * xx[2] + wx[3] * xx[3]));
    float B4[4], C4[4];
#pragma unroll
    for (int i = 0; i < 4; ++i) { B4[i] = siluf_(bb[i] + (wb[0][i] * xb[0][i] + wb[1][i] * xb[1][i]) + (wb[2][i] * xb[2][i] + wb[3][i] * xb[3][i]));
        C4[i] = siluf_(bc[i] + (wc_[0][i] * xc[0][i] + wc_[1][i] * xc[1][i]) + (wc_[2][i] * xc[2][i] + wc_[3][i] * xc[3][i])); }
    const float dt = softplusf_(dtraw + dtb), dA = __expf(-dt * __expf(alog));
    const float* sp = F.in[4] + ((size_t)(bs * 16 + h) * 64 + half) * 128 + n4;
    float* op = F.out + O_SSDS + ((size_t)(bs * 16 + h) * 64 + half) * 128 + n4;
    const float xdt = xs * dt;
    float y = 0.f;
#pragma unroll
    for (int bt = 0; bt < 2; ++bt) { f32x4 hb[16];
#pragma unroll
        for (int i = 0; i < 16; ++i) hb[i] = __builtin_nontemporal_load((const f32x4*)(sp + (bt * 16 + i) * 256));
#pragma unroll
        for (int i = 0; i < 16; ++i) { const int pp = bt * 16 + i; const float xp = __shfl(xdt, 2 * pp + half); const f32x4 h0 = hb[i];
            const f32x4 hn = (f32x4){dA * h0[0] + xp * B4[0], dA * h0[1] + xp * B4[1], dA * h0[2] + xp * B4[2], dA * h0[3] + xp * B4[3]}; __builtin_nontemporal_store(hn, (f32x4*)(op + pp * 256));
            const float v = half_sum_dpp((C4[0] * hn[0] + C4[1] * hn[1]) + (C4[2] * hn[2] + C4[3] * hn[3]));
            const float t0 = __builtin_bit_cast(float, __builtin_amdgcn_readlane(__builtin_bit_cast(int, v), 31)), t1 = __builtin_bit_cast(float, __builtin_amdgcn_readlane(__builtin_bit_cast(int, v), 63));
            if (lane == 2 * pp) y = t0; if (lane == 2 * pp + 1) y = t1; } }
    { float* oc = F.out + O_CVS + (size_t)bs * 3 * DCONV;
#pragma unroll
      for (int k = 0; k < 3; ++k) { oc[k * DCONV + chx] = xx[k + 1]; if (wid == 0 && half == 0) { *(f32x4*)(oc + k * DCONV + chb) = xb[k + 1]; *(f32x4*)(oc + k * DCONV + chc) = xc[k + 1]; } } }
    y = (y + dh * xs) * siluf_(zv);
    const float ssw = wave_sum(y * y);
    if (lane == 0) red[wid] = ssw;
    __syncthreads();
    float tot = 0.f;
#pragma unroll
    for (int w = 0; w < 8; ++w) tot += red[w];
    *zp = (bf16_t)(pk2(y * rs_from_ss(tot, 512.f), 0.f) & 0xffffu);
    __syncthreads();
}

#define XB_TMO      128
#define XB_XCNT(j)  (256  + 64 * (j))
#define XB_XSUB(j)  (1280 + 64 * (j))
#define XB_XGEN(j)  (2304 + 64 * (j))
#define XB_TOP      3328
#define XB_TOPGEN   3392
#define XCD_BAR_WORDS 3456
#define XB_SPIN_CAP (1u << 18)
__device__ __forceinline__ unsigned xb_ld(unsigned* p)              { return __hip_atomic_load(p, __ATOMIC_RELAXED, __HIP_MEMORY_SCOPE_AGENT); }
__device__ __forceinline__ unsigned xb_add(unsigned* p, unsigned v) { return __hip_atomic_fetch_add(p, v, __ATOMIC_RELAXED, __HIP_MEMORY_SCOPE_AGENT); }
__device__ __forceinline__ unsigned xb_xcc_id() { return (unsigned)__builtin_amdgcn_s_getreg((3 << 11) | 20) & 0xFu; }
#define XB_SPIN(cond, bar) do { unsigned _sp = 0; while (cond) { __builtin_amdgcn_s_sleep(1); \
    if ((++_sp & 255u) == 0u) { if (xb_ld(&(bar)[XB_TMO])) break; if (_sp > XB_SPIN_CAP) { atomicAdd(&(bar)[XB_TMO], 1u); break; } } } } while (0)
struct XcdBarrier { unsigned* bar; unsigned x; volatile LAS unsigned* st; };
__device__ __forceinline__ XcdBarrier xcd_barrier_post(unsigned* bar, volatile LAS unsigned* st) {
    XcdBarrier b; b.bar = bar; b.x = xb_xcc_id(); b.st = st;
    if (threadIdx.x == 0) (void)xb_add(&bar[XB_XCNT(b.x)], 1u);
    return b;
}
__device__ __forceinline__ void xcd_barrier_complete(unsigned* bar, unsigned x, unsigned& nloc, unsigned& nx) {
    const unsigned G = gridDim.x * gridDim.y * gridDim.z;
    unsigned sum, cnt, mine, sp = 0u;
    for (;;) {
        sum = 0u; cnt = 0u; mine = 0u;
#pragma unroll
        for (unsigned j = 0; j < 16; ++j) { const unsigned c = xb_ld(&bar[XB_XCNT(j)]); sum += c; cnt += (c > 0u) ? 1u : 0u; mine = (j == x) ? c : mine; }
        if (sum == G) break;
        __builtin_amdgcn_s_sleep(1);
        if ((++sp & 255u) == 0u) { if (xb_ld(&bar[XB_TMO])) break; if (sp > XB_SPIN_CAP) { atomicAdd(&bar[XB_TMO], 1u); break; } }
    }
    nloc = mine > 0u ? mine : 1u; nx = cnt > 0u ? cnt : 1u;
}
__device__ __forceinline__ void xcd_barrier(const XcdBarrier& b) {
    asm volatile("s_waitcnt vmcnt(0)" ::: "memory");
    __syncthreads();
    if (threadIdx.x == 0) {
        unsigned* bar = b.bar;
        __builtin_amdgcn_s_waitcnt(0);
        unsigned nloc = b.st[0], nx = b.st[1];
        if (nloc == 0u) { xcd_barrier_complete(bar, b.x, nloc, nx); b.st[0] = nloc; b.st[1] = nx; }
        const unsigned old = xb_add(&bar[XB_XSUB(b.x)], 1u);
        const unsigned gen = old / nloc;
        if (old + 1u == (gen + 1u) * nloc) {
            __builtin_amdgcn_fence(__ATOMIC_RELEASE, "agent");
            asm volatile("s_waitcnt vmcnt(0)" ::: "memory");
            const unsigned og = xb_add(&bar[XB_TOP], 1u);
            const unsigned tg = og / nx;
            if (og + 1u == (tg + 1u) * nx) xb_add(&bar[XB_TOPGEN], 1u);
            else XB_SPIN(xb_ld(&bar[XB_TOPGEN]) == tg, bar);
            __builtin_amdgcn_fence(__ATOMIC_ACQUIRE, "agent");
            xb_add(&bar[XB_XGEN(b.x)], 1u);
            asm volatile("s_waitcnt vmcnt(0)" ::: "memory");
        } else {
            XB_SPIN(xb_ld(&bar[XB_XGEN(b.x)]) == gen, bar);
            __builtin_amdgcn_fence(__ATOMIC_ACQUIRE, "agent");
            asm volatile("s_waitcnt vmcnt(0)" ::: "memory");
        }
    }
    __syncthreads();
}

__device__ __forceinline__ void convert_item(const Frame& F, int it, LAS float* scr, int lane) {
    constexpr int I_IN = 16 * (N1 / 32), I_GLU = 16 * 32, I_OUT = 32 * 32, I_FF1 = 16 * 128;
    int r = it;
    if (r < I_IN) { p0_transpose_item(F.in[7], 1024, N1V, N1, F.WIN, nullptr, scr, r, lane); return; } r -= I_IN;
    if (r < I_GLU) { p0_transpose_item(F.in[16], 1024, 1024, 1024, F.WGLU, nullptr, scr, r, lane); return; } r -= I_GLU;
    if (r < I_OUT) { const int k0 = 64 * (r / 32); p0_transpose_item(F.in[25], 2048, 1024, 1024, F.WOUT, k0 < 1024 ? F.in[18] : F.in[24] - 1024, scr, r, lane); return; } r -= I_OUT;
    if (r < I_FF1) { p0_transpose_item(F.in[27], 1024, 4096, 4096, F.WFF1, F.in[26], scr, r, lane); return; } r -= I_FF1;
    p0_transpose_item(F.in[28], 4096, 1024, 1024, F.WFF2, nullptr, scr, r, lane);
}

__global__ void __launch_bounds__(512, 2) hymba_fwd(Args args) {
    extern __shared__ __attribute__((aligned(16))) unsigned char lds_raw[];
    LAS unsigned char* lds = (LAS unsigned char*)lds_raw;
    cg::grid_group grid = cg::this_grid();
    Frame F;
#pragma unroll
    for (int i = 0; i < 30; ++i) F.in[i] = args.in[i];
    F.out = args.out; F.ws = args.ws;
    unsigned char* ws = args.ws;
    F.WIN = (bf16_t*)(ws + WS_WIN); F.WGLU = (bf16_t*)(ws + WS_WGLU); F.WOUT = (bf16_t*)(ws + WS_WOUT); F.WFF1 = (bf16_t*)(ws + WS_WFF1); F.WFF2 = (bf16_t*)(ws + WS_WFF2);
    F.XN = (bf16_t*)(ws + WS_XN); F.PROJ = (bf16_t*)(ws + WS_PROJ); F.ST = (bf16_t*)(ws + WS_ST); F.HID = (bf16_t*)(ws + WS_HID);
    F.XS = (bf16_t*)(ws + WS_XS); F.BBT = (bf16_t*)(ws + WS_BBT); F.CM = (bf16_t*)(ws + WS_CM);
    F.SS5 = (float*)(ws + WS_SS5); F.SSF = (float*)(ws + WS_SSF); F.CD = (float*)(ws + WS_CD); F.DT = (float*)(ws + WS_DT);
    F.PW = (f32x2*)(ws + WS_PW); F.A32 = (f32x2*)(ws + WS_A32); F.BBS = (bf16_t*)(ws + WS_BBS); F.AB = (f32x2*)(ws + WS_AB); F.AQ = (f32x2*)(ws + WS_AQ); F.SE = (f32x2*)(ws + WS_SE);
    const int tid = threadIdx.x, wid = __builtin_amdgcn_readfirstlane(tid >> 6), lane = tid & 63;
    const int G = gridDim.x, gt = blockIdx.x * 512 + tid, GT = G * 512, gw = blockIdx.x * 8 + wid, NGW = G * 8;
    const int lo = args.ph_lo, hi = args.ph_hi;
    const bool late_w = (G == 256);
    if (lo < 0) grid.sync();
    if (tid < 2) ((LAS unsigned*)(lds + LDS_MAIN))[tid] = 0u;
    __syncthreads();
    XcdBarrier bar = xcd_barrier_post((unsigned*)(ws + WS_BAR), (volatile LAS unsigned*)(lds + LDS_MAIN));
#define IN(k) (lo <= (k) && (k) < hi)
#ifndef PROBE_SYNCS
#define PROBE_SYNCS 1
#endif
#ifndef PROBE_REP
#define PROBE_REP 0
#endif
#define SEAM(k) do { if (IN(k) && IN((k) + 1)) { for (int _s = 0; _s < PROBE_SYNCS; ++_s) xcd_barrier(bar); } } while (0)
#define REPS(k) (((PROBE_REP >> (k)) & 1) + 1)
#ifdef PROBE_TS
    unsigned long long* const tsb = (unsigned long long*)(ws + WS_TS);
    if (blockIdx.x == 0 && tid == 0) tsb[0] = __builtin_amdgcn_s_memrealtime();
#define STAMP(k) do { if (blockIdx.x == 0 && tid == 0) tsb[1 + (k)] = __builtin_amdgcn_s_memrealtime(); } while (0)
#else
#define STAMP(k) do {} while (0)
#endif

    if (IN(0)) for (int _rep = 0; _rep < REPS(0); ++_rep) { if (_rep) xcd_barrier(bar);
        for (int i = gt; i < TT; i += GT) { F.SS5[i] = 0.f; F.SSF[i] = 0.f; }
        LAS float* scr = (LAS float*)(lds + wid * 8448);
        constexpr int I_IN = 16 * (N1 / 32), I_GLU = 16 * 32, I_OUT = 32 * 32, I_FF1 = 16 * 128, I_FF2 = 64 * 32, I_ALL = I_IN + I_GLU + I_OUT + I_FF1 + I_FF2;
        for (int it = gw; it < (late_w ? I_IN : I_ALL); it += NGW) convert_item(F, it, scr, lane);
        for (int m0 = gw * 2; m0 < TT; m0 += NGW * 2) {
            f32x4 v[2][4]; float s[2] = {0.f, 0.f};
#pragma unroll
            for (int q = 0; q < 2; ++q) { const int m = m0 + q; const float* src = m < MP ? F.in[0] + (size_t)m * DM : F.in[1] + (size_t)(m - MP) * DM;
#pragma unroll
                for (int j = 0; j < 4; ++j) v[q][j] = __builtin_nontemporal_load((const f32x4*)(src + 4 * lane + 256 * j)); }
            f32x4 gn[4];
#pragma unroll
            for (int j = 0; j < 4; ++j) gn[j] = *(const f32x4*)(F.in[6] + 4 * lane + 256 * j);
#pragma unroll
            for (int q = 0; q < 2; ++q) {
#pragma unroll
                for (int j = 0; j < 4; ++j) s[q] += (v[q][j][0] * v[q][j][0] + v[q][j][1] * v[q][j][1]) + (v[q][j][2] * v[q][j][2] + v[q][j][3] * v[q][j][3]);
                const float rs = rs_from_ss(wave_sum(s[q]), 1024.f);
#pragma unroll
                for (int j = 0; j < 4; ++j) *(u32x2*)(F.XN + (size_t)(m0 + q) * DM + 4 * lane + 256 * j) = (u32x2){pk2(v[q][j][0] * rs * gn[j][0], v[q][j][1] * rs * gn[j][1]), pk2(v[q][j][2] * rs * gn[j][2], v[q][j][3] * rs * gn[j][3])}; } }
        for (int t = gt; t < 4096 * 32; t += GT) { const int idx = t >> 5, k = t & 31, g = idx >> 6, p = idx & 63;
            const float dt = expf(F.in[10][g]), lr = F.in[8][idx], li = F.in[9][idx];
            const float mag = expf(lr * dt), ang = li * dt, abr = mag * cosf(ang), abi = mag * sinf(ang);
            { float pr = 1.f, pi = 0.f, br_ = abr, bi_ = abi;
#pragma unroll
              for (int bit = 0; bit < 5; ++bit) { if ((k >> bit) & 1) { const float tr = pr * br_ - pi * bi_, ti = pr * bi_ + pi * br_; pr = tr; pi = ti; } const float sr = br_ * br_ - bi_ * bi_, si = 2.f * br_ * bi_; br_ = sr; bi_ = si; }
              const int tt = 31 - k, hf = (tt >> 2) & 1, r = (tt & 3) + 4 * (tt >> 3);
              F.PW[(size_t)((g * 2 + hf) * 16 + r) * 64 + p] = (f32x2){pr, pi};
              if (k == 0) { F.AB[idx] = (f32x2){abr, abi}; F.A32[idx] = (f32x2){br_, bi_};
                  const float q1r = br_ * br_ - bi_ * bi_, q1i = 2.f * br_ * bi_, q2r = q1r * q1r - q1i * q1i, q2i = 2.f * q1r * q1i; F.AQ[idx] = (f32x2){q2r, q2i}; } }
            if (k < 16) { const int c = k;
                const float den = lr * lr + li * li, nr = abr - 1.f, ni = abi, fre = (nr * lr + ni * li) / den, fim = (ni * lr - nr * li) / den;
                const float br = F.in[11][(size_t)idx * 16 + c], bi = F.in[12][(size_t)idx * 16 + c], cr = F.in[13][(size_t)(g * 16 + c) * 64 + p], ci = F.in[14][(size_t)(g * 16 + c) * 64 + p];
                const bf16_t vr = (bf16_t)(pk2(fre * br - fim * bi, 0.f) & 0xffffu), vi = (bf16_t)(pk2(fre * bi + fim * br, 0.f) & 0xffffu);
                F.BBT[(size_t)(g * 128 + 2 * p) * 16 + c] = vr; F.BBT[(size_t)(g * 128 + 2 * p + 1) * 16 + c] = vi; F.BBS[(size_t)(g * 128 + p) * 16 + c] = vr; F.BBS[(size_t)(g * 128 + 64 + p) * 16 + c] = vi;
                *(unsigned*)(F.CM + (size_t)(g * 16 + c) * 128 + 2 * p) = pk2(cr, -ci); } }
    }
    SEAM(0); STAMP(0);

    const bool early = false;
    if (IN(1)) for (int _rep = 0; _rep < REPS(1); ++_rep) { if (_rep) xcd_barrier(bar);
        bf16_t* P = F.PROJ; float* DTp = F.DT;
        auto sk1 = [=](int row, int col, float lo0, float hi0, float lo1, float hi1) {
            const float v0 = lo0 + hi0, v1 = lo1 + hi1; const size_t r = (size_t)MP + row;
            if (col < PJ) *(unsigned*)(P + r * PJ + col) = pk2(v0, v1); else if (col < N1V) { DTp[r * 16 + col - PJ] = v0; DTp[r * 16 + col - PJ + 1] = v1; } };
        unsigned* cnt2 = (unsigned*)(ws + WS_CNT2);
        if (early) {
            skinny_gemm(lds, F.XN + (size_t)MP * DM, DM, F.WIN, DM, DM, 113, sk1);
            asm volatile("s_waitcnt vmcnt(0)" ::: "memory"); __syncthreads();
            if (tid == 0) { __builtin_amdgcn_fence(__ATOMIC_RELEASE, "agent"); asm volatile("s_waitcnt vmcnt(0)" ::: "memory"); xb_add(cnt2, 1u); }
        }
        pg8::Gemm gm{F.XN, F.WIN, DM, DM, DM}; pg8::StaticOrder S; S.init(MP, early ? PJ : N1, G, (int)blockIdx.x);
        EpiProj E{F.PROJ, F.DT};
        pg8::gemm_phase<EpiProj, pg8::StaticOrder, true, true>(lds, gm, S, E);
        if (late_w && !early && blockIdx.x >= 192) { LAS float* scr = (LAS float*)(lds + wid * 8448); constexpr int I_IN = 16 * (N1 / 32), I_ALL = I_IN + 16 * 32 + 32 * 32 + 16 * 128 + 64 * 32;
            for (int it = I_IN + (blockIdx.x - 192) * 8 + wid; it < I_ALL; it += 512) convert_item(F, it, scr, lane);
            __syncthreads(); }
        if (!early) skinny_gemm<1, 2>(lds, F.XN + (size_t)MP * DM, DM, F.WIN, DM, DM, 113, sk1);
        else if (blockIdx.x >= 128) {
            { const int fr = lane & 15, fq = lane >> 4;
              for (int rt = (blockIdx.x - 128) * 8 + wid; rt < MP / 16; rt += 1024) { f32x4 acc = (f32x4){0.f, 0.f, 0.f, 0.f};
                const bf16_t* ap = F.XN + (size_t)(16 * rt + fr) * DM + fq * 8; const bf16_t* bp = F.WIN + (size_t)(PJ + fr) * DM + fq * 8;
#pragma unroll 16
                for (int ks = 0; ks < 32; ++ks) { const bf16x8 a = *(const bf16x8*)(ap + ks * 32), b_ = *(const bf16x8*)(bp + ks * 32); acc = MFMA16(a, b_, acc); }
#pragma unroll
                for (int j = 0; j < 4; ++j) F.DT[(size_t)(16 * rt + 4 * fq + j) * 16 + fr] = acc[j]; } }
            if (tid == 0) { unsigned sp = 0; while (xb_ld(cnt2) < (unsigned)G && ++sp < (1u << 22)) __builtin_amdgcn_s_sleep(1); __builtin_amdgcn_fence(__ATOMIC_ACQUIRE, "agent"); asm volatile("s_waitcnt vmcnt(0)" ::: "memory"); }
            __syncthreads();
            for (int j = blockIdx.x - 128; j < NSAMP * 2; j += 128) ssd_sample_job(lds, F, j >> 1, j & 1);
            s5_sample_jobs(F, (blockIdx.x - 128) * 8 + wid, 1024, lane);
        }
    }
    SEAM(1); STAMP(1);

    if (IN(2)) {
        const bool sample_first = false;
        if (sample_first) for (int j = blockIdx.x; j < NSAMP * 2; j += G) ssd_sample_job(lds, F, j >> 1, j & 1);
        for (int tile = blockIdx.x; tile < NB * NCH * 2; tile += G) ssd_states_tile(lds, F, tile >> 5, (tile >> 1) & 15, tile & 1);
        __syncthreads(); STAMP(10);
        s5_pass_a(F, gw, NGW, lane);
        __syncthreads(); STAMP(11);
        if (!early) { for (int j = blockIdx.x; j < NSAMP * 2; j += G) ssd_sample_job(lds, F, j >> 1, j & 1);
            s5_sample_jobs(F, gw, NGW, lane); }
        STAMP(12);
    }
    SEAM(2); STAMP(2);

    if (IN(3)) {
        for (int idx = gt; idx < NB * 16 * 64 * 16; idx += GT) { const int n8 = idx & 15, p = (idx >> 4) & 63, h = (idx >> 10) & 15, b = idx >> 14;
            bf16_t* base = F.ST + ((size_t)(b * 16 * 16 + h) * 64 + p) * 128 + n8 * 8; const size_t cstep = (size_t)16 * 64 * 128;
            u32x4 v[NCH];
#pragma unroll
            for (int c = 0; c < NCH; ++c) v[c] = *(const u32x4*)(base + c * cstep);
            float hs[8];
#pragma unroll
            for (int i = 0; i < 8; ++i) hs[i] = 0.f;
#pragma unroll
            for (int c = 0; c < NCH; ++c) { const float cd = F.CD[(b * 16 + c) * 16 + h];
                *(u32x4*)(base + c * cstep) = (u32x4){pk2(hs[0], hs[1]), pk2(hs[2], hs[3]), pk2(hs[4], hs[5]), pk2(hs[6], hs[7])};
                hs[0] = cd * hs[0] + bflo(v[c].x); hs[1] = cd * hs[1] + bfhi(v[c].x); hs[2] = cd * hs[2] + bflo(v[c].y); hs[3] = cd * hs[3] + bfhi(v[c].y);
                hs[4] = cd * hs[4] + bflo(v[c].z); hs[5] = cd * hs[5] + bfhi(v[c].z); hs[6] = cd * hs[6] + bflo(v[c].w); hs[7] = cd * hs[7] + bfhi(v[c].w); }
            float* o = F.out + O_SSDP + ((size_t)(b * 16 + h) * 64 + p) * 128 + n8 * 8;
            *(f32x4*)o = (f32x4){hs[0], hs[1], hs[2], hs[3]}; *(f32x4*)(o + 4) = (f32x4){hs[4], hs[5], hs[6], hs[7]}; }
        for (int idx = gt; idx < NB * 64 * 64; idx += GT) { const int p = idx & 63, bg = idx >> 6, g = bg & 63;
            const f32x2 aq = F.AQ[g * 64 + p]; f32x2* sp = F.SE + (size_t)bg * 16 * 64 + p; float hr = 0.f, hi_ = 0.f;
#pragma unroll 4
            for (int c = 0; c < NCH; ++c) { const f32x2 t = sp[c * 64]; sp[c * 64] = (f32x2){hr, hi_}; const float nr = aq.x * hr - aq.y * hi_ + t.x, ni = aq.x * hi_ + aq.y * hr + t.y; hr = nr; hi_ = ni; }
            F.out[O_S5RP + idx] = hr; F.out[O_S5IP + idx] = hi_; }
        {
        const bf16_t* Gp = F.XN; bf16_t* P = F.PROJ; const float* bias = F.in[17]; float* SS = F.SS5;
        skinny_gemm<1, 2>(lds, F.XN + (size_t)MP * DM, DM, F.WGLU, DM, DM, 32, [=](int row, int col, float lo0, float hi0, float lo1, float hi1) {
            const size_t r = (size_t)MP + row; const unsigned gw_ = *(const unsigned*)(Gp + r * DM + col);
            const float o0 = bflo(gw_) * sigmoidf_(lo0 + hi0 + bias[col]), o1 = bfhi(gw_) * sigmoidf_(lo1 + hi1 + bias[col + 1]);
            *(unsigned*)(P + r * PJ + col) = pk2(o0, o1);
            const float ss = red16(o0 * o0 + o1 * o1); if ((threadIdx.x & 15) == 0) atomicAdd(SS + r, ss); });
        }
    }
    SEAM(3); STAMP(3);

    if (IN(4)) {
        for (int tile = blockIdx.x; tile < NB * NCH * 2; tile += G) ssd_y_tile(lds, F, tile >> 5, (tile >> 1) & 15, tile & 1, G == 256);
        __syncthreads(); STAMP(13);
        s5_pass_b(lds + wid * 16896, F, gw, NGW, lane);
        __syncthreads();
        {
        const float* xs = F.in[1]; float* X1 = F.out; bf16_t* X1B = F.XN; float* SSF = F.SSF; const float* SS5 = F.SS5;
        skinny_gemm<1, 2>(lds, F.PROJ + (size_t)MP * PJ, PJ, F.WOUT, 2048, 2048, 32, [=](int row, int col, float lo0, float hi0, float lo1, float hi1) {
            const size_t r = (size_t)MP + row; const float s = rs_from_ss(SS5[r], 1024.f);
            const float v0 = xs[(size_t)row * DM + col] + lo0 * s + hi0, v1 = xs[(size_t)row * DM + col + 1] + lo1 * s + hi1;
            X1[r * DM + col] = v0; X1[r * DM + col + 1] = v1; *(unsigned*)(X1B + r * DM + col) = pk2(v0, v1);
            const float ss = red16(v0 * v0 + v1 * v1); if ((threadIdx.x & 15) == 0) atomicAdd(SSF + r, ss); });
        }
    }
    SEAM(4); STAMP(4);

    if (IN(5)) {
        pg8::Gemm gm{F.XN, F.WGLU, DM, DM, DM}; pg8::StaticOrder S; S.init(MP, DM, G, (int)blockIdx.x);
        EpiGlu E{F.XN, F.PROJ, F.in[17], F.SS5};
        pg8::gemm_phase<EpiGlu, pg8::StaticOrder, false, true>(lds, gm, S, E);
        {
        bf16_t* H = F.HID; const float* SSF = F.SSF;
        skinny_gemm<1, 2>(lds, F.XN + (size_t)MP * DM, DM, F.WFF1, DM, DM, 128, [=](int row, int col, float lo0, float hi0, float lo1, float hi1) {
            const size_t r = (size_t)MP + row; const float s = rs_from_ss(SSF[r], 1024.f);
            const float a = fmaxf((lo0 + hi0) * s, 0.f), b = fmaxf((lo1 + hi1) * s, 0.f); *(unsigned*)(H + r * DFF + col) = pk2(a * a, b * b); });
        }
    }
    SEAM(5); STAMP(5);

    if (IN(6)) {
        pg8::Gemm gm{F.PROJ, F.WOUT, PJ, 2048, 2048}; pg8::StaticOrder S; S.init(MP, DM, G, (int)blockIdx.x);
        const LAS float* tab = nullptr;
        if (G == 256) { pg8::Unit u0; if (S.next(0, u0) && tid < 256) { const int row = u0.pm * 256 + tid; const f32x2 sg = *(const f32x2*)((const float*)(ws + WS_SSG) + (size_t)row * 2);
                const float s5 = rs_from_ss(F.SS5[row], 1024.f), g0 = rs_from_ss(sg.x, 512.f), g1 = rs_from_ss(sg.y, 512.f); LAS float* tw = (LAS float*)(lds + 131072);
                tw[tid] = s5 / g0; tw[256 + tid] = g0 / g1; tw[512 + tid] = g1; }
            __syncthreads(); tab = (const LAS float*)(lds + 131072); }
        if (tab) { EpiOut<true> E{F.in[0], F.out, F.XN, F.SSF, F.SS5, tab}; pg8::gemm_phase<EpiOut<true>, pg8::StaticOrder, false, true>(lds, gm, S, E); }
        else { EpiOut<false> E{F.in[0], F.out, F.XN, F.SSF, F.SS5, tab}; pg8::gemm_phase<EpiOut<false>, pg8::StaticOrder, false, true>(lds, gm, S, E); }
        {
        float* X1 = F.out;
        skinny_gemm<2>(lds, F.HID + (size_t)MP * DFF, DFF, F.WFF2, DFF, DFF, 32, [=](int row, int col, float lo0, float hi0, float lo1, float hi1) {
            const size_t r = (size_t)MP + row; atomicAdd(X1 + r * DM + col, lo0 + hi0); atomicAdd(X1 + r * DM + col + 1, lo1 + hi1); });
        }
    }
    SEAM(6); STAMP(6);

    if (IN(7)) for (int _rep = 0; _rep < REPS(7); ++_rep) { if (_rep) xcd_barrier(bar);
        pg8::Gemm gm{F.XN, F.WFF1, DM, DM, DM}; pg8::StaticOrder S; S.init(MP, DFF, G, (int)blockIdx.x);
        EpiFF1 E{F.HID, F.SSF};
        pg8::gemm_phase<EpiFF1, pg8::StaticOrder, true, true>(lds, gm, S, E);
        for (int m = MP + gw; m < TT; m += NGW) { float* src = F.out + (size_t)m * DM;
            f32x4 v[4]; float sq = 0.f;
#pragma unroll
            for (int j = 0; j < 4; ++j) { v[j] = *(const f32x4*)(src + 4 * lane + 256 * j); sq += (v[j][0] * v[j][0] + v[j][1] * v[j][1]) + (v[j][2] * v[j][2] + v[j][3] * v[j][3]); }
            const float rs = rs_from_ss(wave_sum(sq), 1024.f);
#pragma unroll
            for (int j = 0; j < 4; ++j) { const f32x4 gn = *(const f32x4*)(F.in[29] + 4 * lane + 256 * j); *(f32x4*)(src + 4 * lane + 256 * j) = v[j] * rs * gn; } }
        STAMP(15);
    }
    SEAM(7); STAMP(7);

    const bool fuse_norm = (G == 256);
    if (IN(8)) {
        pg8::Gemm gm{F.HID, F.WFF2, DFF, DFF, DFF}; pg8::StaticOrder S; S.init(MP, DM, G, (int)blockIdx.x);
        if (fuse_norm) { EpiFF2Norm E{F.out, F.XN, F.in[29], (float*)(ws + WS_SLOT), (unsigned*)(ws + WS_CNT)}; pg8::gemm_phase<EpiFF2Norm, pg8::StaticOrder, false, true>(lds, gm, S, E); }
        else { EpiFF2 E{F.out, F.XN}; pg8::gemm_phase<EpiFF2, pg8::StaticOrder, false, true>(lds, gm, S, E); }
        STAMP(14);
    }
    if (!fuse_norm) { SEAM(8); } STAMP(8);

#ifdef PROBE_TS
    if (IN(9) && blockIdx.x == 0) {
        if (tid == 0) { *(LAS float*)(lds + 1024) = (float)(tsb[1 + PROBE_TS] - tsb[0]) * 0.01f; }
        __syncthreads();
        const float t_us = *(LAS float*)(lds + 1024); const float sc = 1.0f + sqrtf(1e-4f + t_us * 2e-7f);
        for (int i = tid; i < 524288; i += 512) F.out[O_S5RS + i] *= sc;
        __syncthreads(); }
#endif
    if (IN(9) && !fuse_norm) {
        for (int m = gw; m < MP; m += NGW) { float* src = F.out + (size_t)m * DM;
            f32x4 v[4]; float s = 0.f;
#pragma unroll
            for (int j = 0; j < 4; ++j) { v[j] = *(const f32x4*)(src + 4 * lane + 256 * j); s += (v[j][0] * v[j][0] + v[j][1] * v[j][1]) + (v[j][2] * v[j][2] + v[j][3] * v[j][3]); }
            const float rs = rs_from_ss(wave_sum(s), 1024.f);
#pragma unroll
            for (int j = 0; j < 4; ++j) { const f32x4 gn = *(const f32x4*)(F.in[29] + 4 * lane + 256 * j); *(f32x4*)(src + 4 * lane + 256 * j) = v[j] * rs * gn; } }
    }
#undef IN
#undef SEAM
}

#ifndef N_LAUNCHES
#define N_LAUNCHES 1
#endif
extern "C" void kernel_launch(void* const* d_in, const int* in_sizes, int n_in, void* d_out, int out_size, void* d_ws, size_t ws_size, hipStream_t stream) {
    static int grid = 0;
    if (grid == 0) {
        if (n_in != 30 || (size_t)out_size != O_END || ws_size < WS_END) { fprintf(stderr, "kernel_launch: unexpected shapes: n_in %d out_size %d ws %zu\n", n_in, out_size, ws_size); grid = -1; return; }
        int dev = 0, cus = 0, per_cu = 0;
        (void)hipGetDevice(&dev); (void)hipDeviceGetAttribute(&cus, hipDeviceAttributeMultiprocessorCount, dev);
        if (hipFuncSetAttribute((const void*)hymba_fwd, hipFuncAttributeMaxDynamicSharedMemorySize, LDS_BYTES) != hipSuccess) { fprintf(stderr, "kernel_launch: hipFuncSetAttribute failed\n"); grid = -1; return; }
        if (hipOccupancyMaxActiveBlocksPerMultiprocessor(&per_cu, (const void*)hymba_fwd, 512, LDS_BYTES) != hipSuccess || per_cu < 1) { fprintf(stderr, "kernel_launch: occupancy query says %d\n", per_cu); per_cu = 1; }
        (void)hipGetLastError();
        grid = cus * per_cu;
    }
    if (grid < 0) return;
    if (hipMemsetAsync((char*)d_ws + WS_BAR, 0, 32768 + 256, stream) != hipSuccess) { fprintf(stderr, "kernel_launch: memset failed\n"); return; }
    Args a{};
    for (int i = 0; i < 30; ++i) a.in[i] = (const float*)d_in[i];
    a.out = (float*)d_out; a.ws = (unsigned char*)d_ws;
    constexpr int NPH = 10;
    for (int li = 0; li < N_LAUNCHES; ++li) {
        a.ph_lo = (N_LAUNCHES == 1) ? 0 : li; a.ph_hi = (N_LAUNCHES == 1) ? NPH : li + 1;
        void* kargs[] = {&a};
        const hipError_t e = hipLaunchCooperativeKernel((const void*)hymba_fwd, dim3(grid), dim3(512), kargs, LDS_BYTES, stream);
        if (e != hipSuccess) { fprintf(stderr, "kernel_launch: cooperative launch %d failed: %s (grid %d)\n", li, hipGetErrorString(e), grid); break; }
    }
}
```

```cpp
#include <hip/hip_runtime.h>
#include <hip/hip_cooperative_groups.h>
#include <cstdio>
#include <cstdint>
namespace cg = cooperative_groups;

namespace pg8 {
#define PG8_LAS __attribute__((address_space(3)))
typedef unsigned short bf16_t;
typedef short bf16x8 __attribute__((ext_vector_type(8)));
typedef float f32x4 __attribute__((ext_vector_type(4)));
typedef unsigned u32x4 __attribute__((ext_vector_type(4)));
typedef unsigned u32x2 __attribute__((ext_vector_type(2)));
constexpr int BM = 256, BK = 64, HALF = 128, HTB = HALF * BK * 2  , STAGE_BYTES = 8 * HTB, NXCD = 8, WGM = 8;

__host__ __device__ __forceinline__ int lds_byte(int r, int c) { const int st = (r >> 4) * 2 + (c >> 5), rr = r & 15, cc = c & 31, ob = rr * 64 + cc * 2; return st * 1024 + (ob ^ (((ob >> 9) & 1) << 5)); }
__host__ __device__ __forceinline__ void stage_rc(int b, int& R, int& C) { const int st = b / 1024, sb = b % 1024, swz = sb ^ (((sb >> 9) & 1) << 5); R = (st >> 1) * 16 + swz / 64; C = (st & 1) * 32 + (swz % 64) / 2; }
__host__ __device__ __forceinline__ int perm32(int rho) { const int n = rho >> 4, i = rho & 15; return 8 * (i >> 2) + 4 * n + (i & 3); }

struct Unit { int pm, pn; };
struct Gemm { const bf16_t* A; const bf16_t* Bt; int lda, ldb, K; };

struct StaticOrder {
    int nM, nN, nwg, G, c;
    __host__ __device__ void init(int M, int N, int G_, int c_) { nM = M / BM; nN = N / BM; nwg = nM * nN; G = G_; c = c_; }
    __host__ __device__ bool next(int i, Unit& u) const {
        const long L = (long)i * G + c; if (L >= nwg) return false;
        int wgid = (int)L; { const int q = nwg / NXCD, r = nwg % NXCD, xcd = wgid % NXCD, off = wgid / NXCD; wgid = (xcd < r ? xcd * (q + 1) : r * (q + 1) + (xcd - r) * q) + off; }
        const int nig = WGM * nN, gid = wgid / nig, fm = gid * WGM, gsz = (nM - fm) < WGM ? (nM - fm) : WGM;
        u.pm = fm + ((wgid % nig) % gsz); u.pn = (wgid % nig) / gsz; return true;
    }
};

__device__ __forceinline__ unsigned cvt_pk_bf16(float lo, float hi) { unsigned r; asm volatile("v_cvt_pk_bf16_f32 %0, %1, %2" : "=v"(r) : "v"(lo), "v"(hi)); return r; }

template <class Epi, class Sched, bool ALIGN_EPI = false, bool SP2 = false>
__device__ __forceinline__ void gemm_phase(PG8_LAS unsigned char* lds, const Gemm g, const Sched& S, const Epi& E) {
    const int tid = threadIdx.x, wid = __builtin_amdgcn_readfirstlane(tid >> 6), lane = tid & 63, wr = wid >> 2, wc = wid & 3, fr = lane & 15, fq = lane >> 4;
    const int K = g.K, nt = K / BK;
    unsigned voffA[2], voffB[2];
#pragma unroll
    for (int i = 0; i < 2; ++i) { int R, C; stage_rc(tid * 16 + i * 8192, R, C); const int Rb = Epi::PERM ? ((R & ~31) + perm32(R & 31)) : R;
        voffA[i] = (unsigned)(R * g.lda + C) * 2u; voffB[i] = (unsigned)(Rb * g.ldb + C) * 2u; }
    const size_t kstep = (size_t)(BK * 2);
    const size_t hstepA = (size_t)HALF * g.lda * 2, hstepB = (size_t)HALF * g.ldb * 2;
    const size_t tstepA = 2 * hstepA, tstepB = 2 * hstepB;
    const unsigned ldsw = (unsigned)wid * 1024u;
    const int aoff = lds_byte(wr * 64 + fr, fq * 8), boff = lds_byte(wc * 32 + fr, fq * 8);
#define PG8_SA(b, h) (((b) * 2 + (h)) * HTB)
#define PG8_SB(b, h) ((4 + (b) * 2 + (h)) * HTB)
#define PG8_STAGE(bufoff, gbase, voff) do { _Pragma("unroll") for (int _i = 0; _i < 2; ++_i) \
        __builtin_amdgcn_global_load_lds((const unsigned*)((const char*)(gbase) + (voff)[_i]), (PG8_LAS unsigned*)(lds + (bufoff) + ldsw + _i * 8192), 16, 0, 0); } while (0)
#define PG8_LDA(dst, b, h) do { _Pragma("unroll") for (int m = 0; m < 4; ++m) _Pragma("unroll") for (int k = 0; k < 2; ++k) dst[m][k] = *(const PG8_LAS bf16x8*)(lds + PG8_SA(b, h) + aoff + m * 2048 + k * 1024); } while (0)
#define PG8_LDB(dst, b, h) do { _Pragma("unroll") for (int n = 0; n < 2; ++n) _Pragma("unroll") for (int k = 0; k < 2; ++k) dst[n][k] = *(const PG8_LAS bf16x8*)(lds + PG8_SB(b, h) + boff + n * 2048 + k * 1024); } while (0)
#define PG8_MMA(ai, bj, At, Bt) do { __builtin_amdgcn_s_setprio(1); _Pragma("unroll") for (int m = 0; m < 4; ++m) _Pragma("unroll") for (int n = 0; n < 2; ++n) _Pragma("unroll") for (int k = 0; k < 2; ++k) \
        acc[ai][bj][m][n] = __builtin_amdgcn_mfma_f32_16x16x32_bf16(Bt[n][k], At[m][k], acc[ai][bj][m][n], 0, 0, 0); __builtin_amdgcn_s_setprio(0); } while (0)
#define PG8_WAIT_V(n) asm volatile("s_waitcnt vmcnt(" #n ")" ::: "memory")
#define PG8_WAIT_L(n) asm volatile("s_waitcnt lgkmcnt(" #n ")" ::: "memory")
#define PG8_BAR __builtin_amdgcn_s_barrier()
#define PG8_SCHED __builtin_amdgcn_sched_barrier(0)
    Unit cur, nxt; int ui = 0;
    if (!S.next(0, cur)) return;
    f32x4 acc[2][2][4][2];
#pragma unroll
    for (int a = 0; a < 2; ++a)
#pragma unroll
        for (int b = 0; b < 2; ++b)
#pragma unroll
            for (int m = 0; m < 4; ++m)
#pragma unroll
                for (int n = 0; n < 2; ++n) acc[a][b][m][n] = (f32x4){0.f, 0.f, 0.f, 0.f};
    bf16x8 At[4][2], B0[2][2], B1[2][2];
    const char* cA = (const char*)g.A + (size_t)cur.pm * tstepA; const char* cB = (const char*)g.Bt + (size_t)cur.pn * tstepB;
    if constexpr (SP2) {
        PG8_STAGE(PG8_SB(0, 0), cB, voffB); PG8_STAGE(PG8_SB(0, 1), cB + hstepB, voffB); PG8_STAGE(PG8_SA(0, 0), cA, voffA); PG8_STAGE(PG8_SA(0, 1), cA + hstepA, voffA);
        if (wr == 1) PG8_BAR;
        PG8_WAIT_V(2); PG8_BAR;
        PG8_STAGE(PG8_SB(1, 0), cB + kstep, voffB); PG8_STAGE(PG8_SA(1, 0), cA + kstep, voffA); PG8_STAGE(PG8_SB(1, 1), cB + hstepB + kstep, voffB);
        PG8_WAIT_V(6); PG8_BAR;
    } else {
        PG8_STAGE(PG8_SB(0, 0), cB, voffB); PG8_STAGE(PG8_SA(0, 0), cA, voffA); PG8_STAGE(PG8_SB(0, 1), cB + hstepB, voffB); PG8_STAGE(PG8_SA(0, 1), cA + hstepA, voffA);
        if (wr == 1) PG8_BAR;
        PG8_WAIT_V(4); PG8_BAR;
        PG8_STAGE(PG8_SB(1, 0), cB + kstep, voffB); PG8_STAGE(PG8_SA(1, 0), cA + kstep, voffA); PG8_STAGE(PG8_SB(1, 1), cB + hstepB + kstep, voffB);
        PG8_WAIT_V(6); PG8_BAR;
    }
    for (;;) {
        const bool has_next = S.next(ui + 1, nxt);
        const char* nA = has_next ? (const char*)g.A + (size_t)nxt.pm * tstepA : cA; const char* nB = has_next ? (const char*)g.Bt + (size_t)nxt.pn * tstepB : cB;
        for (int t = 0; t < nt; t += 2) {
            const bool last = (t == nt - 2);
            const char* a1 = cA + (size_t)(t + 1) * kstep;
            const char* a2 = last ? nA : cA + (size_t)(t + 2) * kstep; const char* b2 = last ? nB : cB + (size_t)(t + 2) * kstep;
            const char* a3 = a2 + kstep; const char* b3 = b2 + kstep;
            if constexpr (Epi::MID) { if (t == (nt >> 1)) E.mid(acc, cur, wr, wc, fr, fq, 0); else if (t == (nt >> 1) + (nt >> 2)) E.mid(acc, cur, wr, wc, fr, fq, 1); }
            if constexpr (SP2) {
            PG8_LDB(B0, 0, 0); PG8_LDB(B1, 0, 1); PG8_SCHED; PG8_LDA(At, 0, 0); PG8_STAGE(PG8_SA(1, 1), a1 + hstepA, voffA);
            PG8_WAIT_V(8); PG8_WAIT_L(0); PG8_BAR; PG8_MMA(0, 0, At, B0); PG8_MMA(0, 1, At, B1); PG8_BAR; PG8_SCHED;
            PG8_LDA(At, 0, 1); PG8_STAGE(PG8_SB(0, 0), b2, voffB); PG8_STAGE(PG8_SB(0, 1), b2 + hstepB, voffB); PG8_STAGE(PG8_SA(0, 0), a2, voffA);
            PG8_WAIT_V(8); PG8_WAIT_L(0); PG8_BAR; PG8_MMA(1, 0, At, B0); PG8_MMA(1, 1, At, B1); PG8_BAR; PG8_SCHED;
            PG8_LDB(B0, 1, 0); PG8_LDB(B1, 1, 1); PG8_SCHED; PG8_LDA(At, 1, 0); PG8_STAGE(PG8_SA(0, 1), a2 + hstepA, voffA);
            PG8_WAIT_V(8); PG8_WAIT_L(0); PG8_BAR; PG8_MMA(0, 0, At, B0); PG8_MMA(0, 1, At, B1); PG8_BAR; PG8_SCHED;
            PG8_LDA(At, 1, 1); PG8_STAGE(PG8_SB(1, 0), b3, voffB); PG8_STAGE(PG8_SB(1, 1), b3 + hstepB, voffB); PG8_STAGE(PG8_SA(1, 0), a3, voffA);
            PG8_WAIT_V(8); PG8_WAIT_L(0); PG8_BAR; PG8_MMA(1, 0, At, B0); PG8_MMA(1, 1, At, B1); PG8_BAR; PG8_SCHED;
            } else {
            PG8_LDB(B0, 0, 0); PG8_SCHED; PG8_LDA(At, 0, 0); PG8_STAGE(PG8_SA(1, 1), a1 + hstepA, voffA);
            PG8_WAIT_L(8); PG8_BAR; PG8_WAIT_L(0); PG8_MMA(0, 0, At, B0); PG8_BAR; PG8_SCHED;
            PG8_LDB(B1, 0, 1); PG8_STAGE(PG8_SB(0, 0), b2, voffB);
            PG8_BAR; PG8_WAIT_L(0); PG8_MMA(0, 1, At, B1); PG8_BAR;
            PG8_LDA(At, 0, 1); PG8_STAGE(PG8_SA(0, 0), a2, voffA);
            PG8_BAR; PG8_WAIT_L(0); PG8_MMA(1, 0, At, B0); PG8_BAR; PG8_SCHED;
            PG8_STAGE(PG8_SB(0, 1), b2 + hstepB, voffB);
            PG8_WAIT_V(6); PG8_BAR; PG8_MMA(1, 1, At, B1); PG8_BAR;
            PG8_LDB(B0, 1, 0); PG8_SCHED; PG8_LDA(At, 1, 0); PG8_STAGE(PG8_SA(0, 1), a2 + hstepA, voffA);
            PG8_WAIT_L(8); PG8_BAR; PG8_WAIT_L(0); PG8_MMA(0, 0, At, B0); PG8_BAR; PG8_SCHED;
            PG8_LDB(B1, 1, 1); PG8_STAGE(PG8_SB(1, 0), b3, voffB);
            PG8_BAR; PG8_WAIT_L(0); PG8_MMA(0, 1, At, B1); PG8_BAR;
            PG8_LDA(At, 1, 1); PG8_STAGE(PG8_SA(1, 0), a3, voffA);
            PG8_BAR; PG8_WAIT_L(0); PG8_MMA(1, 0, At, B0); PG8_BAR; PG8_SCHED;
            PG8_STAGE(PG8_SB(1, 1), b3 + hstepB, voffB);
            PG8_WAIT_V(6); PG8_BAR; PG8_MMA(1, 1, At, B1); PG8_BAR;
            }
        }
        if constexpr (ALIGN_EPI) { if (wr == 0) PG8_BAR; }
        if constexpr (!Epi::AFTER_DRAIN) E(acc, cur, wr, wc, fr, fq);
        if (!has_next) break;
#pragma unroll
        for (int a = 0; a < 2; ++a)
#pragma unroll
            for (int b = 0; b < 2; ++b)
#pragma unroll
                for (int m = 0; m < 4; ++m)
#pragma unroll
                    for (int n = 0; n < 2; ++n) acc[a][b][m][n] = (f32x4){0.f, 0.f, 0.f, 0.f};
        cur = nxt; cA = nA; cB = nB; ++ui;
        if constexpr (ALIGN_EPI) { if (wr == 1) PG8_BAR; }
    }
    PG8_WAIT_V(0);
    if constexpr (!ALIGN_EPI) { if (wr == 0) PG8_BAR; }
    PG8_BAR;
    if constexpr (Epi::AFTER_DRAIN) E.fused(acc, cur, wr, wc, fr, fq, lds, tid);
#undef PG8_SA
#undef PG8_SB
#undef PG8_STAGE
#undef PG8_LDA
#undef PG8_LDB
#undef PG8_MMA
#undef PG8_WAIT_V
#undef PG8_WAIT_L
#undef PG8_BAR
#undef PG8_SCHED
}
}

#define LAS __attribute__((address_space(3)))
typedef unsigned short bf16_t;
typedef short bf16x8 __attribute__((ext_vector_type(8)));
typedef float f32x4 __attribute__((ext_vector_type(4)));
typedef float f32x2 __attribute__((ext_vector_type(2)));
typedef float f32x16 __attribute__((ext_vector_type(16)));
typedef unsigned u32x4 __attribute__((ext_vector_type(4)));
typedef unsigned u32x2 __attribute__((ext_vector_type(2)));

constexpr int DM = 1024, NB = 8, SEQ = 2048, MP = NB * SEQ, NSAMP = 128, TT = MP + NSAMP;
constexpr int NCH = SEQ / 128;
constexpr int PJ = 3584;
constexpr int N1 = 3840, N1V = 3600;
constexpr int DCONV = 1536, DFF = 4096;
constexpr float EPS = 1e-5f;
constexpr int XT_P = 136;

constexpr size_t MiB = 1u << 20;
constexpr size_t WS_SS5 = 0, WS_SSF = 128 * 1024, WS_SSG = 256 * 1024, WS_CD = 384 * 1024, WS_BAR = 448 * 1024, WS_CNT = 448 * 1024 + 16384, WS_CNT2 = 448 * 1024 + 32768, WS_TS = 448 * 1024 + 40960, WS_AB = 512 * 1024, WS_AQ = 576 * 1024;
constexpr size_t WS_BBT = 1 * MiB, WS_CM = 1 * MiB + 256 * 1024, WS_DT = 2 * MiB, WS_SE = 4 * MiB;
constexpr size_t WS_WIN = 8 * MiB, WS_WGLU = WS_WIN + (size_t)N1 * DM * 2, WS_WOUT = WS_WGLU + (size_t)DM * DM * 2, WS_WFF1 = WS_WOUT + (size_t)DM * 2048 * 2, WS_WFF2 = WS_WFF1 + (size_t)DFF * DM * 2;
constexpr size_t WS_XN = 38 * MiB;
constexpr size_t WS_PROJ = 71 * MiB;
constexpr size_t WS_ST = 184 * MiB;
constexpr size_t WS_HID = 71 * MiB;
constexpr size_t WS_PW = 216 * MiB, WS_A32 = 217 * MiB, WS_BBS = 217 * MiB + 256 * 1024;
constexpr size_t WS_SLOT = 218 * MiB;
constexpr size_t WS_XS = 219 * MiB;
constexpr size_t WS_END = 251 * MiB;
static_assert(WS_WFF2 + (size_t)DM * DFF * 2 <= WS_XN && WS_XN + (size_t)TT * DM * 2 <= WS_PROJ && WS_PROJ + (size_t)TT * PJ * 2 <= WS_ST && WS_HID + (size_t)TT * DFF * 2 <= WS_PW, "ws map");

constexpr size_t O_YS = (size_t)MP * DM, O_S5RP = O_YS + (size_t)NSAMP * DM, O_S5IP = O_S5RP + 32768, O_SSDP = O_S5IP + 32768, O_CVP = O_SSDP + 1048576,
                 O_S5RS = O_CVP + 36864, O_S5IS = O_S5RS + 524288, O_SSDS = O_S5IS + 524288, O_CVS = O_SSDS + 16777216, O_END = O_CVS + 589824;

constexpr int LDS_MAIN = 155648;
constexpr int LDS_BYTES = LDS_MAIN + 64;

struct Args { const float* in[30]; float* out; unsigned char* ws; int ph_lo, ph_hi; };

__device__ __forceinline__ float bf2f(unsigned short b) { return __builtin_bit_cast(float, (unsigned)b << 16); }
__device__ __forceinline__ float bflo(unsigned w) { return __builtin_bit_cast(float, w << 16); }
__device__ __forceinline__ float bfhi(unsigned w) { return __builtin_bit_cast(float, w & 0xffff0000u); }
__device__ __forceinline__ unsigned pk2(float lo, float hi) { return pg8::cvt_pk_bf16(lo, hi); }
__device__ __forceinline__ float wave_sum(float v) {
#pragma unroll
    for (int o = 1; o < 64; o <<= 1) v += __shfl_xor(v, o);
    return v;
}
template <int CTRL, int ROWMASK> __device__ __forceinline__ float dpp_add(float v) {
    return v + __builtin_bit_cast(float, __builtin_amdgcn_update_dpp(0, __builtin_bit_cast(int, v), CTRL, ROWMASK, 0xf, false)); }
__device__ __forceinline__ float half_sum_dpp(float v) { v = dpp_add<0x111, 0xf>(v); v = dpp_add<0x112, 0xf>(v); v = dpp_add<0x114, 0xf>(v); v = dpp_add<0x118, 0xf>(v); v = dpp_add<0x142, 0xa>(v); return v; }
__device__ __forceinline__ float sigmoidf_(float v) { return __builtin_amdgcn_rcpf(1.f + __expf(-v)); }
__device__ __forceinline__ float siluf_(float v) { return v * sigmoidf_(v); }
__device__ __forceinline__ float gelu_tanh(float v) { const float u = 1.5957691216057308f * (v + 0.044715f * v * v * v); return v * sigmoidf_(u); }
__device__ __forceinline__ float softplusf_(float x) { return fmaxf(x, 0.f) + log1pf(__expf(-fabsf(x))); }
__device__ __forceinline__ float rs_from_ss(float ss, float n) { return 1.0f / sqrtf(ss / n + EPS); }

struct EpiProj {
    static constexpr bool PERM = true, MID = false, AFTER_DRAIN = false;
    bf16_t* P; float* DT;
    __device__ __forceinline__ void operator()(const f32x4 (&acc)[2][2][4][2], const pg8::Unit& u, int wr, int wc, int fr, int fq) const {
        const int row0 = u.pm * 256 + wr * 64 + fr, col0 = u.pn * 256 + wc * 32 + 8 * fq;
#pragma unroll
        for (int ai = 0; ai < 2; ++ai)
#pragma unroll
            for (int m = 0; m < 4; ++m) { const int row = row0 + ai * 128 + m * 16;
#pragma unroll
                for (int bj = 0; bj < 2; ++bj) { const int col = col0 + bj * 128; const f32x4 v0 = acc[ai][bj][m][0], v1 = acc[ai][bj][m][1];
                    if (col < PJ) { u32x4 w; w.x = pk2(v0[0], v0[1]); w.y = pk2(v0[2], v0[3]); w.z = pk2(v1[0], v1[1]); w.w = pk2(v1[2], v1[3]); *(u32x4*)(P + (size_t)row * PJ + col) = w; }
                    else if (col < N1V) { float* d = DT + (size_t)row * 16 + (col - PJ); *(f32x4*)d = v0; *(f32x4*)(d + 4) = v1; } } }
    }
};
struct EpiGlu {
    static constexpr bool PERM = true, MID = false, AFTER_DRAIN = false;
    const bf16_t* G; bf16_t* P; const float* bias; float* SS;
    __device__ __forceinline__ void operator()(const f32x4 (&acc)[2][2][4][2], const pg8::Unit& u, int wr, int wc, int fr, int fq) const {
        const int row0 = u.pm * 256 + wr * 64 + fr, col0 = u.pn * 256 + wc * 32 + 8 * fq;
        f32x4 bv[2][2];
#pragma unroll
        for (int bj = 0; bj < 2; ++bj) { bv[bj][0] = *(const f32x4*)(bias + col0 + bj * 128); bv[bj][1] = *(const f32x4*)(bias + col0 + bj * 128 + 4); }
#pragma unroll
        for (int ai = 0; ai < 2; ++ai) {
            u32x4 gw[4][2];
#pragma unroll
            for (int m = 0; m < 4; ++m)
#pragma unroll
                for (int bj = 0; bj < 2; ++bj) gw[m][bj] = *(const u32x4*)(G + (size_t)(row0 + ai * 128 + m * 16) * DM + col0 + bj * 128);
#pragma unroll
            for (int m = 0; m < 4; ++m) { const int row = row0 + ai * 128 + m * 16; float ss = 0.f;
#pragma unroll
                for (int bj = 0; bj < 2; ++bj) { const int col = col0 + bj * 128; const u32x4 g4 = gw[m][bj];
                    const f32x4 v0 = acc[ai][bj][m][0] + bv[bj][0], v1 = acc[ai][bj][m][1] + bv[bj][1]; float o[8];
                    o[0] = bflo(g4.x) * sigmoidf_(v0[0]); o[1] = bfhi(g4.x) * sigmoidf_(v0[1]); o[2] = bflo(g4.y) * sigmoidf_(v0[2]); o[3] = bfhi(g4.y) * sigmoidf_(v0[3]);
                    o[4] = bflo(g4.z) * sigmoidf_(v1[0]); o[5] = bfhi(g4.z) * sigmoidf_(v1[1]); o[6] = bflo(g4.w) * sigmoidf_(v1[2]); o[7] = bfhi(g4.w) * sigmoidf_(v1[3]);
#pragma unroll
                    for (int i = 0; i < 8; ++i) ss += o[i] * o[i];
                    u32x4 w; w.x = pk2(o[0], o[1]); w.y = pk2(o[2], o[3]); w.z = pk2(o[4], o[5]); w.w = pk2(o[6], o[7]); *(u32x4*)(P + (size_t)row * PJ + col) = w; }
                ss += __shfl_xor(ss, 16); ss += __shfl_xor(ss, 32);
                if (fq == 0) atomicAdd(SS + row, ss); } }
    }
};
template <bool TAB> struct EpiOut {
    static constexpr bool PERM = true, MID = true, AFTER_DRAIN = false;
    const float* X; float* X1; bf16_t* X1B; float* SSF; const float* SS5; const LAS float* tab;
    __device__ __forceinline__ void mid(f32x4 (&acc)[2][2][4][2], const pg8::Unit& u, int wr, int wc, int fr, int fq, int which) const {
        if constexpr (TAB) {
#pragma unroll
            for (int ai = 0; ai < 2; ++ai)
#pragma unroll
                for (int m = 0; m < 4; ++m) { const float s = tab[which * 256 + ai * 128 + wr * 64 + m * 16 + fr];
#pragma unroll
                    for (int bj = 0; bj < 2; ++bj) { acc[ai][bj][m][0] *= s; acc[ai][bj][m][1] *= s; } }
            return; }
        else { if (which != 0) return;
        const int row0 = u.pm * 256 + wr * 64 + fr;
#pragma unroll
        for (int ai = 0; ai < 2; ++ai)
#pragma unroll
            for (int m = 0; m < 4; ++m) { const float s = rs_from_ss(SS5[row0 + ai * 128 + m * 16], 1024.f);
#pragma unroll
                for (int bj = 0; bj < 2; ++bj) { acc[ai][bj][m][0] *= s; acc[ai][bj][m][1] *= s; } } }
    }
    __device__ __forceinline__ void operator()(const f32x4 (&acc)[2][2][4][2], const pg8::Unit& u, int wr, int wc, int fr, int fq) const {
        const int row0 = u.pm * 256 + wr * 64 + fr, col0 = u.pn * 256 + wc * 32 + 8 * fq;
#pragma unroll
        for (int ai = 0; ai < 2; ++ai) {
            f32x4 xr[4][2][2];
#pragma unroll
            for (int m = 0; m < 4; ++m)
#pragma unroll
                for (int bj = 0; bj < 2; ++bj) { const size_t off = (size_t)(row0 + ai * 128 + m * 16) * DM + col0 + bj * 128; xr[m][bj][0] = __builtin_nontemporal_load((const f32x4*)(X + off)); xr[m][bj][1] = __builtin_nontemporal_load((const f32x4*)(X + off + 4)); }
#pragma unroll
            for (int m = 0; m < 4; ++m) { const int row = row0 + ai * 128 + m * 16; float ss = 0.f; const float sfin = TAB ? tab[512 + ai * 128 + wr * 64 + m * 16 + fr] : 1.0f;
#pragma unroll
                for (int bj = 0; bj < 2; ++bj) { const size_t off = (size_t)row * DM + col0 + bj * 128;
                    const f32x4 v0 = xr[m][bj][0] + acc[ai][bj][m][0] * sfin, v1 = xr[m][bj][1] + acc[ai][bj][m][1] * sfin;
                    ss += (v0[0] * v0[0] + v0[1] * v0[1]) + (v0[2] * v0[2] + v0[3] * v0[3]) + (v1[0] * v1[0] + v1[1] * v1[1]) + (v1[2] * v1[2] + v1[3] * v1[3]);
                    u32x4 w; w.x = pk2(v0[0], v0[1]); w.y = pk2(v0[2], v0[3]); w.z = pk2(v1[0], v1[1]); w.w = pk2(v1[2], v1[3]); *(u32x4*)(X1B + off) = w; }
                ss += __shfl_xor(ss, 16); ss += __shfl_xor(ss, 32);
                if (fq == 0) atomicAdd(SSF + row, ss); } }
    }
};
struct EpiFF1 {
    static constexpr bool PERM = true, MID = false, AFTER_DRAIN = false;
    bf16_t* H; const float* SSF;
    __device__ __forceinline__ void operator()(const f32x4 (&acc)[2][2][4][2], const pg8::Unit& u, int wr, int wc, int fr, int fq) const {
        const int row0 = u.pm * 256 + wr * 64 + fr, col0 = u.pn * 256 + wc * 32 + 8 * fq;
        float sv[2][4];
#pragma unroll
        for (int ai = 0; ai < 2; ++ai)
#pragma unroll
            for (int m = 0; m < 4; ++m) sv[ai][m] = SSF[row0 + ai * 128 + m * 16];
#pragma unroll
        for (int ai = 0; ai < 2; ++ai)
#pragma unroll
            for (int m = 0; m < 4; ++m) { const int row = row0 + ai * 128 + m * 16; const float s = rs_from_ss(sv[ai][m], 1024.f);
#pragma unroll
                for (int bj = 0; bj < 2; ++bj) { f32x4 v0 = acc[ai][bj][m][0] * s, v1 = acc[ai][bj][m][1] * s;
#pragma unroll
                    for (int i = 0; i < 4; ++i) { const float a = fmaxf(v0[i], 0.f), b = fmaxf(v1[i], 0.f); v0[i] = a * a; v1[i] = b * b; }
                    u32x4 w; w.x = pk2(v0[0], v0[1]); w.y = pk2(v0[2], v0[3]); w.z = pk2(v1[0], v1[1]); w.w = pk2(v1[2], v1[3]); *(u32x4*)(H + (size_t)row * DFF + col0 + bj * 128) = w; } }
    }
};
struct EpiFF2 {
    static constexpr bool PERM = true, MID = false, AFTER_DRAIN = false;
    float* X1; const bf16_t* X1B;
    __device__ __forceinline__ void operator()(const f32x4 (&acc)[2][2][4][2], const pg8::Unit& u, int wr, int wc, int fr, int fq) const {
        const int row0 = u.pm * 256 + wr * 64 + fr, col0 = u.pn * 256 + wc * 32 + 8 * fq;
#pragma unroll
        for (int ai = 0; ai < 2; ++ai)
#pragma unroll
            for (int m = 0; m < 4; ++m) { const int row = row0 + ai * 128 + m * 16;
#pragma unroll
                for (int bj = 0; bj < 2; ++bj) { float* p = X1 + (size_t)row * DM + col0 + bj * 128; const u32x4 xw = *(const u32x4*)(X1B + (size_t)row * DM + col0 + bj * 128);
                    const f32x4 v0 = (f32x4){bflo(xw.x), bfhi(xw.x), bflo(xw.y), bfhi(xw.y)} + acc[ai][bj][m][0], v1 = (f32x4){bflo(xw.z), bfhi(xw.z), bflo(xw.w), bfhi(xw.w)} + acc[ai][bj][m][1]; *(f32x4*)p = v0; *(f32x4*)(p + 4) = v1; } }
    }
};

struct EpiFF2Norm {
    static constexpr bool PERM = true, MID = false, AFTER_DRAIN = true;
    float* X1; const bf16_t* X1B; const float* gain; float* slots; unsigned* cnt;
    __device__ __forceinline__ void fused(f32x4 (&acc)[2][2][4][2], const pg8::Unit& u, int wr, int wc, int fr, int fq, LAS unsigned char* lds, int tid) const {
        LAS float* P = (LAS float*)lds;
        const int row0 = u.pm * 256 + wr * 64 + fr, col0 = u.pn * 256 + wc * 32 + 8 * fq;
#pragma unroll
        for (int ai = 0; ai < 2; ++ai)
#pragma unroll
            for (int m = 0; m < 4; ++m) { const int row = row0 + ai * 128 + m * 16; float ss = 0.f;
#pragma unroll
                for (int bj = 0; bj < 2; ++bj) { const u32x4 xw = *(const u32x4*)(X1B + (size_t)row * DM + col0 + bj * 128);
                    const f32x4 v0 = (f32x4){bflo(xw.x), bfhi(xw.x), bflo(xw.y), bfhi(xw.y)} + acc[ai][bj][m][0], v1 = (f32x4){bflo(xw.z), bfhi(xw.z), bflo(xw.w), bfhi(xw.w)} + acc[ai][bj][m][1]; acc[ai][bj][m][0] = v0; acc[ai][bj][m][1] = v1;
                    ss += (v0[0] * v0[0] + v0[1] * v0[1]) + (v0[2] * v0[2] + v0[3] * v0[3]) + (v1[0] * v1[0] + v1[1] * v1[1]) + (v1[2] * v1[2] + v1[3] * v1[3]); }
                ss += __shfl_xor(ss, 16); ss += __shfl_xor(ss, 32);
                if (fq == 0) P[(ai * 128 + wr * 64 + m * 16 + fr) * 4 + wc] = ss; }
        __syncthreads();
        if (tid < 256) { const f32x4 q = *(const LAS f32x4*)(P + tid * 4); const float s = (q[0] + q[1]) + (q[2] + q[3]);
            __hip_atomic_store(slots + (size_t)(u.pm * 256 + tid) * 4 + u.pn, s, __ATOMIC_RELAXED, __HIP_MEMORY_SCOPE_AGENT); }
        asm volatile("s_waitcnt vmcnt(0)" ::: "memory");
        __syncthreads();
        if (tid == 0) { unsigned* c = cnt + 64 * u.pm; __hip_atomic_fetch_add(c, 1u, __ATOMIC_RELAXED, __HIP_MEMORY_SCOPE_AGENT);
            unsigned sp = 0; while (__hip_atomic_load(c, __ATOMIC_RELAXED, __HIP_MEMORY_SCOPE_AGENT) < 4u && ++sp < (1u << 22)) __builtin_amdgcn_s_sleep(1); }
        __syncthreads();
        if (tid < 256) { const float* sl = slots + (size_t)(u.pm * 256 + tid) * 4; float t = 0.f;
#pragma unroll
            for (int k = 0; k < 4; ++k) t += __hip_atomic_load(sl + k, __ATOMIC_RELAXED, __HIP_MEMORY_SCOPE_AGENT);
            P[1024 + tid] = rs_from_ss(t, 1024.f); }
        __syncthreads();
        f32x4 gv[2][2];
#pragma unroll
        for (int bj = 0; bj < 2; ++bj) { gv[bj][0] = *(const f32x4*)(gain + col0 + bj * 128); gv[bj][1] = *(const f32x4*)(gain + col0 + bj * 128 + 4); }
#pragma unroll
        for (int ai = 0; ai < 2; ++ai)
#pragma unroll
            for (int m = 0; m < 4; ++m) { const int rl = ai * 128 + wr * 64 + m * 16 + fr; const float rs = P[1024 + rl];
#pragma unroll
                for (int bj = 0; bj < 2; ++bj) { float* p = X1 + (size_t)(u.pm * 256 + rl) * DM + col0 + bj * 128;
                    __builtin_nontemporal_store(acc[ai][bj][m][0] * rs * gv[bj][0], (f32x4*)p); __builtin_nontemporal_store(acc[ai][bj][m][1] * rs * gv[bj][1], (f32x4*)(p + 4)); } }
        __syncthreads();
    }
};

template <int KSPLIT = 1, int NCT = 1, class F>
__device__ __forceinline__ void skinny_gemm(LAS unsigned char* lds, const bf16_t* A, int lda, const bf16_t* Bt, int ldb, int K, int nct, const F& f) {
    const int tid = threadIdx.x, wid = tid >> 6, lane = tid & 63;
    LAS float* red = (LAS float*)lds;
    const int ncu = (nct + NCT - 1) / NCT, nunits = 4 * ncu * KSPLIT, kw = (K / KSPLIT) >> 3;
    for (int uu = blockIdx.x; uu < nunits; uu += gridDim.x) {
        const int u = uu / KSPLIT, ksl = uu % KSPLIT;
        const int rt = u & 3, ct = (u >> 2) * NCT;
        const bf16_t* ap = A + (size_t)(rt * 32 + (lane & 31)) * lda + ksl * (K / KSPLIT) + wid * kw + (lane >> 5) * 8;
        const bf16_t* bp = Bt + (size_t)(ct * 32 + (lane & 31)) * ldb + ksl * (K / KSPLIT) + wid * kw + (lane >> 5) * 8;
        f32x16 acc[NCT];
#pragma unroll
        for (int c = 0; c < NCT; ++c)
#pragma unroll
            for (int i = 0; i < 16; ++i) acc[c][i] = 0.f;
#pragma unroll (NCT == 1 ? 16 : 8)
        for (int kk = 0; kk < kw; kk += 16) { const bf16x8 a = *(const bf16x8*)(ap + kk);
#pragma unroll
            for (int c = 0; c < NCT; ++c) { const bf16x8 b = *(const bf16x8*)(bp + (size_t)c * 32 * ldb + kk); acc[c] = __builtin_amdgcn_mfma_f32_32x32x16_bf16(a, b, acc[c], 0, 0, 0); } }
#pragma unroll
        for (int c = 0; c < NCT; ++c)
#pragma unroll
            for (int r = 0; r < 16; ++r) red[(c * 8 + wid) * 1056 + ((r & 3) + 8 * (r >> 2) + 4 * (lane >> 5)) * 33 + (lane & 31)] = acc[c][r];
        __syncthreads();
        const int row = tid >> 4, cc = (tid & 15) * 2;
#pragma unroll
        for (int c = 0; c < NCT; ++c) { float lo0 = 0.f, lo1 = 0.f, hi0 = 0.f, hi1 = 0.f;
#pragma unroll
            for (int w = 0; w < 4; ++w) { lo0 += red[(c * 8 + w) * 1056 + row * 33 + cc]; lo1 += red[(c * 8 + w) * 1056 + row * 33 + cc + 1]; hi0 += red[(c * 8 + w + 4) * 1056 + row * 33 + cc]; hi1 += red[(c * 8 + w + 4) * 1056 + row * 33 + cc + 1]; }
            f(rt * 32 + row, (ct + c) * 32 + cc, lo0, hi0, lo1, hi1); }
        __syncthreads();
    }
}
__device__ __forceinline__ float red16(float v) { v += __shfl_xor(v, 1); v += __shfl_xor(v, 2); v += __shfl_xor(v, 4); v += __shfl_xor(v, 8); return v; }

__device__ __forceinline__ void p0_transpose_item(const float* W, int K, int Nsrc, int N, bf16_t* WT, const float* gain, LAS float* scr, int item, int lane) {
    const int nblk = N / 32, kb = item / nblk, nb = item % nblk, k0 = 64 * kb, n0 = 32 * nb;
    const int n = n0 + (lane & 31); const bool ok = n < Nsrc;
    float tv[32];
#pragma unroll
    for (int i = 0; i < 32; ++i) { const int kk = 2 * i + (lane >> 5); tv[i] = ok ? W[(size_t)(k0 + kk) * Nsrc + n] : 0.f; }
    if (gain) {
#pragma unroll
        for (int i = 0; i < 32; ++i) tv[i] *= gain[k0 + 2 * i + (lane >> 5)]; }
#pragma unroll
    for (int i = 0; i < 32; ++i) scr[(2 * i + (lane >> 5)) * 33 + (lane & 31)] = tv[i];
    asm volatile("s_waitcnt lgkmcnt(0)" ::: "memory");
    const int c = lane & 7;
#pragma unroll
    for (int j = 0; j < 4; ++j) { const int nn = (lane >> 3) + 8 * j; const LAS float* s = scr + (8 * c) * 33 + nn;
        u32x4 o; o.x = pk2(s[0 * 33], s[1 * 33]); o.y = pk2(s[2 * 33], s[3 * 33]); o.z = pk2(s[4 * 33], s[5 * 33]); o.w = pk2(s[6 * 33], s[7 * 33]);
        *(u32x4*)(WT + (size_t)(n0 + nn) * K + k0 + 8 * c) = o; }
    asm volatile("s_waitcnt lgkmcnt(0)" ::: "memory");
}

__device__ __forceinline__ void conv4x4(const bf16_t* xcol, long rowg, bool zero_hist3, const float* cw, const float* cbias, int ch, float (&out)[4][4]) {
    float xin[7][4];
#pragma unroll
    for (int rr = 0; rr < 7; ++rr) {
        if (rr < 3 && zero_hist3) { xin[rr][0] = xin[rr][1] = xin[rr][2] = xin[rr][3] = 0.f; }
        else { const u32x2 w = *(const u32x2*)(xcol + (rowg - 3 + rr) * PJ); xin[rr][0] = bflo(w.x); xin[rr][1] = bfhi(w.x); xin[rr][2] = bflo(w.y); xin[rr][3] = bfhi(w.y); }
    }
    const f32x4 b = *(const f32x4*)(cbias + ch);
    f32x4 w[4];
#pragma unroll
    for (int k = 0; k < 4; ++k) w[k] = *(const f32x4*)(cw + k * DCONV + ch);
#pragma unroll
    for (int i = 0; i < 4; ++i)
#pragma unroll
        for (int j = 0; j < 4; ++j) { float v = b[j];
#pragma unroll
            for (int k = 0; k < 4; ++k) v += w[k][j] * xin[i + k][j];
            out[i][j] = siluf_(v); }
}

struct ConvIn { u32x2 x[7]; f32x4 w[4]; f32x4 b; };
__device__ __forceinline__ void conv_load(ConvIn& ci, const bf16_t* xcol, long rowg, const float* cw, const float* cbias, int ch) {
#pragma unroll
    for (int rr = 0; rr < 7; ++rr) ci.x[rr] = *(const u32x2*)(xcol + (rowg - 3 + rr) * PJ);
#pragma unroll
    for (int k = 0; k < 4; ++k) ci.w[k] = *(const f32x4*)(cw + k * DCONV + ch);
    ci.b = *(const f32x4*)(cbias + ch);
}
__device__ __forceinline__ void conv_compute(const ConvIn& ci, bool zero_hist3, float (&out)[4][4]) {
    float xin[7][4];
#pragma unroll
    for (int rr = 0; rr < 7; ++rr) { const bool z = rr < 3 && zero_hist3;
        xin[rr][0] = z ? 0.f : bflo(ci.x[rr].x); xin[rr][1] = z ? 0.f : bfhi(ci.x[rr].x); xin[rr][2] = z ? 0.f : bflo(ci.x[rr].y); xin[rr][3] = z ? 0.f : bfhi(ci.x[rr].y); }
#pragma unroll
    for (int i = 0; i < 4; ++i)
#pragma unroll
        for (int j = 0; j < 4; ++j) { float v = ci.b[j];
#pragma unroll
            for (int k = 0; k < 4; ++k) v += ci.w[k][j] * xin[i + k][j];
            out[i][j] = siluf_(v); }
}

__device__ __forceinline__ void ssd_dt_acum(LAS float* dtv, LAS float* acu, const float* DT, long r0, int g, const float* dt_bias, const float* a_log, int wid, int lane) {
    const int h = g * 8 + wid; const float bias = dt_bias[h], A = -__expf(a_log[h]); const int t0 = 2 * lane;
    const float d0 = softplusf_(DT[(r0 + t0) * 16 + h] + bias), d1 = softplusf_(DT[(r0 + t0 + 1) * 16 + h] + bias);
    const float a0 = d0 * A, s = a0 + d1 * A; float inc = s;
#pragma unroll
    for (int o = 1; o < 64; o <<= 1) { const float v = __shfl_up(inc, o); if (lane >= o) inc += v; }
    const float exc = inc - s;
    dtv[wid * 128 + t0] = d0; dtv[wid * 128 + t0 + 1] = d1; acu[wid * 128 + t0] = exc + a0; acu[wid * 128 + t0 + 1] = exc + s;
}

struct Frame {
    const float* in[30]; float* out; unsigned char* ws;
    bf16_t *WIN, *WGLU, *WOUT, *WFF1, *WFF2, *XN, *PROJ, *ST, *HID, *BBT, *CM, *XS;
    float *SS5, *SSF, *CD, *DT; f32x2 *AB, *AQ, *SE, *PW, *A32; bf16_t* BBS;
};
#define MFMA16(a, b, c) __builtin_amdgcn_mfma_f32_16x16x32_bf16((a), (b), (c), 0, 0, 0)
#define MFMA32(a, b, c) __builtin_amdgcn_mfma_f32_32x32x16_bf16((a), (b), (c), 0, 0, 0)

__device__ __forceinline__ void ssd_states_tile(LAS unsigned char* lds, const Frame& F, int b, int c, int g) {
    const int tid = threadIdx.x, wid = __builtin_amdgcn_readfirstlane(tid >> 6), lane = tid & 63, fr = lane & 15, fq = lane >> 4;
    LAS bf16_t* Bt = (LAS bf16_t*)lds; LAS bf16_t* Xt0 = (LAS bf16_t*)(lds + 34816);
    LAS float* dtv = (LAS float*)(lds + 69632); LAS float* acu = dtv + 1024;
    const long r0 = (long)b * SEQ + c * 128; const bool zh = (c == 0);
    const float* cw = F.in[19]; const float* cbias = F.in[20];
    const int xcg = tid & 15, xtg = tid >> 4;
    ConvIn cx, cb0, cb1;
    { const int q0 = tid, q1 = tid + 512;
      conv_load(cb0, F.PROJ + 2048 + 1024 + g * 128 + (q0 & 31) * 4, r0 + (q0 >> 5) * 4, cw, cbias, 1024 + g * 128 + (q0 & 31) * 4);
      conv_load(cb1, F.PROJ + 2048 + 1024 + g * 128 + (q1 & 31) * 4, r0 + (q1 >> 5) * 4, cw, cbias, 1024 + g * 128 + (q1 & 31) * 4); }
    conv_load(cx, F.PROJ + 2048 + g * 512 + xcg * 4, r0 + xtg * 4, cw, cbias, g * 512 + xcg * 4);
    ssd_dt_acum(dtv, acu, F.DT, r0, g, F.in[22], F.in[21], wid, lane);
    { float o[4][4]; int q = tid;
      conv_compute(cb0, zh && (q >> 5) == 0, o);
#pragma unroll
      for (int j = 0; j < 4; ++j) *(LAS u32x2*)(Bt + ((q & 31) * 4 + j) * XT_P + (q >> 5) * 4) = (u32x2){pk2(o[0][j], o[1][j]), pk2(o[2][j], o[3][j])};
      q = tid + 512; conv_compute(cb1, false, o);
#pragma unroll
      for (int j = 0; j < 4; ++j) *(LAS u32x2*)(Bt + ((q & 31) * 4 + j) * XT_P + (q >> 5) * 4) = (u32x2){pk2(o[0][j], o[1][j]), pk2(o[2][j], o[3][j])}; }
    __syncthreads();
#pragma unroll 1
    for (int hh = 0; hh < 8; ++hh) { const int h = g * 8 + hh; const float a_last = acu[hh * 128 + 127]; LAS bf16_t* Xt = Xt0 + (hh & 1) * (64 * XT_P);
        { float o[4][4], f[4];
          conv_compute(cx, zh && xtg == 0, o);
          if (hh < 7) conv_load(cx, F.PROJ + 2048 + h * 64 + 64 + xcg * 4, r0 + xtg * 4, cw, cbias, h * 64 + 64 + xcg * 4);
#pragma unroll
          for (int i = 0; i < 4; ++i) *(u32x2*)(F.XS + (size_t)(r0 + xtg * 4 + i) * DM + h * 64 + xcg * 4) = (u32x2){pk2(o[i][0], o[i][1]), pk2(o[i][2], o[i][3])};
#pragma unroll
          for (int i = 0; i < 4; ++i) f[i] = dtv[hh * 128 + xtg * 4 + i] * __expf(a_last - acu[hh * 128 + xtg * 4 + i]);
#pragma unroll
          for (int j = 0; j < 4; ++j) *(LAS u32x2*)(Xt + (xcg * 4 + j) * XT_P + xtg * 4) = (u32x2){pk2(o[0][j] * f[0], o[1][j] * f[1]), pk2(o[2][j] * f[2], o[3][j] * f[3])}; }
        __syncthreads();
        f32x4 acc[4];
#pragma unroll
        for (int i = 0; i < 4; ++i) acc[i] = (f32x4){0.f, 0.f, 0.f, 0.f};
#pragma unroll
        for (int ks = 0; ks < 4; ++ks) { const bf16x8 bfr = *(const LAS bf16x8*)(Bt + (16 * wid + fr) * XT_P + ks * 32 + fq * 8);
#pragma unroll
            for (int i = 0; i < 4; ++i) { const bf16x8 afr = *(const LAS bf16x8*)(Xt + (16 * i + fr) * XT_P + ks * 32 + fq * 8); acc[i] = MFMA16(bfr, afr, acc[i]); } }
        bf16_t* st = F.ST + ((size_t)((b * 16 + c) * 16 + h) * 64) * 128;
#pragma unroll
        for (int i = 0; i < 4; ++i) *(u32x2*)(st + (size_t)(16 * i + fr) * 128 + 16 * wid + 4 * fq) = (u32x2){pk2(acc[i][0], acc[i][1]), pk2(acc[i][2], acc[i][3])};
        if (tid == 0) F.CD[(b * 16 + c) * 16 + h] = __expf(a_last);
    }
    if (c == NCH - 1) {
        for (int e = tid; e < 3 * 768; e += 512) { const int k = e / 768, ch = g * 768 + e % 768;
            F.out[O_CVP + (size_t)(b * 3 + k) * DCONV + ch] = bf2f(F.PROJ[(size_t)(b * SEQ + SEQ - 3 + k) * PJ + 2048 + ch]); }
    }
    __syncthreads();
}

__device__ __forceinline__ void ssd_y_tile(LAS unsigned char* lds, const Frame& F, int b, int c, int g, bool defer_gn) {
    const int tid = threadIdx.x, wid = __builtin_amdgcn_readfirstlane(tid >> 6), lane = tid & 63, fr = lane & 15, fq = lane >> 4;
    LAS bf16_t* Bs = (LAS bf16_t*)lds; LAS bf16_t* Ps = Bs; LAS bf16_t* Cs = (LAS bf16_t*)(lds + 34816);
    LAS bf16_t* Xt0 = (LAS bf16_t*)(lds + 69632); LAS bf16_t* Hs0 = (LAS bf16_t*)(lds + 104448);
    LAS float* dtv = (LAS float*)(lds + 139264); LAS float* acu = dtv + 1024;
    LAS float* T0 = (LAS float*)(lds + 147456);
    const long r0 = (long)b * SEQ + c * 128; const bool zh = (c == 0);
    const float* cw = F.in[19]; const float* cbias = F.in[20];
    const int xcg = tid & 15, xtg = tid >> 4;
    const int l = 16 * wid + fr;
    bf16_t* zrow = F.PROJ + (size_t)(r0 + l) * PJ + 1024 + g * 512 + 4 * fq;
    const bf16_t* hsrc = F.ST + ((size_t)((b * 16 + c) * 16 + g * 8) * 64 + (tid >> 3)) * 128 + (tid & 7) * 16;
    const bf16_t* xsrc = F.XS + (size_t)(r0 + xtg * 4) * DM + g * 512 + xcg * 4;
    u32x2 xv[4]; u32x4 hv0, hv1; u32x2 zw[4];
    { ConvIn cq[2];
#pragma unroll
      for (int rnd = 0; rnd < 2; ++rnd) {
#pragma unroll
        for (int k = 0; k < 2; ++k) { const int q = tid + 512 * (rnd * 2 + k), qq = q & 1023, ch = 1024 + (q >> 10) * 256 + g * 128 + (qq & 31) * 4; conv_load(cq[k], F.PROJ + 2048 + ch, r0 + (qq >> 5) * 4, cw, cbias, ch); }
        if (rnd == 0) ssd_dt_acum(dtv, acu, F.DT, r0, g, F.in[22], F.in[21], wid, lane);
        if (rnd == 1) { hv0 = *(const u32x4*)hsrc; hv1 = *(const u32x4*)(hsrc + 8);
#pragma unroll
            for (int i = 0; i < 4; ++i) xv[i] = *(const u32x2*)(xsrc + (size_t)i * DM);
#pragma unroll
            for (int pt = 0; pt < 4; ++pt) zw[pt] = *(const u32x2*)(zrow + 16 * pt); }
#pragma unroll
        for (int k = 0; k < 2; ++k) { const int q = tid + 512 * (rnd * 2 + k), qq = q & 1023; float o[4][4]; conv_compute(cq[k], zh && (qq >> 5) == 0, o);
            LAS bf16_t* dst = (q >> 10) ? Cs : Bs;
#pragma unroll
            for (int i = 0; i < 4; ++i) *(LAS u32x2*)(dst + ((qq >> 5) * 4 + i) * XT_P + (qq & 31) * 4) = (u32x2){pk2(o[i][0], o[i][1]), pk2(o[i][2], o[i][3])}; } } }
    __syncthreads();
#pragma unroll
    for (int k = 0; k < 2; ++k) { const int idx = tid + 512 * k, w = idx >> 7, s = idx & 127; T0[idx] = (s < 16 * w) ? __expf(acu[16 * w] - acu[s]) : 0.f; }
    f32x4 cb[8]; bf16x8 cfr[4];
#pragma unroll
    for (int st = 0; st < 8; ++st) cb[st] = (f32x4){0.f, 0.f, 0.f, 0.f};
#pragma unroll
    for (int ks = 0; ks < 4; ++ks) cfr[ks] = *(const LAS bf16x8*)(Cs + (16 * wid + fr) * XT_P + ks * 32 + fq * 8);
#pragma unroll
    for (int st = 0; st < 8; ++st) if (st <= wid) {
#pragma unroll
        for (int ks = 0; ks < 4; ++ks) { const bf16x8 bfr = *(const LAS bf16x8*)(Bs + (16 * st + fr) * XT_P + ks * 32 + fq * 8); cb[st] = MFMA16(bfr, cfr[ks], cb[st]); } }
    __syncthreads();
    float ss = 0.f;
#pragma unroll 1
    for (int hh = 0; hh < 8; ++hh) { const int h = g * 8 + hh; LAS bf16_t* Xt = Xt0 + (hh & 1) * (64 * XT_P); LAS bf16_t* Hs = Hs0 + (hh & 1) * (64 * XT_P);
        LAS float* T = T0 + (hh & 1) * 1024; LAS float* Tn = T0 + ((hh + 1) & 1) * 1024;
        { float f[4], o[4][4];
#pragma unroll
          for (int i = 0; i < 4; ++i) { f[i] = dtv[hh * 128 + xtg * 4 + i]; o[i][0] = bflo(xv[i].x) * f[i]; o[i][1] = bfhi(xv[i].x) * f[i]; o[i][2] = bflo(xv[i].y) * f[i]; o[i][3] = bfhi(xv[i].y) * f[i]; }
#pragma unroll
          for (int j = 0; j < 4; ++j) *(LAS u32x2*)(Xt + (xcg * 4 + j) * XT_P + xtg * 4) = (u32x2){pk2(o[0][j], o[1][j]), pk2(o[2][j], o[3][j])}; }
        *(LAS u32x4*)(Hs + (tid >> 3) * XT_P + (tid & 7) * 16) = hv0; *(LAS u32x4*)(Hs + (tid >> 3) * XT_P + (tid & 7) * 16 + 8) = hv1;
        u32x2 zc[4];
#pragma unroll
        for (int pt = 0; pt < 4; ++pt) zc[pt] = zw[pt];
        if (hh < 7) {
            hv0 = __builtin_nontemporal_load((const u32x4*)(hsrc + (size_t)(hh + 1) * 8192)); hv1 = __builtin_nontemporal_load((const u32x4*)(hsrc + (size_t)(hh + 1) * 8192 + 8));
#pragma unroll
            for (int i = 0; i < 4; ++i) xv[i] = __builtin_nontemporal_load((const u32x2*)(xsrc + (size_t)i * DM + (hh + 1) * 64));
#pragma unroll
            for (int pt = 0; pt < 4; ++pt) zw[pt] = *(const u32x2*)(zrow + (hh + 1) * 64 + 16 * pt);
#pragma unroll
            for (int k = 0; k < 2; ++k) { const int idx = tid + 512 * k, w = idx >> 7, s = idx & 127; Tn[idx] = (s < 16 * w) ? __expf(acu[(hh + 1) * 128 + 16 * w] - acu[(hh + 1) * 128 + s]) : 0.f; } }
        const float al = acu[hh * 128 + l], elw = __expf(al - acu[hh * 128 + 16 * wid]);
#pragma unroll
        for (int st = 0; st < 8; ++st) if (st <= (wid | 1)) { const int s0 = 16 * st + 4 * fq; float v[4];
            if (st < wid) { const f32x4 tv = *(const LAS f32x4*)(T + wid * 128 + s0);
#pragma unroll
                for (int j = 0; j < 4; ++j) v[j] = cb[st][j] * elw * tv[j]; }
            else {
#pragma unroll
                for (int j = 0; j < 4; ++j) v[j] = (s0 + j <= l) ? cb[st][j] * __expf(al - acu[hh * 128 + s0 + j]) : 0.f; }
            *(LAS u32x2*)(Ps + l * XT_P + s0) = (u32x2){pk2(v[0], v[1]), pk2(v[2], v[3])}; }
        __syncthreads();
        f32x4 accY[4], accO[4];
#pragma unroll
        for (int i = 0; i < 4; ++i) { accY[i] = (f32x4){0.f, 0.f, 0.f, 0.f}; accO[i] = (f32x4){0.f, 0.f, 0.f, 0.f}; }
#pragma unroll
        for (int ks = 0; ks < 4; ++ks) {
            if (ks <= (wid >> 1)) { const bf16x8 pfr = *(const LAS bf16x8*)(Ps + l * XT_P + ks * 32 + fq * 8);
#pragma unroll
                for (int pt = 0; pt < 4; ++pt) { const bf16x8 xfr = *(const LAS bf16x8*)(Xt + (16 * pt + fr) * XT_P + ks * 32 + fq * 8); accY[pt] = MFMA16(xfr, pfr, accY[pt]); } }
#pragma unroll
            for (int pt = 0; pt < 4; ++pt) { const bf16x8 hfr = *(const LAS bf16x8*)(Hs + (16 * pt + fr) * XT_P + ks * 32 + fq * 8); accO[pt] = MFMA16(hfr, cfr[ks], accO[pt]); } }
        const float el = __expf(al), rdt = 1.0f / dtv[hh * 128 + l], Dh = F.in[23][h];
#pragma unroll
        for (int pt = 0; pt < 4; ++pt) { bf16_t* zp = zrow + hh * 64 + 16 * pt;
            const float z[4] = {bflo(zc[pt].x), bfhi(zc[pt].x), bflo(zc[pt].y), bfhi(zc[pt].y)}; float y[4];
#pragma unroll
            for (int j = 0; j < 4; ++j) { const float xs = bf2f(Xt[(16 * pt + 4 * fq + j) * XT_P + l]) * rdt; y[j] = (accY[pt][j] + el * accO[pt][j] + Dh * xs) * siluf_(z[j]); ss += y[j] * y[j]; }
            *(u32x2*)zp = (u32x2){pk2(y[0], y[1]), pk2(y[2], y[3])}; }
    }
    ss += __shfl_xor(ss, 16); ss += __shfl_xor(ss, 32);
    if (defer_gn) { if (fq == 0) ((float*)(F.ws + WS_SSG))[(size_t)(r0 + l) * 2 + g] = ss; __syncthreads(); return; }
    const float rs = rs_from_ss(ss, 512.f);
    asm volatile("s_waitcnt vmcnt(0)" ::: "memory");
    { u32x2 wv[32];
#pragma unroll
      for (int i = 0; i < 32; ++i) wv[i] = *(const u32x2*)(zrow + 16 * i);
#pragma unroll
      for (int i = 0; i < 32; ++i) *(u32x2*)(zrow + 16 * i) = (u32x2){pk2(bflo(wv[i].x) * rs, bfhi(wv[i].x) * rs), pk2(bflo(wv[i].y) * rs, bfhi(wv[i].y) * rs)}; }
    __syncthreads();
}

__device__ __forceinline__ void s5_pass_a(const Frame& F, int gw, int NGW, int lane) {
    const int p0 = lane & 31, half = lane >> 5;
    bf16x8 afr[4];
    if (gw < NB * NCH * 64) { const bf16_t* ap = F.PROJ + (size_t)((gw >> 6) * 128 + p0) * PJ + (gw & 63) * 16 + half * 8;
#pragma unroll
        for (int rt = 0; rt < 4; ++rt) afr[rt] = *(const bf16x8*)(ap + (size_t)rt * 32 * PJ); }
#pragma unroll 1
    for (int job = gw; job < NB * NCH * 64; job += NGW) { const int g = job & 63, bc = job >> 6;
        bf16x8 acur[4];
#pragma unroll
        for (int rt = 0; rt < 4; ++rt) acur[rt] = afr[rt];
        if (job + NGW < NB * NCH * 64) { const int nj = job + NGW; const bf16_t* ap = F.PROJ + (size_t)((nj >> 6) * 128 + p0) * PJ + (nj & 63) * 16 + half * 8;
#pragma unroll
            for (int rt = 0; rt < 4; ++rt) afr[rt] = *(const bf16x8*)(ap + (size_t)rt * 32 * PJ); }
        float sr[2], si[2];
#pragma unroll
        for (int pp = 0; pp < 2; ++pp) { const int p = p0 + 32 * pp;
            const bf16x8 bre = *(const bf16x8*)(F.BBS + (size_t)(g * 128 + p) * 16 + half * 8), bim = *(const bf16x8*)(F.BBS + (size_t)(g * 128 + 64 + p) * 16 + half * 8);
            f32x2 w[16];
#pragma unroll
            for (int r = 0; r < 16; ++r) w[r] = F.PW[(size_t)((g * 2 + half) * 16 + r) * 64 + p];
            const f32x2 q = F.A32[g * 64 + p];
            float s_r = 0.f, s_i = 0.f;
#pragma unroll
            for (int rt = 0; rt < 4; ++rt) { f32x16 z;
#pragma unroll
                for (int r = 0; r < 16; ++r) z[r] = 0.f;
                const f32x16 are = MFMA32(acur[rt], bre, z), aim = MFMA32(acur[rt], bim, z);
                float tr = 0.f, ti = 0.f;
#pragma unroll
                for (int r = 0; r < 16; ++r) { tr += w[r].x * are[r] - w[r].y * aim[r]; ti += w[r].x * aim[r] + w[r].y * are[r]; }
                tr += __shfl_xor(tr, 32); ti += __shfl_xor(ti, 32);
                const float nr = q.x * s_r - q.y * s_i + tr, ni = q.x * s_i + q.y * s_r + ti; s_r = nr; s_i = ni; }
            sr[pp] = s_r; si[pp] = s_i; __builtin_amdgcn_sched_barrier(0); }
        F.SE[((size_t)((bc >> 4) * 64 + g) * 16 + (bc & 15)) * 64 + lane] = half ? (f32x2){sr[1], si[1]} : (f32x2){sr[0], si[0]};
    }
}
__device__ __forceinline__ void s5_pass_b(LAS unsigned char* wl, const Frame& F, int gw, int NGW, int lane) {
    int gcur = -1; bf16x8 bfr[4], cfr[4]; f32x4 d4; f32x2 a;
#pragma unroll 1
    for (int job = gw; job < NB * NCH * 64; job += NGW) { const int g = job & 63, bc = job >> 6;
        if (g != gcur) { gcur = g;
#pragma unroll
            for (int j = 0; j < 4; ++j) bfr[j] = *(const bf16x8*)(F.BBT + (size_t)(g * 128 + j * 32 + (lane & 31)) * 16 + (lane >> 5) * 8);
#pragma unroll
            for (int ks = 0; ks < 4; ++ks) cfr[ks] = *(const bf16x8*)(F.CM + (size_t)(g * 16 + (lane & 15)) * 128 + ks * 32 + (lane >> 4) * 8);
            d4 = *(const f32x4*)(F.in[15] + g * 16 + 4 * (lane >> 4)); a = F.AB[g * 64 + lane]; }
        const size_t r0 = (size_t)bc * 128;
        const bf16_t* ap = F.PROJ + (r0 + (lane & 31)) * PJ + g * 16 + (lane >> 5) * 8;
        const bf16_t* up = F.PROJ + (r0 + (lane & 15)) * PJ + g * 16 + 4 * (lane >> 4);
        bf16x8 afr[4]; u32x2 uw[8];
#pragma unroll
        for (int rt = 0; rt < 4; ++rt) afr[rt] = *(const bf16x8*)(ap + (size_t)rt * 32 * PJ);
#pragma unroll
        for (int i = 0; i < 8; ++i) uw[i] = *(const u32x2*)(up + (size_t)i * 16 * PJ);
        const f32x2 h0 = F.SE[((size_t)((bc >> 4) * 64 + g) * 16 + (bc & 15)) * 64 + lane]; float hr = h0.x, hi = h0.y;
#pragma unroll
        for (int rt = 0; rt < 4; ++rt) {
#pragma unroll
            for (int j = 0; j < 4; ++j) { f32x16 acc;
#pragma unroll
                for (int r = 0; r < 16; ++r) acc[r] = 0.f;
                acc = MFMA32(afr[rt], bfr[j], acc);
#pragma unroll
                for (int r = 0; r < 16; ++r) *(LAS float*)(wl + ((r & 3) + 8 * (r >> 2) + 4 * (lane >> 5)) * 528 + (j * 32 + (lane & 31)) * 4) = acc[r]; }
#pragma unroll 8
            for (int t = 0; t < 32; ++t) { const f32x2 bu = *(const LAS f32x2*)(wl + t * 528 + lane * 8);
                const float nr = a.x * hr - a.y * hi + bu.x, ni = a.x * hi + a.y * hr + bu.y; hr = nr; hi = ni;
                *(LAS unsigned*)(wl + t * 528 + lane * 4) = pk2(hr, hi); }
#pragma unroll
            for (int half = 0; half < 2; ++half) { f32x4 accy = (f32x4){0.f, 0.f, 0.f, 0.f};
#pragma unroll
                for (int ks = 0; ks < 4; ++ks) { const bf16x8 hfr = *(const LAS bf16x8*)(wl + (half * 16 + (lane & 15)) * 528 + (ks * 32 + (lane >> 4) * 8) * 2); accy = MFMA16(cfr[ks], hfr, accy); }
                const size_t row = r0 + rt * 32 + half * 16 + (lane & 15); const u32x2 u2 = uw[rt * 2 + half];
                const float y0 = gelu_tanh(accy[0] + d4[0] * bflo(u2.x)), y1 = gelu_tanh(accy[1] + d4[1] * bfhi(u2.x)), y2 = gelu_tanh(accy[2] + d4[2] * bflo(u2.y)), y3 = gelu_tanh(accy[3] + d4[3] * bfhi(u2.y));
                *(u32x2*)(F.XN + row * DM + g * 16 + 4 * (lane >> 4)) = (u32x2){pk2(y0, y1), pk2(y2, y3)}; }
        }
    }
}

struct S5In { u32x4 u0, u1, br0, br1, bi0, bi1; float h0r, h0i, ul, dl; f32x2 a; unsigned cm[16]; };
__device__ __forceinline__ void s5_sample_load(S5In& q, const Frame& F, int bs, int g, int lane) {
    const bf16_t* up = F.PROJ + ((size_t)MP + bs) * PJ + g * 16; q.u0 = *(const u32x4*)up; q.u1 = *(const u32x4*)(up + 8); q.ul = bf2f(up[lane & 15]); q.dl = F.in[15][g * 16 + (lane & 15)];
    const bf16_t* bp = F.BBT + (size_t)(g * 128 + 2 * lane) * 16; q.br0 = *(const u32x4*)bp; q.br1 = *(const u32x4*)(bp + 8); q.bi0 = *(const u32x4*)(bp + 16); q.bi1 = *(const u32x4*)(bp + 24);
    const size_t si = (size_t)(bs * 64 + g) * 64 + lane; q.h0r = F.in[2][si]; q.h0i = F.in[3][si]; q.a = F.AB[g * 64 + lane];
#pragma unroll
    for (int c = 0; c < 16; ++c) q.cm[c] = *(const unsigned*)(F.CM + (size_t)(g * 16 + c) * 128 + 2 * lane);
}
__device__ __forceinline__ float dot8bf(const u32x4 w, const float* u) { return (bflo(w.x) * u[0] + bfhi(w.x) * u[1]) + (bflo(w.y) * u[2] + bfhi(w.y) * u[3]) + (bflo(w.z) * u[4] + bfhi(w.z) * u[5]) + (bflo(w.w) * u[6] + bfhi(w.w) * u[7]); }
__device__ __forceinline__ void s5_sample_compute(const S5In& q, const Frame& F, int bs, int g, int lane) {
    const float u[16] = {bflo(q.u0.x), bfhi(q.u0.x), bflo(q.u0.y), bfhi(q.u0.y), bflo(q.u0.z), bfhi(q.u0.z), bflo(q.u0.w), bfhi(q.u0.w), bflo(q.u1.x), bfhi(q.u1.x), bflo(q.u1.y), bfhi(q.u1.y), bflo(q.u1.z), bfhi(q.u1.z), bflo(q.u1.w), bfhi(q.u1.w)};
    const float bre = dot8bf(q.br0, u) + dot8bf(q.br1, u + 8), bim = dot8bf(q.bi0, u) + dot8bf(q.bi1, u + 8);
    const size_t si = (size_t)(bs * 64 + g) * 64 + lane;
    const float hr = q.a.x * q.h0r - q.a.y * q.h0i + bre, hi = q.a.x * q.h0i + q.a.y * q.h0r + bim;
    F.out[O_S5RS + si] = hr; F.out[O_S5IS + si] = hi;
    float yv = 0.f;
#pragma unroll
    for (int c = 0; c < 16; ++c) { const float v = half_sum_dpp(bflo(q.cm[c]) * hr + bfhi(q.cm[c]) * hi);
        const float tot = __builtin_bit_cast(float, __builtin_amdgcn_readlane(__builtin_bit_cast(int, v), 31)) + __builtin_bit_cast(float, __builtin_amdgcn_readlane(__builtin_bit_cast(int, v), 63)); if (lane == c) yv = tot; }
    if (lane < 16) { const float y = gelu_tanh(yv + q.dl * q.ul); F.XN[((size_t)MP + bs) * DM + g * 16 + lane] = (bf16_t)(pk2(y, 0.f) & 0xffffu); }
}
__device__ __forceinline__ void s5_sample_jobs(const Frame& F, int first, int stride, int lane) {
    if (first >= NSAMP * 64) return;
    S5In cur; s5_sample_load(cur, F, first >> 6, first & 63, lane);
#pragma unroll 1
    for (int job = first; job < NSAMP * 64; job += stride) { const int nj = job + stride; S5In nxt = cur;
        if (nj < NSAMP * 64) s5_sample_load(nxt, F, nj >> 6, nj & 63, lane);
        s5_sample_compute(cur, F, job >> 6, job & 63, lane); cur = nxt; }
}

__device__ __forceinline__ void ssd_sample_job(LAS unsigned char* lds, const Frame& F, int bs, int g) {
    const int tid = threadIdx.x, wid = __builtin_amdgcn_readfirstlane(tid >> 6), lane = tid & 63, h = g * 8 + wid, half = lane >> 5, n4 = (lane & 31) * 4;
    LAS float* red = (LAS float*)lds;
    const size_t row = (size_t)MP + bs;
    const int chx = h * 64 + lane, chb = 1024 + g * 128 + n4, chc = 1280 + g * 128 + n4;
    const float* sc = F.in[5] + (size_t)bs * 3 * DCONV; const float* cw = F.in[19]; const bf16_t* xr = F.PROJ + row * PJ + 2048;
    float xx[4], wx[4]; f32x4 xb[4], xc[4], wb[4], wc_[4];
#pragma unroll
    for (int k = 0; k < 3; ++k) { xx[k] = sc[k * DCONV + chx]; xb[k] = *(const f32x4*)(sc + k * DCONV + chb); xc[k] = *(const f32x4*)(sc + k * DCONV + chc); }
    { xx[3] = bf2f(xr[chx]); const u32x2 b2 = *(const u32x2*)(xr + chb), c2 = *(const u32x2*)(xr + chc);
      xb[3] = (f32x4){bflo(b2.x), bfhi(b2.x), bflo(b2.y), bfhi(b2.y)}; xc[3] = (f32x4){bflo(c2.x), bfhi(c2.x), bflo(c2.y), bfhi(c2.y)}; }
#pragma unroll
    for (int k = 0; k < 4; ++k) { wx[k] = cw[k * DCONV + chx]; wb[k] = *(const f32x4*)(cw + k * DCONV + chb); wc_[k] = *(const f32x4*)(cw + k * DCONV + chc); }
    const float bx = F.in[20][chx]; const f32x4 bb = *(const f32x4*)(F.in[20] + chb), bc = *(const f32x4*)(F.in[20] + chc);
    const float dtraw = F.DT[row * 16 + h], dtb = F.in[22][h], alog = F.in[21][h], dh = F.in[23][h];
    bf16_t* zp = F.PROJ + row * PJ + 1024 + h * 64 + lane; const float zv = bf2f(*zp);
    const float xs = siluf_(bx + (wx[0] * xx[0] + wx[1] * xx[1]) + (wx[2] * xx[2] + wx[3] * xx[3]));
    float B4[4], C4[4];
#pragma unroll
    for (int i = 0; i < 4; ++i) { B4[i] = siluf_(bb[i] + (wb[0][i] * xb[0][i] + wb[1][i] * xb[1][i]) + (wb[2][i] * xb[2][i] + wb[3][i] * xb[3][i]));
        C4[i] = siluf_(bc[i] + (wc_[0][i] * xc[0][i] + wc_[1][i] * xc[1][i]) + (wc_[2][i] * xc[2][i] + wc_[3][i] * xc[3][i])); }
    const float dt = softplusf_(dtraw + dtb), dA = __expf(-dt * __expf(alog));
    const float* sp = F.in[4] + ((size_t)(bs * 16 + h) * 64 + half) * 128 + n4;
    float* op = F.out + O_SSDS + ((size_t)(bs * 16 + h) * 64 + half) * 128 + n4;
    const float xdt = xs * dt;
    float y = 0.f;
#pragma unroll
    for (int bt = 0; bt < 2; ++bt) { f32x4 hb[16];
#pragma unroll
        for (int i = 0; i < 16; ++i) hb[i] = __builtin_nontemporal_load((const f32x4*)(sp + (bt * 16 + i) * 256));
#pragma unroll
        for (int i = 0; i < 16; ++i) { const int pp = bt * 16 + i; const float xp = __shfl(xdt, 2 * pp + half); const f32x4 h0 = hb[i];
            const f32x4 hn = (f32x4){dA * h0[0] + xp * B4[0], dA * h0[1] + xp * B4[1], dA * h0[2] + xp * B4[2], dA * h0[3] + xp * B4[3]}; __builtin_nontemporal_store(hn, (f32x4*)(op + pp * 256));
            const float v = half_sum_dpp((C4[0] * hn[0] + C4[1] * hn[1]) + (C4[2] * hn[2] + C4[3] * hn[3]));
            const float t0 = __builtin_bit_cast(float, __builtin_amdgcn_readlane(__builtin_bit_cast(int, v), 31)), t1 = __builtin_bit_cast(float, __builtin_amdgcn_readlane(__builtin_bit_cast(int, v), 63));
            if (lane == 2 * pp) y = t0; if (lane == 2 * pp + 1) y = t1; } }
    { float* oc = F.out + O_CVS + (size_t)bs * 3 * DCONV;
#pragma unroll
      for (int k = 0; k < 3; ++k) { oc[k * DCONV + chx] = xx[k + 1]; if (wid == 0 && half == 0) { *(f32x4*)(oc + k * DCONV + chb) = xb[k + 1]; *(f32x4*)(oc + k * DCONV + chc) = xc[k + 1]; } } }
    y = (y + dh * xs) * siluf_(zv);
    const float ssw = wave_sum(y * y);
    if (lane == 0) red[wid] = ssw;
    __syncthreads();
    float tot = 0.f;
#pragma unroll
    for (int w = 0; w < 8; ++w) tot += red[w];
    *zp = (bf16_t)(pk2(y * rs_from_ss(tot, 512.f), 0.f) & 0xffffu);
    __syncthreads();
}

#define XB_TMO      128
#define XB_XCNT(j)  (256  + 64 * (j))
#define XB_XSUB(j)  (1280 + 64 * (j))
#define XB_XGEN(j)  (2304 + 64 * (j))
#define XB_TOP      3328
#define XB_TOPGEN   3392
#define XCD_BAR_WORDS 3456
#define XB_SPIN_CAP (1u << 18)
__device__ __forceinline__ unsigned xb_ld(unsigned* p)              { return __hip_atomic_load(p, __ATOMIC_RELAXED, __HIP_MEMORY_SCOPE_AGENT); }
__device__ __forceinline__ unsigned xb_add(unsigned* p, unsigned v) { return __hip_atomic_fetch_add(p, v, __ATOMIC_RELAXED, __HIP_MEMORY_SCOPE_AGENT); }
__device__ __forceinline__ unsigned xb_xcc_id() { return (unsigned)__builtin_amdgcn_s_getreg((3 << 11) | 20) & 0xFu; }
#define XB_SPIN(cond, bar) do { unsigned _sp = 0; while (cond) { __builtin_amdgcn_s_sleep(1); \
    if ((++_sp & 255u) == 0u) { if (xb_ld(&(bar)[XB_TMO])) break; if (_sp > XB_SPIN_CAP) { atomicAdd(&(bar)[XB_TMO], 1u); break; } } } } while (0)
struct XcdBarrier { unsigned* bar; unsigned x; volatile LAS unsigned* st; };
__device__ __forceinline__ XcdBarrier xcd_barrier_post(unsigned* bar, volatile LAS unsigned* st) {
    XcdBarrier b; b.bar = bar; b.x = xb_xcc_id(); b.st = st;
    if (threadIdx.x == 0) (void)xb_add(&bar[XB_XCNT(b.x)], 1u);
    return b;
}
__device__ __forceinline__ void xcd_barrier_complete(unsigned* bar, unsigned x, unsigned& nloc, unsigned& nx) {
    const unsigned G = gridDim.x * gridDim.y * gridDim.z;
    unsigned sum, cnt, mine, sp = 0u;
    for (;;) {
        sum = 0u; cnt = 0u; mine = 0u;
#pragma unroll
        for (unsigned j = 0; j < 16; ++j) { const unsigned c = xb_ld(&bar[XB_XCNT(j)]); sum += c; cnt += (c > 0u) ? 1u : 0u; mine = (j == x) ? c : mine; }
        if (sum == G) break;
        __builtin_amdgcn_s_sleep(1);
        if ((++sp & 255u) == 0u) { if (xb_ld(&bar[XB_TMO])) break; if (sp > XB_SPIN_CAP) { atomicAdd(&bar[XB_TMO], 1u); break; } }
    }
    nloc = mine > 0u ? mine : 1u; nx = cnt > 0u ? cnt : 1u;
}
__device__ __forceinline__ void xcd_barrier(const XcdBarrier& b) {
    asm volatile("s_waitcnt vmcnt(0)" ::: "memory");
    __syncthreads();
    if (threadIdx.x == 0) {
        unsigned* bar = b.bar;
        __builtin_amdgcn_s_waitcnt(0);
        unsigned nloc = b.st[0], nx = b.st[1];
        if (nloc == 0u) { xcd_barrier_complete(bar, b.x, nloc, nx); b.st[0] = nloc; b.st[1] = nx; }
        const unsigned old = xb_add(&bar[XB_XSUB(b.x)], 1u);
        const unsigned gen = old / nloc;
        if (old + 1u == (gen + 1u) * nloc) {
            __builtin_amdgcn_fence(__ATOMIC_RELEASE, "agent");
            asm volatile("s_waitcnt vmcnt(0)" ::: "memory");
            const unsigned og = xb_add(&bar[XB_TOP], 1u);
            const unsigned tg = og / nx;
            if (og + 1u == (tg + 1u) * nx) xb_add(&bar[XB_TOPGEN], 1u);
            else XB_SPIN(xb_ld(&bar[XB_TOPGEN]) == tg, bar);
            __builtin_amdgcn_fence(__ATOMIC_ACQUIRE, "agent");
            xb_add(&bar[XB_XGEN(b.x)], 1u);
            asm volatile("s_waitcnt vmcnt(0)" ::: "memory");
        } else {
            XB_SPIN(xb_ld(&bar[XB_XGEN(b.x)]) == gen, bar);
            __builtin_amdgcn_fence(__ATOMIC_ACQUIRE, "agent");
            asm volatile("s_waitcnt vmcnt(0)" ::: "memory");
        }
    }
    __syncthreads();
}

__device__ __forceinline__ void convert_item(const Frame& F, int it, LAS float* scr, int lane) {
    constexpr int I_IN = 16 * (N1 / 32), I_GLU = 16 * 32, I_OUT = 32 * 32, I_FF1 = 16 * 128;
    int r = it;
    if (r < I_IN) { p0_transpose_item(F.in[7], 1024, N1V, N1, F.WIN, nullptr, scr, r, lane); return; } r -= I_IN;
    if (r < I_GLU) { p0_transpose_item(F.in[16], 1024, 1024, 1024, F.WGLU, nullptr, scr, r, lane); return; } r -= I_GLU;
    if (r < I_OUT) { const int k0 = 64 * (r / 32); p0_transpose_item(F.in[25], 2048, 1024, 1024, F.WOUT, k0 < 1024 ? F.in[18] : F.in[24] - 1024, scr, r, lane); return; } r -= I_OUT;
    if (r < I_FF1) { p0_transpose_item(F.in[27], 1024, 4096, 4096, F.WFF1, F.in[26], scr, r, lane); return; } r -= I_FF1;
    p0_transpose_item(F.in[28], 4096, 1024, 1024, F.WFF2, nullptr, scr, r, lane);
}

__global__ void __launch_bounds__(512, 2) hymba_fwd(Args args) {
    extern __shared__ __attribute__((aligned(16))) unsigned char lds_raw[];
    LAS unsigned char* lds = (LAS unsigned char*)lds_raw;
    cg::grid_group grid = cg::this_grid();
    Frame F;
#pragma unroll
    for (int i = 0; i < 30; ++i) F.in[i] = args.in[i];
    F.out = args.out; F.ws = args.ws;
    unsigned char* ws = args.ws;
    F.WIN = (bf16_t*)(ws + WS_WIN); F.WGLU = (bf16_t*)(ws + WS_WGLU); F.WOUT = (bf16_t*)(ws + WS_WOUT); F.WFF1 = (bf16_t*)(ws + WS_WFF1); F.WFF2 = (bf16_t*)(ws + WS_WFF2);
    F.XN = (bf16_t*)(ws + WS_XN); F.PROJ = (bf16_t*)(ws + WS_PROJ); F.ST = (bf16_t*)(ws + WS_ST); F.HID = (bf16_t*)(ws + WS_HID);
    F.XS = (bf16_t*)(ws + WS_XS); F.BBT = (bf16_t*)(ws + WS_BBT); F.CM = (bf16_t*)(ws + WS_CM);
    F.SS5 = (float*)(ws + WS_SS5); F.SSF = (float*)(ws + WS_SSF); F.CD = (float*)(ws + WS_CD); F.DT = (float*)(ws + WS_DT);
    F.PW = (f32x2*)(ws + WS_PW); F.A32 = (f32x2*)(ws + WS_A32); F.BBS = (bf16_t*)(ws + WS_BBS); F.AB = (f32x2*)(ws + WS_AB); F.AQ = (f32x2*)(ws + WS_AQ); F.SE = (f32x2*)(ws + WS_SE);
    const int tid = threadIdx.x, wid = __builtin_amdgcn_readfirstlane(tid >> 6), lane = tid & 63;
    const int G = gridDim.x, gt = blockIdx.x * 512 + tid, GT = G * 512, gw = blockIdx.x * 8 + wid, NGW = G * 8;
    const int lo = args.ph_lo, hi = args.ph_hi;
    const bool late_w = (G == 256);
    if (lo < 0) grid.sync();
    if (tid < 2) ((LAS unsigned*)(lds + LDS_MAIN))[tid] = 0u;
    __syncthreads();
    XcdBarrier bar = xcd_barrier_post((unsigned*)(ws + WS_BAR), (volatile LAS unsigned*)(lds + LDS_MAIN));
#define IN(k) (lo <= (k) && (k) < hi)
#ifndef PROBE_SYNCS
#define PROBE_SYNCS 1
#endif
#ifndef PROBE_REP
#define PROBE_REP 0
#endif
#define SEAM(k) do { if (IN(k) && IN((k) + 1)) { for (int _s = 0; _s < PROBE_SYNCS; ++_s) xcd_barrier(bar); } } while (0)
#define REPS(k) (((PROBE_REP >> (k)) & 1) + 1)
#ifdef PROBE_TS
    unsigned long long* const tsb = (unsigned long long*)(ws + WS_TS);
    if (blockIdx.x == 0 && tid == 0) tsb[0] = __builtin_amdgcn_s_memrealtime();
#define STAMP(k) do { if (blockIdx.x == 0 && tid == 0) tsb[1 + (k)] = __builtin_amdgcn_s_memrealtime(); } while (0)
#else
#define STAMP(k) do {} while (0)
#endif

    if (IN(0)) for (int _rep = 0; _rep < REPS(0); ++_rep) { if (_rep) xcd_barrier(bar);
        for (int i = gt; i < TT; i += GT) { F.SS5[i] = 0.f; F.SSF[i] = 0.f; }
        LAS float* scr = (LAS float*)(lds + wid * 8448);
        constexpr int I_IN = 16 * (N1 / 32), I_GLU = 16 * 32, I_OUT = 32 * 32, I_FF1 = 16 * 128, I_FF2 = 64 * 32, I_ALL = I_IN + I_GLU + I_OUT + I_FF1 + I_FF2;
        for (int it = gw; it < (late_w ? I_IN : I_ALL); it += NGW) convert_item(F, it, scr, lane);
        for (int m0 = gw * 2; m0 < TT; m0 += NGW * 2) {
            f32x4 v[2][4]; float s[2] = {0.f, 0.f};
#pragma unroll
            for (int q = 0; q < 2; ++q) { const int m = m0 + q; const float* src = m < MP ? F.in[0] + (size_t)m * DM : F.in[1] + (size_t)(m - MP) * DM;
#pragma unroll
                for (int j = 0; j < 4; ++j) v[q][j] = __builtin_nontemporal_load((const f32x4*)(src + 4 * lane + 256 * j)); }
            f32x4 gn[4];
#pragma unroll
            for (int j = 0; j < 4; ++j) gn[j] = *(const f32x4*)(F.in[6] + 4 * lane + 256 * j);
#pragma unroll
            for (int q = 0; q < 2; ++q) {
#pragma unroll
                for (int j = 0; j < 4; ++j) s[q] += (v[q][j][0] * v[q][j][0] + v[q][j][1] * v[q][j][1]) + (v[q][j][2] * v[q][j][2] + v[q][j][3] * v[q][j][3]);
                const float rs = rs_from_ss(wave_sum(s[q]), 1024.f);
#pragma unroll
                for (int j = 0; j < 4; ++j) *(u32x2*)(F.XN + (size_t)(m0 + q) * DM + 4 * lane + 256 * j) = (u32x2){pk2(v[q][j][0] * rs * gn[j][0], v[q][j][1] * rs * gn[j][1]), pk2(v[q][j][2] * rs * gn[j][2], v[q][j][3] * rs * gn[j][3])}; } }
        for (int t = gt; t < 4096 * 32; t += GT) { const int idx = t >> 5, k = t & 31, g = idx >> 6, p = idx & 63;
            const float dt = expf(F.in[10][g]), lr = F.in[8][idx], li = F.in[9][idx];
            const float mag = expf(lr * dt), ang = li * dt, abr = mag * cosf(ang), abi = mag * sinf(ang);
            { float pr = 1.f, pi = 0.f, br_ = abr, bi_ = abi;
#pragma unroll
              for (int bit = 0; bit < 5; ++bit) { if ((k >> bit) & 1) { const float tr = pr * br_ - pi * bi_, ti = pr * bi_ + pi * br_; pr = tr; pi = ti; } const float sr = br_ * br_ - bi_ * bi_, si = 2.f * br_ * bi_; br_ = sr; bi_ = si; }
              const int tt = 31 - k, hf = (tt >> 2) & 1, r = (tt & 3) + 4 * (tt >> 3);
              F.PW[(size_t)((g * 2 + hf) * 16 + r) * 64 + p] = (f32x2){pr, pi};
              if (k == 0) { F.AB[idx] = (f32x2){abr, abi}; F.A32[idx] = (f32x2){br_, bi_};
                  const float q1r = br_ * br_ - bi_ * bi_, q1i = 2.f * br_ * bi_, q2r = q1r * q1r - q1i * q1i, q2i = 2.f * q1r * q1i; F.AQ[idx] = (f32x2){q2r, q2i}; } }
            if (k < 16) { const int c = k;
                const float den = lr * lr + li * li, nr = abr - 1.f, ni = abi, fre = (nr * lr + ni * li) / den, fim = (ni * lr - nr * li) / den;
                const float br = F.in[11][(size_t)idx * 16 + c], bi = F.in[12][(size_t)idx * 16 + c], cr = F.in[13][(size_t)(g * 16 + c) * 64 + p], ci = F.in[14][(size_t)(g * 16 + c) * 64 + p];
                const bf16_t vr = (bf16_t)(pk2(fre * br - fim * bi, 0.f) & 0xffffu), vi = (bf16_t)(pk2(fre * bi + fim * br, 0.f) & 0xffffu);
                F.BBT[(size_t)(g * 128 + 2 * p) * 16 + c] = vr; F.BBT[(size_t)(g * 128 + 2 * p + 1) * 16 + c] = vi; F.BBS[(size_t)(g * 128 + p) * 16 + c] = vr; F.BBS[(size_t)(g * 128 + 64 + p) * 16 + c] = vi;
                *(unsigned*)(F.CM + (size_t)(g * 16 + c) * 128 + 2 * p) = pk2(cr, -ci); } }
    }
    SEAM(0); STAMP(0);

    const bool early = false;
    if (IN(1)) for (int _rep = 0; _rep < REPS(1); ++_rep) { if (_rep) xcd_barrier(bar);
        bf16_t* P = F.PROJ; float* DTp = F.DT;
        auto sk1 = [=](int row, int col, float lo0, float hi0, float lo1, float hi1) {
            const float v0 = lo0 + hi0, v1 = lo1 + hi1; const size_t r = (size_t)MP + row;
            if (col < PJ) *(unsigned*)(P + r * PJ + col) = pk2(v0, v1); else if (col < N1V) { DTp[r * 16 + col - PJ] = v0; DTp[r * 16 + col - PJ + 1] = v1; } };
        unsigned* cnt2 = (unsigned*)(ws + WS_CNT2);
        if (early) {
            skinny_gemm(lds, F.XN + (size_t)MP * DM, DM, F.WIN, DM, DM, 113, sk1);
            asm volatile("s_waitcnt vmcnt(0)" ::: "memory"); __syncthreads();
            if (tid == 0) { __builtin_amdgcn_fence(__ATOMIC_RELEASE, "agent"); asm volatile("s_waitcnt vmcnt(0)" ::: "memory"); xb_add(cnt2, 1u); }
        }
        pg8::Gemm gm{F.XN, F.WIN, DM, DM, DM}; pg8::StaticOrder S; S.init(MP, early ? PJ : N1, G, (int)blockIdx.x);
        EpiProj E{F.PROJ, F.DT};
        pg8::gemm_phase<EpiProj, pg8::StaticOrder, true, true>(lds, gm, S, E);
        if (late_w && !early && blockIdx.x >= 192) { LAS float* scr = (LAS float*)(lds + wid * 8448); constexpr int I_IN = 16 * (N1 / 32), I_ALL = I_IN + 16 * 32 + 32 * 32 + 16 * 128 + 64 * 32;
            for (int it = I_IN + (blockIdx.x - 192) * 8 + wid; it < I_ALL; it += 512) convert_item(F, it, scr, lane);
            __syncthreads(); }
        if (!early) skinny_gemm<1, 2>(lds, F.XN + (size_t)MP * DM, DM, F.WIN, DM, DM, 113, sk1);
        else if (blockIdx.x >= 128) {
            { const int fr = lane & 15, fq = lane >> 4;
              for (int rt = (blockIdx.x - 128) * 8 + wid; rt < MP / 16; rt += 1024) { f32x4 acc = (f32x4){0.f, 0.f, 0.f, 0.f};
                const bf16_t* ap = F.XN + (size_t)(16 * rt + fr) * DM + fq * 8; const bf16_t* bp = F.WIN + (size_t)(PJ + fr) * DM + fq * 8;
#pragma unroll 16
                for (int ks = 0; ks < 32; ++ks) { const bf16x8 a = *(const bf16x8*)(ap + ks * 32), b_ = *(const bf16x8*)(bp + ks * 32); acc = MFMA16(a, b_, acc); }
#pragma unroll
                for (int j = 0; j < 4; ++j) F.DT[(size_t)(16 * rt + 4 * fq + j) * 16 + fr] = acc[j]; } }
            if (tid == 0) { unsigned sp = 0; while (xb_ld(cnt2) < (unsigned)G && ++sp < (1u << 22)) __builtin_amdgcn_s_sleep(1); __builtin_amdgcn_fence(__ATOMIC_ACQUIRE, "agent"); asm volatile("s_waitcnt vmcnt(0)" ::: "memory"); }
            __syncthreads();
            for (int j = blockIdx.x - 128; j < NSAMP * 2; j += 128) ssd_sample_job(lds, F, j >> 1, j & 1);
            s5_sample_jobs(F, (blockIdx.x - 128) * 8 + wid, 1024, lane);
        }
    }
    SEAM(1); STAMP(1);

    if (IN(2)) {
        const bool sample_first = false;
        if (sample_first) for (int j = blockIdx.x; j < NSAMP * 2; j += G) ssd_sample_job(lds, F, j >> 1, j & 1);
        for (int tile = blockIdx.x; tile < NB * NCH * 2; tile += G) ssd_states_tile(lds, F, tile >> 5, (tile >> 1) & 15, tile & 1);
        __syncthreads(); STAMP(10);
        s5_pass_a(F, gw, NGW, lane);
        __syncthreads(); STAMP(11);
        if (!early) { for (int j = blockIdx.x; j < NSAMP * 2; j += G) ssd_sample_job(lds, F, j >> 1, j & 1);
            s5_sample_jobs(F, gw, NGW, lane); }
        STAMP(12);
    }
    SEAM(2); STAMP(2);

    if (IN(3)) {
        for (int idx = gt; idx < NB * 16 * 64 * 16; idx += GT) { const int n8 = idx & 15, p = (idx >> 4) & 63, h = (idx >> 10) & 15, b = idx >> 14;
            bf16_t* base = F.ST + ((size_t)(b * 16 * 16 + h) * 64 + p) * 128 + n8 * 8; const size_t cstep = (size_t)16 * 64 * 128;
            u32x4 v[NCH];
#pragma unroll
            for (int c = 0; c < NCH; ++c) v[c] = *(const u32x4*)(base + c * cstep);
            float hs[8];
#pragma unroll
            for (int i = 0; i < 8; ++i) hs[i] = 0.f;
#pragma unroll
            for (int c = 0; c < NCH; ++c) { const float cd = F.CD[(b * 16 + c) * 16 + h];
                *(u32x4*)(base + c * cstep) = (u32x4){pk2(hs[0], hs[1]), pk2(hs[2], hs[3]), pk2(hs[4], hs[5]), pk2(hs[6], hs[7])};
                hs[0] = cd * hs[0] + bflo(v[c].x); hs[1] = cd * hs[1] + bfhi(v[c].x); hs[2] = cd * hs[2] + bflo(v[c].y); hs[3] = cd * hs[3] + bfhi(v[c].y);
                hs[4] = cd * hs[4] + bflo(v[c].z); hs[5] = cd * hs[5] + bfhi(v[c].z); hs[6] = cd * hs[6] + bflo(v[c].w); hs[7] = cd * hs[7] + bfhi(v[c].w); }
            float* o = F.out + O_SSDP + ((size_t)(b * 16 + h) * 64 + p) * 128 + n8 * 8;
            *(f32x4*)o = (f32x4){hs[0], hs[1], hs[2], hs[3]}; *(f32x4*)(o + 4) = (f32x4){hs[4], hs[5], hs[6], hs[7]}; }
        for (int idx = gt; idx < NB * 64 * 64; idx += GT) { const int p = idx & 63, bg = idx >> 6, g = bg & 63;
            const f32x2 aq = F.AQ[g * 64 + p]; f32x2* sp = F.SE + (size_t)bg * 16 * 64 + p; float hr = 0.f, hi_ = 0.f;
#pragma unroll 4
            for (int c = 0; c < NCH; ++c) { const f32x2 t = sp[c * 64]; sp[c * 64] = (f32x2){hr, hi_}; const float nr = aq.x * hr - aq.y * hi_ + t.x, ni = aq.x * hi_ + aq.y * hr + t.y; hr = nr; hi_ = ni; }
            F.out[O_S5RP + idx] = hr; F.out[O_S5IP + idx] = hi_; }
        {
        const bf16_t* Gp = F.XN; bf16_t* P = F.PROJ; const float* bias = F.in[17]; float* SS = F.SS5;
        skinny_gemm(lds, F.XN + (size_t)MP * DM, DM, F.WGLU, DM, DM, 32, [=](int row, int col, float lo0, float hi0, float lo1, float hi1) {
            const size_t r = (size_t)MP + row; const unsigned gw_ = *(const unsigned*)(Gp + r * DM + col);
            const float o0 = bflo(gw_) * sigmoidf_(lo0 + hi0 + bias[col]), o1 = bfhi(gw_) * sigmoidf_(lo1 + hi1 + bias[col + 1]);
            *(unsigned*)(P + r * PJ + col) = pk2(o0, o1);
            const float ss = red16(o0 * o0 + o1 * o1); if ((threadIdx.x & 15) == 0) atomicAdd(SS + r, ss); });
        }
    }
    SEAM(3); STAMP(3);

    if (IN(4)) {
        for (int tile = blockIdx.x; tile < NB * NCH * 2; tile += G) ssd_y_tile(lds, F, tile >> 5, (tile >> 1) & 15, tile & 1, G == 256);
        __syncthreads(); STAMP(13);
        s5_pass_b(lds + wid * 16896, F, gw, NGW, lane);
        __syncthreads();
        {
        const float* xs = F.in[1]; float* X1 = F.out; bf16_t* X1B = F.XN; float* SSF = F.SSF; const float* SS5 = F.SS5;
        skinny_gemm(lds, F.PROJ + (size_t)MP * PJ, PJ, F.WOUT, 2048, 2048, 32, [=](int row, int col, float lo0, float hi0, float lo1, float hi1) {
            const size_t r = (size_t)MP + row; const float s = rs_from_ss(SS5[r], 1024.f);
            const float v0 = xs[(size_t)row * DM + col] + lo0 * s + hi0, v1 = xs[(size_t)row * DM + col + 1] + lo1 * s + hi1;
            X1[r * DM + col] = v0; X1[r * DM + col + 1] = v1; *(unsigned*)(X1B + r * DM + col) = pk2(v0, v1);
            const float ss = red16(v0 * v0 + v1 * v1); if ((threadIdx.x & 15) == 0) atomicAdd(SSF + r, ss); });
        }
    }
    SEAM(4); STAMP(4);

    if (IN(5)) {
        pg8::Gemm gm{F.XN, F.WGLU, DM, DM, DM}; pg8::StaticOrder S; S.init(MP, DM, G, (int)blockIdx.x);
        EpiGlu E{F.XN, F.PROJ, F.in[17], F.SS5};
        pg8::gemm_phase<EpiGlu, pg8::StaticOrder, false, true>(lds, gm, S, E);
        {
        bf16_t* H = F.HID; const float* SSF = F.SSF;
        skinny_gemm<1, 2>(lds, F.XN + (size_t)MP * DM, DM, F.WFF1, DM, DM, 128, [=](int row, int col, float lo0, float hi0, float lo1, float hi1) {
            const size_t r = (size_t)MP + row; const float s = rs_from_ss(SSF[r], 1024.f);
            const float a = fmaxf((lo0 + hi0) * s, 0.f), b = fmaxf((lo1 + hi1) * s, 0.f); *(unsigned*)(H + r * DFF + col) = pk2(a * a, b * b); });
        }
    }
    SEAM(5); STAMP(5);

    if (IN(6)) {
        pg8::Gemm gm{F.PROJ, F.WOUT, PJ, 2048, 2048}; pg8::StaticOrder S; S.init(MP, DM, G, (int)blockIdx.x);
        const LAS float* tab = nullptr;
        if (G == 256) { pg8::Unit u0; if (S.next(0, u0) && tid < 256) { const int row = u0.pm * 256 + tid; const f32x2 sg = *(const f32x2*)((const float*)(ws + WS_SSG) + (size_t)row * 2);
                const float s5 = rs_from_ss(F.SS5[row], 1024.f), g0 = rs_from_ss(sg.x, 512.f), g1 = rs_from_ss(sg.y, 512.f); LAS float* tw = (LAS float*)(lds + 131072);
                tw[tid] = s5 / g0; tw[256 + tid] = g0 / g1; tw[512 + tid] = g1; }
            __syncthreads(); tab = (const LAS float*)(lds + 131072); }
        if (tab) { EpiOut<true> E{F.in[0], F.out, F.XN, F.SSF, F.SS5, tab}; pg8::gemm_phase<EpiOut<true>, pg8::StaticOrder, false, true>(lds, gm, S, E); }
        else { EpiOut<false> E{F.in[0], F.out, F.XN, F.SSF, F.SS5, tab}; pg8::gemm_phase<EpiOut<false>, pg8::StaticOrder, false, true>(lds, gm, S, E); }
        {
        float* X1 = F.out;
        skinny_gemm<2>(lds, F.HID + (size_t)MP * DFF, DFF, F.WFF2, DFF, DFF, 32, [=](int row, int col, float lo0, float hi0, float lo1, float hi1) {
            const size_t r = (size_t)MP + row; atomicAdd(X1 + r * DM + col, lo0 + hi0); atomicAdd(X1 + r * DM + col + 1, lo1 + hi1); });
        }
    }
    SEAM(6); STAMP(6);

    if (IN(7)) for (int _rep = 0; _rep < REPS(7); ++_rep) { if (_rep) xcd_barrier(bar);
        pg8::Gemm gm{F.XN, F.WFF1, DM, DM, DM}; pg8::StaticOrder S; S.init(MP, DFF, G, (int)blockIdx.x);
        EpiFF1 E{F.HID, F.SSF};
        pg8::gemm_phase<EpiFF1, pg8::StaticOrder, true, true>(lds, gm, S, E);
        for (int m = MP + gw; m < TT; m += NGW) { float* src = F.out + (size_t)m * DM;
            f32x4 v[4]; float sq = 0.f;
#pragma unroll
            for (int j = 0; j < 4; ++j) { v[j] = *(const f32x4*)(src + 4 * lane + 256 * j); sq += (v[j][0] * v[j][0] + v[j][1] * v[j][1]) + (v[j][2] * v[j][2] + v[j][3] * v[j][3]); }
            const float rs = rs_from_ss(wave_sum(sq), 1024.f);
#pragma unroll
            for (int j = 0; j < 4; ++j) { const f32x4 gn = *(const f32x4*)(F.in[29] + 4 * lane + 256 * j); *(f32x4*)(src + 4 * lane + 256 * j) = v[j] * rs * gn; } }
        STAMP(15);
    }
    SEAM(7); STAMP(7);

    const bool fuse_norm = (G == 256);
    if (IN(8)) {
        pg8::Gemm gm{F.HID, F.WFF2, DFF, DFF, DFF}; pg8::StaticOrder S; S.init(MP, DM, G, (int)blockIdx.x);
        if (fuse_norm) { EpiFF2Norm E{F.out, F.XN, F.in[29], (float*)(ws + WS_SLOT), (unsigned*)(ws + WS_CNT)}; pg8::gemm_phase<EpiFF2Norm, pg8::StaticOrder, false, true>(lds, gm, S, E); }
        else { EpiFF2 E{F.out, F.XN}; pg8::gemm_phase<EpiFF2, pg8::StaticOrder, false, true>(lds, gm, S, E); }
        STAMP(14);
    }
    if (!fuse_norm) { SEAM(8); } STAMP(8);

#ifdef PROBE_TS
    if (IN(9) && blockIdx.x == 0) {
        if (tid == 0) { *(LAS float*)(lds + 1024) = (float)(tsb[1 + PROBE_TS] - tsb[0]) * 0.01f; }
        __syncthreads();
        const float t_us = *(LAS float*)(lds + 1024); const float sc = 1.0f + sqrtf(1e-4f + t_us * 2e-7f);
        for (int i = tid; i < 524288; i += 512) F.out[O_S5RS + i] *= sc;
        __syncthreads(); }
#endif
    if (IN(9) && !fuse_norm) {
        for (int m = gw; m < MP; m += NGW) { float* src = F.out + (size_t)m * DM;
            f32x4 v[4]; float s = 0.f;
#pragma unroll
            for (int j = 0; j < 4; ++j) { v[j] = *(const f32x4*)(src + 4 * lane + 256 * j); s += (v[j][0] * v[j][0] + v[j][1] * v[j][1]) + (v[j][2] * v[j][2] + v[j][3] * v[j][3]); }
            const float rs = rs_from_ss(wave_sum(s), 1024.f);
#pragma unroll
            for (int j = 0; j < 4; ++j) { const f32x4 gn = *(const f32x4*)(F.in[29] + 4 * lane + 256 * j); *(f32x4*)(src + 4 * lane + 256 * j) = v[j] * rs * gn; } }
    }
#undef IN
#undef SEAM
}

#ifndef N_LAUNCHES
#define N_LAUNCHES 1
#endif
extern "C" void kernel_launch(void* const* d_in, const int* in_sizes, int n_in, void* d_out, int out_size, void* d_ws, size_t ws_size, hipStream_t stream) {
    static int grid = 0;
    if (grid == 0) {
        if (n_in != 30 || (size_t)out_size != O_END || ws_size < WS_END) { fprintf(stderr, "kernel_launch: unexpected shapes: n_in %d out_size %d ws %zu\n", n_in, out_size, ws_size); grid = -1; return; }
        int dev = 0, cus = 0, per_cu = 0;
        (void)hipGetDevice(&dev); (void)hipDeviceGetAttribute(&cus, hipDeviceAttributeMultiprocessorCount, dev);
        if (hipFuncSetAttribute((const void*)hymba_fwd, hipFuncAttributeMaxDynamicSharedMemorySize, LDS_BYTES) != hipSuccess) { fprintf(stderr, "kernel_launch: hipFuncSetAttribute failed\n"); grid = -1; return; }
        if (hipOccupancyMaxActiveBlocksPerMultiprocessor(&per_cu, (const void*)hymba_fwd, 512, LDS_BYTES) != hipSuccess || per_cu < 1) { fprintf(stderr, "kernel_launch: occupancy query says %d\n", per_cu); per_cu = 1; }
        (void)hipGetLastError();
        grid = cus * per_cu;
    }
    if (grid < 0) return;
    if (hipMemsetAsync((char*)d_ws + WS_BAR, 0, 32768 + 256, stream) != hipSuccess) { fprintf(stderr, "kernel_launch: memset failed\n"); return; }
    Args a{};
    for (int i = 0; i < 30; ++i) a.in[i] = (const float*)d_in[i];
    a.out = (float*)d_out; a.ws = (unsigned char*)d_ws;
    constexpr int NPH = 10;
    for (int li = 0; li < N_LAUNCHES; ++li) {
        a.ph_lo = (N_LAUNCHES == 1) ? 0 : li; a.ph_hi = (N_LAUNCHES == 1) ? NPH : li + 1;
        void* kargs[] = {&a};
        const hipError_t e = hipLaunchCooperativeKernel((const void*)hymba_fwd, dim3(grid), dim3(512), kargs, LDS_BYTES, stream);
        if (e != hipSuccess) { fprintf(stderr, "kernel_launch: cooperative launch %d failed: %s (grid %d)\n", li, hipGetErrorString(e), grid); break; }
    }
}
```
